# Optimizing an MI355X kernel written in HIP

```python
import jax, jax.numpy as jnp
from jax import lax
import numpy as np

D_MODEL = 2048
BATCH = 2
SEQ = 4096
DEPTH = 2

HEAD_DIM = 64
N_Q_HEADS = 16
N_KV_HEADS = 4
ATTN_WIDTH = N_Q_HEADS * HEAD_DIM
KV_WIDTH = N_KV_HEADS * HEAD_DIM
WINDOW = 128
BLOCK = 128

RWKV_HEAD = 64
N_RWKV_HEADS = 16
RWKV_WIDTH = N_RWKV_HEADS * RWKV_HEAD
DECAY_LORA = 64
AAA_LORA = 64
MV_LORA = 32
GATE_LORA = 160
RWKV_GN_EPS = 64e-5

ATTN_COLS = ATTN_WIDTH + 2 * KV_WIDTH
SHIFT_WIDTH = 3 * RWKV_WIDTH + DECAY_LORA + AAA_LORA + GATE_LORA
IN_WIDTH = ATTN_COLS + SHIFT_WIDTH + 2 * D_MODEL

N_GROUPS = 4
EXPERTS_PER_GROUP = 8
N_EXPERTS = N_GROUPS * EXPERTS_PER_GROUP
TOP_K = 2
EXPERT_HIDDEN = D_MODEL // 4
MOE_BLOCK = 128

NORM_EPS = 1e-5

kernel_name = "hybrid_swa_rwkv7_hmoe"


def rms_norm(x, w):
    xf = x.astype(jnp.float32)
    y = xf * lax.rsqrt(jnp.mean(xf * xf, axis=-1, keepdims=True) + NORM_EPS)
    return (y * w.astype(jnp.float32)).astype(x.dtype)


def token_shift(z):
    return jnp.pad(z[:, :-1], ((0, 0), (1, 0), (0, 0)))


def _split(z, sizes):
    out, off = [], 0
    for s in sizes:
        out.append(z[..., off:off + s])
        off += s
    return out


def alibi_slopes(n):
    return jnp.exp2(-8.0 * jnp.arange(1, n + 1, dtype=jnp.float32) / n)


def sliding_window_attention(q, k, v, sinks):
    B, T = q.shape[:2]
    nb = T // BLOCK
    G = N_Q_HEADS // N_KV_HEADS
    f32 = jnp.float32
    qb = q.reshape(B, nb, BLOCK, N_KV_HEADS, G, HEAD_DIM).astype(f32)

    def with_prev(z):
        zb = z.reshape(B, nb, BLOCK, N_KV_HEADS, HEAD_DIM)
        prev = jnp.pad(zb[:, :-1], ((0, 0), (1, 0), (0, 0), (0, 0), (0, 0)))
        return jnp.concatenate([prev, zb], axis=2).astype(f32)

    kw, vw = with_prev(k), with_prev(v)
    scores = jnp.einsum('bnqhgd,bnkhd->bnhgqk', qb, kw) * (HEAD_DIM ** -0.5)
    qi = jnp.arange(BLOCK)[:, None]
    kj = jnp.arange(2 * BLOCK)[None, :]
    dist = qi + BLOCK - kj
    key_pos = (jnp.arange(nb)[:, None, None] - 1) * BLOCK + kj
    valid = (dist >= 0) & (dist < WINDOW) & (key_pos >= 0)
    slopes = alibi_slopes(N_Q_HEADS).reshape(N_KV_HEADS, G)[:, :, None, None]
    scores = scores - slopes * dist.astype(f32)
    scores = jnp.where(valid[None, :, None, None], scores, -jnp.inf)
    sink = sinks.astype(f32).reshape(N_KV_HEADS, G)[:, :, None, None]
    m = jnp.maximum(jnp.max(scores, axis=-1, keepdims=True), sink)
    p = jnp.exp(scores - m)
    probs = p / (jnp.sum(p, axis=-1, keepdims=True) + jnp.exp(sink - m))
    out = jnp.einsum('bnhgqk,bnkhd->bnqhgd', probs, vw)
    return out.reshape(B, T, ATTN_WIDTH)


def rwkv7_scan(r, decay, k, v, kk, a):
    B, T, H, N = r.shape

    def step(S, inp):
        r_t, w_t, k_t, v_t, kk_t, a_t = inp
        sa = jnp.einsum('bhvk,bhk->bhv', S, -kk_t)
        S = S * w_t[:, :, None, :] + sa[..., None] * (kk_t * a_t)[:, :, None, :] \
            + v_t[..., None] * k_t[:, :, None, :]
        return S, jnp.einsum('bhvk,bhk->bhv', S, r_t)

    xs = tuple(jnp.moveaxis(z, 1, 0) for z in (r, decay, k, v, kk, a))
    S0 = jnp.zeros((B, H, N, N), jnp.float32)
    _, ys = lax.scan(step, S0, xs)
    return jnp.moveaxis(ys, 0, 1)


def hybrid_mixer(h, v_first, w_in, shift_mix, attn_sinks, w0, w_up, a0, a_up, g_up,
                 k_k, k_a, r_k, ln_w, ln_b, w_branch_a, w_branch_b, w_out, vres):
    B, T, _ = h.shape
    f32 = jnp.float32
    proj = jnp.einsum('btd,dc->btc', h, w_in)
    q, k, v, z, gates = _split(proj, (ATTN_WIDTH, KV_WIDTH, KV_WIDTH, SHIFT_WIDTH, 2 * D_MODEL))

    attn = sliding_window_attention(q.reshape(B, T, N_Q_HEADS, HEAD_DIM),
                                    k.reshape(B, T, N_KV_HEADS, HEAD_DIM),
                                    v.reshape(B, T, N_KV_HEADS, HEAD_DIM), attn_sinks)

    z = (z + (token_shift(z) - z) * shift_mix).astype(f32)
    r, kr, vr, wd, ad, gd = _split(z, (RWKV_WIDTH, RWKV_WIDTH, RWKV_WIDTH, DECAY_LORA, AAA_LORA, GATE_LORA))
    w_log = -jax.nn.softplus(-(w0.astype(f32) + jnp.tanh(wd) @ w_up.astype(f32))) - 0.5
    a = jax.nn.sigmoid(a0.astype(f32) + ad @ a_up.astype(f32))
    g = jax.nn.sigmoid(gd) @ g_up.astype(f32)
    if vres is None:
        v_first = vr
    else:
        vd, vmix, vup, v0 = vres
        zv = h @ vd
        zv = (zv + (token_shift(zv) - zv) * vmix).astype(f32)
        vr = vr + (v_first - vr) * jax.nn.sigmoid(v0.astype(f32) + zv @ vup.astype(f32))

    def heads(t):
        return t.reshape(B, T, N_RWKV_HEADS, RWKV_HEAD)

    kk = heads(kr * k_k.astype(f32))
    kk = kk / jnp.maximum(jnp.sqrt(jnp.sum(kk * kk, axis=-1, keepdims=True)), 1e-12)
    kr = kr * (1.0 + (a - 1.0) * k_a.astype(f32))
    rh, kh, vh, ah = heads(r), heads(kr), heads(vr), heads(a)
    decay = heads(jnp.exp(-jnp.exp(w_log)))
    y = rwkv7_scan(rh, decay, kh, vh, kk, ah)
    mu = jnp.mean(y, axis=-1, keepdims=True)
    var = jnp.mean(jnp.square(y - mu), axis=-1, keepdims=True)
    y = ((y - mu) * lax.rsqrt(var + RWKV_GN_EPS)).reshape(B, T, RWKV_WIDTH)
    y = y * ln_w.astype(f32) + ln_b.astype(f32)
    bonus = jnp.sum(rh * kh * r_k.astype(f32), axis=-1, keepdims=True) * vh
    y = (y + bonus.reshape(B, T, RWKV_WIDTH)) * g

    ga, gb = _split(gates, (D_MODEL, D_MODEL))
    merged = jax.nn.sigmoid(ga) * (attn.astype(h.dtype) @ w_branch_a) \
        + jax.nn.sigmoid(gb) * (y.astype(h.dtype) @ w_branch_b)
    return merged @ w_out, v_first


def hierarchical_moe(h, rg_w, rg_b, re_w, re_b, w_gate, w_up, w_down):
    B, T, D = h.shape
    N = B * T
    f32 = jnp.float32
    xt = h.reshape(N, D)
    glog = (xt @ rg_w).astype(f32) + rg_b.astype(f32)
    gprob = jax.nn.softmax(glog, axis=-1)
    gsel = jnp.argmax(glog, axis=-1)
    gp = jnp.take_along_axis(gprob, gsel[:, None], axis=-1)
    elog = ((xt @ re_w).astype(f32) + re_b.astype(f32)).reshape(N, N_GROUPS, EXPERTS_PER_GROUP)
    elog_g = jnp.take_along_axis(elog, gsel[:, None, None], axis=1)[:, 0]
    top_vals, top_idx = lax.top_k(elog_g, TOP_K)
    ew = jax.nn.softmax(top_vals, axis=-1) * gp

    expert_ids = (gsel[:, None] * EXPERTS_PER_GROUP + top_idx).reshape(-1)
    token_ids = jnp.repeat(jnp.arange(N, dtype=jnp.int32), TOP_K)
    weights = ew.reshape(-1)
    A = N * TOP_K
    n_blocks = -(-A // MOE_BLOCK) + N_EXPERTS
    cap = n_blocks * MOE_BLOCK

    order = jnp.argsort(expert_ids)
    se = expert_ids[order]
    counts = jnp.bincount(expert_ids, length=N_EXPERTS)
    starts = jnp.cumsum(counts) - counts
    padded = (counts + MOE_BLOCK - 1) // MOE_BLOCK * MOE_BLOCK
    pad_ends = jnp.cumsum(padded)
    pad_starts = pad_ends - padded
    dest = pad_starts[se] + (jnp.arange(A) - starts[se])
    slot_tok = jnp.full((cap,), N, jnp.int32).at[dest].set(token_ids[order])
    slot_w = jnp.zeros((cap,), f32).at[dest].set(weights[order])
    block_expert = jnp.minimum(
        jnp.searchsorted(pad_ends, jnp.arange(n_blocks) * MOE_BLOCK, side='right'), N_EXPERTS - 1)

    x_pad = jnp.concatenate([xt, jnp.zeros((1, D), xt.dtype)], axis=0)
    xb = x_pad[slot_tok].reshape(n_blocks, MOE_BLOCK, D)

    def expert_block(args):
        xblk, e = args
        hid = jax.nn.silu(xblk @ w_gate[e]) * (xblk @ w_up[e])
        return hid @ w_down[e]

    yb = lax.map(expert_block, (xb, block_expert)).reshape(cap, D).astype(f32)
    y = jnp.zeros((N + 1, D), f32).at[slot_tok].add(yb * slot_w[:, None])
    return y[:N].reshape(B, T, D).astype(h.dtype)


def setup_inputs(seed: int = 0) -> dict:
    key = jax.random.key(seed)
    ks = iter(jax.random.split(key, 40))
    f32 = jnp.float32

    def nrm(shape, scale):
        return jax.random.normal(next(ks), shape, f32) * scale

    def uni(shape):
        return jax.random.uniform(next(ks), shape, f32)

    L, Lv = DEPTH, DEPTH - 1
    return {
        "x": nrm((BATCH, SEQ, D_MODEL), 1.0),
        "attn_norm_w": 1.0 + nrm((L, D_MODEL), 0.02),
        "w_in": nrm((L, D_MODEL, IN_WIDTH), D_MODEL ** -0.5),
        "shift_mix": uni((L, SHIFT_WIDTH)),
        "attn_sinks": nrm((L, N_Q_HEADS), 0.5),
        "rwkv_w0": nrm((L, RWKV_WIDTH), 1.0) - 0.5,
        "rwkv_w_up": nrm((L, DECAY_LORA, RWKV_WIDTH), 0.5 * DECAY_LORA ** -0.5),
        "rwkv_a0": nrm((L, RWKV_WIDTH), 0.5),
        "rwkv_a_up": nrm((L, AAA_LORA, RWKV_WIDTH), 0.5 * AAA_LORA ** -0.5),
        "rwkv_g_up": nrm((L, GATE_LORA, RWKV_WIDTH), GATE_LORA ** -0.5),
        "rwkv_k_k": 0.85 + nrm((L, RWKV_WIDTH), 0.05),
        "rwkv_k_a": 1.0 + nrm((L, RWKV_WIDTH), 0.05),
        "rwkv_r_k": nrm((L, N_RWKV_HEADS, RWKV_HEAD), 0.1),
        "rwkv_ln_w": 1.0 + nrm((L, RWKV_WIDTH), 0.02),
        "rwkv_ln_b": nrm((L, RWKV_WIDTH), 0.02),
        "vres_down": nrm((Lv, D_MODEL, MV_LORA), D_MODEL ** -0.5),
        "vres_mix": uni((Lv, MV_LORA)),
        "vres_up": nrm((Lv, MV_LORA, RWKV_WIDTH), 0.5 * MV_LORA ** -0.5),
        "vres_v0": nrm((Lv, RWKV_WIDTH), 0.5),
        "w_branch_a": nrm((L, ATTN_WIDTH, D_MODEL), ATTN_WIDTH ** -0.5),
        "w_branch_b": nrm((L, RWKV_WIDTH, D_MODEL), RWKV_WIDTH ** -0.5),
        "w_out": nrm((L, D_MODEL, D_MODEL), D_MODEL ** -0.5),
        "ffn_norm_w": 1.0 + nrm((L, D_MODEL), 0.02),
        "router_group_w": nrm((L, D_MODEL, N_GROUPS), D_MODEL ** -0.5),
        "router_group_b": nrm((L, N_GROUPS), 0.01),
        "router_expert_w": nrm((L, D_MODEL, N_EXPERTS), D_MODEL ** -0.5),
        "router_expert_b": nrm((L, N_EXPERTS), 0.01),
        "expert_w_gate": nrm((L, N_EXPERTS, D_MODEL, EXPERT_HIDDEN), D_MODEL ** -0.5),
        "expert_w_up": nrm((L, N_EXPERTS, D_MODEL, EXPERT_HIDDEN), D_MODEL ** -0.5),
        "expert_w_down": nrm((L, N_EXPERTS, EXPERT_HIDDEN, D_MODEL), EXPERT_HIDDEN ** -0.5),
        "final_norm_w": 1.0 + nrm((D_MODEL,), 0.02),
    }


def reference(x, attn_norm_w, w_in, shift_mix, attn_sinks, rwkv_w0, rwkv_w_up, rwkv_a0,
              rwkv_a_up, rwkv_g_up, rwkv_k_k, rwkv_k_a, rwkv_r_k, rwkv_ln_w, rwkv_ln_b,
              vres_down, vres_mix, vres_up, vres_v0, w_branch_a, w_branch_b, w_out,
              ffn_norm_w, router_group_w, router_group_b, router_expert_w, router_expert_b,
              expert_w_gate, expert_w_up, expert_w_down, final_norm_w):
    v_first = None
    for i in range(DEPTH):
        vres = None if i == 0 else (vres_down[i - 1], vres_mix[i - 1], vres_up[i - 1], vres_v0[i - 1])
        h = rms_norm(x, attn_norm_w[i])
        mix, v_first = hybrid_mixer(h, v_first, w_in[i], shift_mix[i], attn_sinks[i],
                                    rwkv_w0[i], rwkv_w_up[i], rwkv_a0[i], rwkv_a_up[i], rwkv_g_up[i],
                                    rwkv_k_k[i], rwkv_k_a[i], rwkv_r_k[i], rwkv_ln_w[i], rwkv_ln_b[i],
                                    w_branch_a[i], w_branch_b[i], w_out[i], vres)
        x = x + mix.astype(x.dtype)
        hf = rms_norm(x, ffn_norm_w[i])
        x = x + hierarchical_moe(hf, router_group_w[i], router_group_b[i], router_expert_w[i],
                                 router_expert_b[i], expert_w_gate[i], expert_w_up[i],
                                 expert_w_down[i]).astype(x.dtype)
    return rms_norm(x, final_norm_w)
```

```cpp
#include <hip/hip_runtime.h>
#include <cstdio>
#include <cstdint>

namespace pg8 {
#define PG8_LAS __attribute__((address_space(3)))
typedef unsigned short bf16_t;
typedef short bf16x8 __attribute__((ext_vector_type(8)));
typedef float f32x4 __attribute__((ext_vector_type(4)));
typedef unsigned u32x4 __attribute__((ext_vector_type(4)));
typedef unsigned u32x2 __attribute__((ext_vector_type(2)));
constexpr int BM = 256, BK = 64, HALF = 128, HTB = HALF * BK * 2  , STAGE_BYTES = 8 * HTB, NXCD = 8, WGM = 8;

__host__ __device__ __forceinline__ int lds_byte(int r, int c) { const int st = (r >> 4) * 2 + (c >> 5), rr = r & 15, cc = c & 31, ob = rr * 64 + cc * 2; return st * 1024 + (ob ^ (((ob >> 9) & 1) << 5)); }
__host__ __device__ __forceinline__ void stage_rc(int b, int& R, int& C) { const int st = b / 1024, sb = b % 1024, swz = sb ^ (((sb >> 9) & 1) << 5); R = (st >> 1) * 16 + swz / 64; C = (st & 1) * 32 + (swz % 64) / 2; }
__host__ __device__ __forceinline__ int perm32(int rho) { const int n = rho >> 4, i = rho & 15; return 8 * (i >> 2) + 4 * n + (i & 3); }

struct Unit { int pm, pn, kq, sb; };
struct Gemm { const bf16_t* A; const bf16_t* Bt; int M, N, K, ld; };

struct StaticOrder {
    int nM, nN, nwg, G, c, wgm;
    __host__ __device__ void init(int M, int N, int G_, int c_, int wgm_ = WGM) { nM = M / BM; nN = N / BM; nwg = nM * nN; G = G_; c = c_; wgm = wgm_; }
    __host__ __device__ bool next(int i, Unit& u) const { return at((long)i * G + c, u); }
    __host__ __device__ bool at(const long L, Unit& u) const {
        if (L >= nwg) return false;
        int wgid = (int)L; { const int q = nwg / NXCD, r = nwg % NXCD, xcd = wgid % NXCD, off = wgid / NXCD; wgid = (xcd < r ? xcd * (q + 1) : r * (q + 1) + (xcd - r) * q) + off; }
        const int nig = wgm * nN, gid = wgid / nig, fm = gid * wgm, gsz = (nM - fm) < wgm ? (nM - fm) : wgm;
        u.pm = fm + ((wgid % nig) % gsz); u.pn = (wgid % nig) / gsz; u.kq = 0; u.sb = 0; return true;
    }
    __device__ __forceinline__ void a_ready(const Unit&) const {}
    __device__ __forceinline__ void done(const Unit&) const {}
};
struct ListOrder {
    StaticOrder base; int first, stride, cnt;
    __device__ __forceinline__ bool next(int i, Unit& u) const { return (i < cnt) && base.at((long)first + (long)i * stride, u); }
    __device__ __forceinline__ void a_ready(const Unit&) const {}
    __device__ __forceinline__ void done(const Unit&) const {}
};
__device__ __forceinline__ unsigned cvt_pk_bf16(float lo, float hi) { unsigned r; asm volatile("v_cvt_pk_bf16_f32 %0, %1, %2" : "=v"(r) : "v"(lo), "v"(hi)); return r; }
typedef int i32x4_ __attribute__((ext_vector_type(4))); typedef int i32x8_ __attribute__((ext_vector_type(8)));
template <class Epi, class Sched, bool ALIGN_EPI = false, bool SP2 = false, bool GATHER = false, int F8 = 0, bool I8 = false>
__device__ __forceinline__ void gemm_phase(PG8_LAS unsigned char* lds, const Gemm g, const Sched& S, const Epi& E, const int* slot_tok = nullptr) {
    static_assert(!GATHER || SP2, "row-gathered A panels: SP2 loop only");
    int tid_ = threadIdx.x; asm volatile("" : "+v"(tid_));
    const int tid = tid_, wid = __builtin_amdgcn_readfirstlane(tid >> 6), lane = tid & 63, wr = wid >> 2, wc = wid & 3, fr = lane & 15, fq = lane >> 4;
    const int K = g.K, nt = K / BK, LD = g.ld ? g.ld : g.K;
    unsigned voffA[2], voffB[2];
#pragma unroll
    for (int i = 0; i < 2; ++i) { int R, C; stage_rc(tid * 16 + i * 8192, R, C); const int Rb = Epi::PERM ? ((R & ~31) + perm32(R & 31)) : R;
        voffA[i] = (unsigned)(R * LD + C) * 2u; voffB[i] = (unsigned)(Rb * LD + C) * 2u; }
    const size_t kstep = (size_t)(BK * 2);
    const size_t hstep = (size_t)HALF * LD * 2;
    const size_t tstep = 2 * hstep;
    const unsigned ldsw = (unsigned)wid * 1024u;
    const int aoff = lds_byte(wr * 64 + fr, fq * 8), boff = lds_byte(wc * 32 + fr, fq * 8);
#define PG8_SA(b, h) (((b) * 2 + (h)) * HTB)
#define PG8_SB(b, h) ((4 + (b) * 2 + (h)) * HTB)
#define PG8_STAGE(bufoff, gbase, voff) do { _Pragma("unroll") for (int _i = 0; _i < 2; ++_i) \
        __builtin_amdgcn_global_load_lds((const unsigned*)((const char*)(gbase) + (voff)[_i]), (PG8_LAS unsigned*)(lds + (bufoff) + ldsw + _i * 8192), 16, 0, 0); } while (0)
#define PG8_LDA(dst, b, h) do { _Pragma("unroll") for (int m = 0; m < 4; ++m) _Pragma("unroll") for (int k = 0; k < 2; ++k) dst[m][k] = *(const PG8_LAS bf16x8*)(lds + PG8_SA(b, h) + aoff + m * 2048 + k * 1024); } while (0)
#define PG8_LDB(dst, b, h) do { _Pragma("unroll") for (int n = 0; n < 2; ++n) _Pragma("unroll") for (int k = 0; k < 2; ++k) dst[n][k] = *(const PG8_LAS bf16x8*)(lds + PG8_SB(b, h) + boff + n * 2048 + k * 1024); } while (0)
#define PG8_CAT(x0, x1) __builtin_shufflevector(__builtin_bit_cast(i32x4_, x0), __builtin_bit_cast(i32x4_, x1), 0, 1, 2, 3, 4, 5, 6, 7)
#define PG8_MMA(ai, bj, At, Bt) do { __builtin_amdgcn_s_setprio(1); if constexpr (F8 != 0) { _Pragma("unroll") for (int m = 0; m < 4; ++m) _Pragma("unroll") for (int n = 0; n < 2; ++n) \
        { const i32x8_ _b8 = PG8_CAT(Bt[n][0], Bt[n][1]), _a8 = PG8_CAT(At[m][0], At[m][1]); asm volatile("v_mfma_scale_f32_16x16x128_f8f6f4 %0, %1, %2, %0, %3, %3 op_sel_hi:[0,0,0]" : "+v"(acc[ai][bj][m][n]) : "v"(_b8), "v"(_a8), "v"(f8scale)); } } else { \
        _Pragma("unroll") for (int m = 0; m < 4; ++m) _Pragma("unroll") for (int n = 0; n < 2; ++n) _Pragma("unroll") for (int k = 0; k < 2; ++k) { \
        if constexpr (I8) acc[ai][bj][m][n] = __builtin_bit_cast(f32x4, __builtin_amdgcn_mfma_i32_16x16x64_i8(__builtin_bit_cast(i32x4_, Bt[n][k]), __builtin_bit_cast(i32x4_, At[m][k]), __builtin_bit_cast(i32x4_, acc[ai][bj][m][n]), 0, 0, 0)); \
        else acc[ai][bj][m][n] = __builtin_amdgcn_mfma_f32_16x16x32_bf16(Bt[n][k], At[m][k], acc[ai][bj][m][n], 0, 0, 0); } } __builtin_amdgcn_s_setprio(0); } while (0)
#define PG8_WAIT_V(n) asm volatile("s_waitcnt vmcnt(" #n ")" ::: "memory")
#define PG8_WAIT_L(n) asm volatile("s_waitcnt lgkmcnt(" #n ")" ::: "memory")
#define PG8_BAR __builtin_amdgcn_s_barrier()
#define PG8_SCHED __builtin_amdgcn_sched_barrier(0)
    int gR[2]; unsigned gC[2]; unsigned gv[2][2], gn[2][2];
#pragma unroll
    for (int i = 0; i < 2; ++i) { int R, C; stage_rc(tid * 16 + i * 8192, R, C); gR[i] = R; gC[i] = (unsigned)C * 2u; gv[0][i] = gv[1][i] = gn[0][i] = gn[1][i] = 0u; }
#define PG8_GOFF(dst, u) do { _Pragma("unroll") for (int _h = 0; _h < 2; ++_h) _Pragma("unroll") for (int _i = 0; _i < 2; ++_i) { \
        const int _tk = slot_tok[(u).sb + _h * HALF + gR[_i]]; dst[_h][_i] = (unsigned)((_tk < 0 ? 0 : (_tk >> 1)) * LD) * 2u + gC[_i]; } } while (0)
#define PG8_STAGE_A(bufoff, gbase, H, NX) do { _Pragma("unroll") for (int _i = 0; _i < 2; ++_i) { unsigned _o; const char* _b; \
        if constexpr (GATHER) { _o = (NX) ? gn[H][_i] : gv[H][_i]; _b = (const char*)(gbase); } else { _o = voffA[_i]; _b = (const char*)(gbase) + (H) * hstep; } \
        __builtin_amdgcn_global_load_lds((const unsigned*)(_b + _o), (PG8_LAS unsigned*)(lds + (bufoff) + ldsw + _i * 8192), 16, 0, 0); } } while (0)
    int f8scale = F8; asm volatile("" : "+v"(f8scale));
    Unit cur, nxt; int ui = 0;
    if (!S.next(0, cur)) return;
    if constexpr (GATHER) PG8_GOFF(gv, cur);
    f32x4 acc[2][2][4][2];
#pragma unroll
    for (int a = 0; a < 2; ++a)
#pragma unroll
        for (int b = 0; b < 2; ++b)
#pragma unroll
            for (int m = 0; m < 4; ++m)
#pragma unroll
                for (int n = 0; n < 2; ++n) acc[a][b][m][n] = (f32x4){0.f, 0.f, 0.f, 0.f};
    bf16x8 At[4][2], B0[2][2], B1[2][2];
    const char* cA = (const char*)g.A + (GATHER ? (size_t)0 : (size_t)cur.pm * tstep) + (size_t)cur.kq * 2; const char* cB = (const char*)g.Bt + (size_t)cur.pn * tstep + (size_t)cur.kq * 2;
    S.a_ready(cur);
    if constexpr (SP2) {
        PG8_STAGE(PG8_SB(0, 0), cB, voffB); PG8_STAGE(PG8_SB(0, 1), cB + hstep, voffB); PG8_STAGE_A(PG8_SA(0, 0), cA, 0, false); PG8_STAGE_A(PG8_SA(0, 1), cA, 1, false);
        if (wr == 1) PG8_BAR;
        PG8_WAIT_V(2); PG8_BAR;
        PG8_STAGE(PG8_SB(1, 0), cB + kstep, voffB); PG8_STAGE_A(PG8_SA(1, 0), cA + kstep, 0, false); PG8_STAGE(PG8_SB(1, 1), cB + hstep + kstep, voffB);
        PG8_WAIT_V(6); PG8_BAR;
    } else {
        PG8_STAGE(PG8_SB(0, 0), cB, voffB); PG8_STAGE(PG8_SA(0, 0), cA, voffA); PG8_STAGE(PG8_SB(0, 1), cB + hstep, voffB); PG8_STAGE(PG8_SA(0, 1), cA + hstep, voffA);
        if (wr == 1) PG8_BAR;
        PG8_WAIT_V(4); PG8_BAR;
        PG8_STAGE(PG8_SB(1, 0), cB + kstep, voffB); PG8_STAGE(PG8_SA(1, 0), cA + kstep, voffA); PG8_STAGE(PG8_SB(1, 1), cB + hstep + kstep, voffB);
        PG8_WAIT_V(6); PG8_BAR;
    }
    for (;;) {
        const bool has_next = S.next(ui + 1, nxt);
        const char* nA = has_next ? (const char*)g.A + (GATHER ? (size_t)0 : (size_t)nxt.pm * tstep) + (size_t)nxt.kq * 2 : cA; const char* nB = has_next ? (const char*)g.Bt + (size_t)nxt.pn * tstep + (size_t)nxt.kq * 2 : cB;
        for (int t = 0; t < nt; t += 2) {
            const bool last = (t == nt - 2);
            const char* a1 = cA + (size_t)(t + 1) * kstep;
            const char* a2 = last ? nA : cA + (size_t)(t + 2) * kstep; const char* b2 = last ? nB : cB + (size_t)(t + 2) * kstep;
            const char* a3 = a2 + kstep; const char* b3 = b2 + kstep;
            if (last && has_next) { S.a_ready(nxt); if constexpr (GATHER) PG8_GOFF(gn, nxt); }
            const bool nx = last && has_next;
            if constexpr (SP2) {
            PG8_LDB(B0, 0, 0); PG8_LDB(B1, 0, 1); PG8_SCHED; PG8_LDA(At, 0, 0); PG8_STAGE_A(PG8_SA(1, 1), a1, 1, false);
            PG8_WAIT_V(8); PG8_WAIT_L(0); PG8_BAR; PG8_MMA(0, 0, At, B0); PG8_MMA(0, 1, At, B1); PG8_BAR; PG8_SCHED;
            PG8_LDA(At, 0, 1); PG8_STAGE(PG8_SB(0, 0), b2, voffB); PG8_STAGE(PG8_SB(0, 1), b2 + hstep, voffB); PG8_STAGE_A(PG8_SA(0, 0), a2, 0, nx);
            PG8_WAIT_V(8); PG8_WAIT_L(0); PG8_BAR; PG8_MMA(1, 0, At, B0); PG8_MMA(1, 1, At, B1); PG8_BAR; PG8_SCHED;
            PG8_LDB(B0, 1, 0); PG8_LDB(B1, 1, 1); PG8_SCHED; PG8_LDA(At, 1, 0); PG8_STAGE_A(PG8_SA(0, 1), a2, 1, nx);
            PG8_WAIT_V(8); PG8_WAIT_L(0); PG8_BAR; PG8_MMA(0, 0, At, B0); PG8_MMA(0, 1, At, B1); PG8_BAR; PG8_SCHED;
            PG8_LDA(At, 1, 1); PG8_STAGE(PG8_SB(1, 0), b3, voffB); PG8_STAGE(PG8_SB(1, 1), b3 + hstep, voffB); PG8_STAGE_A(PG8_SA(1, 0), a3, 0, nx);
            PG8_WAIT_V(8); PG8_WAIT_L(0); PG8_BAR; PG8_MMA(1, 0, At, B0); PG8_MMA(1, 1, At, B1); PG8_BAR; PG8_SCHED;
            } else {
            PG8_LDB(B0, 0, 0); PG8_SCHED; PG8_LDA(At, 0, 0); PG8_STAGE(PG8_SA(1, 1), a1 + hstep, voffA);
            PG8_WAIT_L(8); PG8_BAR; PG8_WAIT_L(0); PG8_MMA(0, 0, At, B0); PG8_BAR; PG8_SCHED;
            PG8_LDB(B1, 0, 1); PG8_STAGE(PG8_SB(0, 0), b2, voffB);
            PG8_BAR; PG8_WAIT_L(0); PG8_MMA(0, 1, At, B1); PG8_BAR;
            PG8_LDA(At, 0, 1); PG8_STAGE(PG8_SA(0, 0), a2, voffA);
            PG8_BAR; PG8_WAIT_L(0); PG8_MMA(1, 0, At, B0); PG8_BAR; PG8_SCHED;
            PG8_STAGE(PG8_SB(0, 1), b2 + hstep, voffB);
            PG8_WAIT_V(6); PG8_BAR; PG8_MMA(1, 1, At, B1); PG8_BAR;
            PG8_LDB(B0, 1, 0); PG8_SCHED; PG8_LDA(At, 1, 0); PG8_STAGE(PG8_SA(0, 1), a2 + hstep, voffA);
            PG8_WAIT_L(8); PG8_BAR; PG8_WAIT_L(0); PG8_MMA(0, 0, At, B0); PG8_BAR; PG8_SCHED;
            PG8_LDB(B1, 1, 1); PG8_STAGE(PG8_SB(1, 0), b3, voffB);
            PG8_BAR; PG8_WAIT_L(0); PG8_MMA(0, 1, At, B1); PG8_BAR;
            PG8_LDA(At, 1, 1); PG8_STAGE(PG8_SA(1, 0), a3, voffA);
            PG8_BAR; PG8_WAIT_L(0); PG8_MMA(1, 0, At, B0); PG8_BAR; PG8_SCHED;
            PG8_STAGE(PG8_SB(1, 1), b3 + hstep, voffB);
            PG8_WAIT_V(6); PG8_BAR; PG8_MMA(1, 1, At, B1); PG8_BAR;
            }
        }
        if constexpr (F8 != 0) { asm volatile("s_nop 15\n\ts_nop 15\n\ts_nop 15" ::: "memory"); }
        if constexpr (ALIGN_EPI) { if (wr == 0) PG8_BAR; }
        bool keep_acc = false;
        if constexpr (!Epi::AFTER_DRAIN) { if constexpr (Epi::HAS_MID) { if (cur.kq == 0) { E.mid(acc, cur, wr, wc, fr, fq); keep_acc = true; } else E(acc, cur, wr, wc, fr, fq); } else E(acc, cur, wr, wc, fr, fq); S.done(cur); }
        if (!has_next) break;
        if (!keep_acc)
#pragma unroll
        for (int a = 0; a < 2; ++a)
#pragma unroll
            for (int b = 0; b < 2; ++b)
#pragma unroll
                for (int m = 0; m < 4; ++m)
#pragma unroll
                    for (int n = 0; n < 2; ++n) acc[a][b][m][n] = (f32x4){0.f, 0.f, 0.f, 0.f};
        cur = nxt; cA = nA; cB = nB; ++ui;
        if constexpr (GATHER) { _Pragma("unroll") for (int _h = 0; _h < 2; ++_h) _Pragma("unroll") for (int _i = 0; _i < 2; ++_i) gv[_h][_i] = gn[_h][_i]; }
        if constexpr (ALIGN_EPI) { if (wr == 1) PG8_BAR; }
    }
    PG8_WAIT_V(0);
    if constexpr (!ALIGN_EPI) { if (wr == 0) PG8_BAR; }
    PG8_BAR;
    if constexpr (Epi::AFTER_DRAIN) { E.fused(acc, cur, wr, wc, fr, fq, lds, wid, lane); S.done(cur); }
#undef PG8_SA
#undef PG8_SB
#undef PG8_STAGE
#undef PG8_STAGE_A
#undef PG8_GOFF
#undef PG8_LDA
#undef PG8_LDB
#undef PG8_MMA
#undef PG8_CAT
#undef PG8_WAIT_V
#undef PG8_WAIT_L
#undef PG8_BAR
#undef PG8_SCHED
}
}

constexpr int NWAVES = 8, NTHR = 512;
constexpr int NTOK = 8192, SEQ = 4096, DM = 2048;
constexpr int INW = 8992, INP = 9216;
constexpr int C_Q = 0, C_K = 1024, C_V = 1280, C_Z = 1536, C_ZV = 4896, C_GATE = 5120;
constexpr float IN_WCLIP = 5.f * 0.0220970869f  , IN_WS = 127.f / IN_WCLIP;
constexpr size_t WIN8_OFF = (size_t)C_GATE * 2048 * 2;
constexpr int GATE_SHIFT = C_GATE - 4896;
constexpr int ZW = 3360;
constexpr int NEXP = 32, EH = 512, MAXSLOT = 16384 + 32 * 256, MAXPANEL = MAXSLOT / 256;
constexpr float NORM_EPS = 1e-5f, GN_EPS = 64e-5f;
constexpr float LOG2E = 1.4426950408889634f;

constexpr size_t MiB = 1u << 20;
constexpr size_t WS_CTL = 0, CTL_ZERO_BYTES = 1 * MiB;
constexpr size_t WS_WIN_T = 2 * MiB;
constexpr size_t WS_WA_T = 38 * MiB;
constexpr size_t WS_WB_T = 42 * MiB;
constexpr size_t WS_WOUT_T = 46 * MiB;
constexpr size_t WS_LORA = 54 * MiB;
constexpr size_t WS_WGU_T = 56 * MiB;
constexpr size_t WS_WD_T = 184 * MiB;
constexpr size_t WS_X = 248 * MiB;
constexpr size_t WS_H = 312 * MiB;
constexpr size_t WS_PROJ = 344 * MiB;
constexpr size_t WS_ATTN = 488 * MiB;
constexpr size_t WS_SCAN = 504 * MiB;
constexpr size_t WS_G = 696 * MiB;
constexpr size_t WS_VFIRST = 728 * MiB;
constexpr size_t WS_Y = 760 * MiB;
constexpr size_t WS_YB = 792 * MiB;
constexpr size_t WS_TMP = 808 * MiB;
constexpr size_t WS_MERGED = 872 * MiB;
constexpr size_t WS_ROUTE = 904 * MiB;
constexpr size_t WS_END = 905 * MiB;
constexpr size_t WS_XG = WS_PROJ;
constexpr size_t WS_SLOT_TOK = WS_Y, WS_SLOT_W = WS_Y + 2 * MiB, WS_H8 = WS_ATTN  , WS_ASC = WS_Y + 7 * MiB  , WS_RSTD = WS_Y + 6 * MiB  ;
constexpr int ECAP = 8192;
constexpr size_t WS_HID = WS_PROJ + 96 * MiB;
constexpr size_t WS_MOEOUT = WS_SCAN;
constexpr size_t WS_GATE8 = WS_SCAN + 96 * MiB;
constexpr size_t WS_AY = WS_SCAN + 64 * MiB;
static_assert(WS_HID + (size_t)MAXSLOT * EH * 2 <= WS_ATTN, "hid overlay");
constexpr size_t SCAN_STRIDE = (size_t)NTOK * 1024;
constexpr size_t LO_WUP = 0, LO_AUP = 65536, LO_GUP = 131072, LO_VUP = 131072 + 163840, LO_RH = 327680 + 0, LO_RL = LO_RH + 48 * 2048;
static_assert((LO_RL + 48 * 2048) * 2 <= 2 * MiB, "lora region");
constexpr size_t RT_E = 0, RT_POS = 65536, RT_W = 131072, RT_SLOT_TOK = 196608, RT_SLOT_W = 196608 + 98304;

constexpr int CW_BAR = 4096;
constexpr int CW_CNT = 8192;

constexpr int RING_BYTES = 131072;
constexpr int LDSCTL_OFF = RING_BYTES;
constexpr int LDS_PANEL = LDSCTL_OFF + 64, LDS_TAB = LDSCTL_OFF + 1024, LDS_PSB = LDSCTL_OFF + 1536, LDS_PTRS = LDSCTL_OFF + 2048;
constexpr int LDS_BYTES = 147456;

#define GAS __attribute__((address_space(1)))
#define LAS __attribute__((address_space(3)))
typedef unsigned short bf16;
typedef unsigned v4u __attribute__((ext_vector_type(4)));
typedef unsigned v2u __attribute__((ext_vector_type(2)));
typedef float f32x4 __attribute__((ext_vector_type(4)));
typedef float f32x2 __attribute__((ext_vector_type(2)));
typedef float f32x16 __attribute__((ext_vector_type(16)));
typedef short bf16x8 __attribute__((ext_vector_type(8)));
typedef short s16x4 __attribute__((ext_vector_type(4)));
#define LDS_WAIT() asm volatile("s_waitcnt lgkmcnt(0)" ::: "memory")
#define VM_WAIT() asm volatile("s_waitcnt vmcnt(0)" ::: "memory")
__device__ __forceinline__ unsigned f2bf(float f) { unsigned u = __builtin_bit_cast(unsigned, f); return (u + 0x7fffu + ((u >> 16) & 1u)) >> 16; }
__device__ __forceinline__ unsigned pk2(float lo, float hi) { return f2bf(lo) | (f2bf(hi) << 16); }
__device__ __forceinline__ float bflo(unsigned u) { return __builtin_bit_cast(float, u << 16); }
__device__ __forceinline__ float bfhi(unsigned u) { return __builtin_bit_cast(float, u & 0xffff0000u); }
__device__ __forceinline__ float rcpf_(float x) { return __builtin_amdgcn_rcpf(x); }
__device__ __forceinline__ float sigmoidf_(float x) { return __builtin_amdgcn_rcpf(1.f + __expf(-x)); }

#define XB_TMO      128
#define XB_XCNT(j)  (256  + 64 * (j))
#define XB_XSUB(j)  (1280 + 64 * (j))
#define XB_XGEN(j)  (2304 + 64 * (j))
#define XB_TOP      3328
#define XB_TOPGEN   3392
#define XCD_BAR_WORDS 3456
#define XB_SPIN_CAP (1u << 18)

__device__ __forceinline__ unsigned xb_ld(unsigned* p)              { return __hip_atomic_load(p, __ATOMIC_RELAXED, __HIP_MEMORY_SCOPE_AGENT); }
__device__ __forceinline__ unsigned xb_add(unsigned* p, unsigned v) { return __hip_atomic_fetch_add(p, v, __ATOMIC_RELAXED, __HIP_MEMORY_SCOPE_AGENT); }
__device__ __forceinline__ unsigned xb_xcc_id() { return (unsigned)__builtin_amdgcn_s_getreg((3 << 11) | 20) & 0xFu; }
#define XB_SPIN(cond, bar) do { unsigned _sp = 0; while (cond) { __builtin_amdgcn_s_sleep(1); \
    if ((++_sp & 255u) == 0u) { if (xb_ld(&(bar)[XB_TMO])) break; if (_sp > XB_SPIN_CAP) { atomicAdd(&(bar)[XB_TMO], 1u); break; } } } } while (0)

struct XcdBarrier {
    unsigned* bar; unsigned x;
    volatile LAS unsigned* st;
};
__device__ __forceinline__ XcdBarrier xcd_barrier_post(unsigned* bar, volatile LAS unsigned* st) {
    XcdBarrier b; b.bar = bar; b.x = xb_xcc_id(); b.st = st;
    if (threadIdx.x == 0) (void)xb_add(&bar[XB_XCNT(b.x)], 1u);
    return b;
}
__device__ __forceinline__ void xcd_barrier_complete(unsigned* bar, unsigned x, unsigned& nloc, unsigned& nx) {
    const unsigned G = gridDim.x * gridDim.y * gridDim.z;
    unsigned sum, cnt, mine, sp = 0u;
    for (;;) {
        sum = 0u; cnt = 0u; mine = 0u;
#pragma unroll
        for (unsigned j = 0; j < 16; ++j) { const unsigned c = xb_ld(&bar[XB_XCNT(j)]); sum += c; cnt += (c > 0u) ? 1u : 0u; mine = (j == x) ? c : mine; }
        if (sum == G) break;
        __builtin_amdgcn_s_sleep(1);
        if ((++sp & 255u) == 0u) { if (xb_ld(&bar[XB_TMO])) break; if (sp > XB_SPIN_CAP) { atomicAdd(&bar[XB_TMO], 1u); break; } }
    }
    nloc = mine > 0u ? mine : 1u; nx = cnt > 0u ? cnt : 1u;
}
__device__ __forceinline__ void xcd_barrier(const XcdBarrier& b) {
    asm volatile("s_waitcnt vmcnt(0)" ::: "memory");
    __syncthreads();
    if (threadIdx.x == 0) {
        unsigned* bar = b.bar;
        __builtin_amdgcn_s_waitcnt(0);
        unsigned nloc = b.st[0], nx = b.st[1];
        if (nloc == 0u) { xcd_barrier_complete(bar, b.x, nloc, nx); b.st[0] = nloc; b.st[1] = nx; }
        const unsigned old = xb_add(&bar[XB_XSUB(b.x)], 1u);
        const unsigned gen = old / nloc;
        if (old + 1u == (gen + 1u) * nloc) {
            __builtin_amdgcn_fence(__ATOMIC_RELEASE, "agent");
            asm volatile("s_waitcnt vmcnt(0)" ::: "memory");
            const unsigned og = xb_add(&bar[XB_TOP], 1u);
            const unsigned tg = og / nx;
            if (og + 1u == (tg + 1u) * nx) xb_add(&bar[XB_TOPGEN], 1u);
            else XB_SPIN(xb_ld(&bar[XB_TOPGEN]) == tg, bar);
            __builtin_amdgcn_fence(__ATOMIC_ACQUIRE, "agent");
            xb_add(&bar[XB_XGEN(b.x)], 1u);
            asm volatile("s_waitcnt vmcnt(0)" ::: "memory");
        } else {
            XB_SPIN(xb_ld(&bar[XB_XGEN(b.x)]) == gen, bar);
            __builtin_amdgcn_fence(__ATOMIC_ACQUIRE, "agent");
            asm volatile("s_waitcnt vmcnt(0)" ::: "memory");
        }
    }
    __syncthreads();
}

struct Frame {
    LAS unsigned char* lds;
    unsigned* ctl;
    unsigned char* ws;
    const float* const* in;
    int tid, lane, wave, vcu, G;
};
__device__ __forceinline__ float wave_max(float v) {
#pragma unroll
    for (int o = 1; o < 64; o <<= 1) v = fmaxf(v, __shfl_xor(v, o));
    return v;
}
__device__ __forceinline__ unsigned pack_i8x4(float a, float b, float c, float d) {
    const int ia = (int)fminf(fmaxf(rintf(a), -127.f), 127.f), ib = (int)fminf(fmaxf(rintf(b), -127.f), 127.f), ic = (int)fminf(fmaxf(rintf(c), -127.f), 127.f), id = (int)fminf(fmaxf(rintf(d), -127.f), 127.f);
    return ((unsigned)ia & 255u) | (((unsigned)ib & 255u) << 8) | (((unsigned)ic & 255u) << 16) | ((unsigned)id << 24);
}
__device__ __forceinline__ float wave_sum(float v) {
#pragma unroll
    for (int o = 1; o < 64; o <<= 1) v += __shfl_xor(v, o);
    return v;
}
#ifndef F8_GATE
#define F8_GATE 0
#endif
#ifndef F8_MRG
#define F8_MRG 0
#endif
#ifndef F8_OUT
#define F8_OUT 0
#endif
#ifndef I8_UP
#define I8_UP 1
#endif
#ifndef F8_MOE
#define F8_MOE 1
#endif
#ifndef F8_IN
#define F8_IN 2
#endif

constexpr int TS = 68;
__device__ __forceinline__ void transpose_item(const float* W, int K, int N, bf16* WT, int ldk, int row_off, int mode, LAS bf16* scr, int item, int lane, const float* ksc = nullptr, float f8 = 0.f) {
    const int nblk = (N + 63) / 64, kb = item / nblk, nb = item - kb * nblk, k0 = 64 * kb, n0 = 64 * nb;
    const int lr = lane >> 4, lc = 4 * (lane & 15);
    const bool cv = (n0 + lc) < N;
    f32x4 v[16];
#pragma unroll
    for (int i = 0; i < 16; ++i) { v[i] = (f32x4){0.f, 0.f, 0.f, 0.f}; if (cv) v[i] = __builtin_nontemporal_load((const GAS f32x4*)(W + (size_t)(k0 + 4 * i + lr) * N + n0 + lc)); }
    if (ksc) {
#pragma unroll
        for (int i = 0; i < 16; ++i) v[i] = v[i] * ksc[k0 + 4 * i + lr]; }
    if (f8 != 0.f) { const float f8a = fabsf(f8);
#pragma unroll
        for (int i = 0; i < 16; ++i) v[i] = v[i] * f8a; }
    const bool g8 = F8_GATE && (mode == 3);
    if (g8 && (n0 + lc) >= 4896) {
#pragma unroll
        for (int i = 0; i < 16; ++i) v[i] = v[i] * 64.f; }
#pragma unroll
    for (int i = 0; i < 16; ++i) { v2u o; o.x = pk2(v[i].x, v[i].y); o.y = pk2(v[i].z, v[i].w); *(LAS v2u*)(scr + (4 * i + lr) * TS + lc) = o; }
    LDS_WAIT(); asm volatile("" ::: "memory");
    const int c = lane & 7;
#pragma unroll
    for (int j = 0; j < 8; ++j) { const int n = (lane >> 3) + 8 * j; const LAS bf16* s = scr + (8 * c) * TS + n;
        v4u o; o.x = (unsigned)s[0 * TS] | ((unsigned)s[1 * TS] << 16); o.y = (unsigned)s[2 * TS] | ((unsigned)s[3 * TS] << 16); o.z = (unsigned)s[4 * TS] | ((unsigned)s[5 * TS] << 16); o.w = (unsigned)s[6 * TS] | ((unsigned)s[7 * TS] << 16);
        const int nn = n0 + n; const int orow = (mode == 0) ? (row_off + nn) : (mode == 3) ? (nn + ((nn >= 4896) ? GATE_SHIFT : 0)) : (((nn >> 2) << 3) + (nn & 3) + ((mode == 2) ? 4 : 0));
        if (f8 < 0.f) { v2u o8; o8.x = pack_i8x4(bflo(o.x), bfhi(o.x), bflo(o.y), bfhi(o.y)); o8.y = pack_i8x4(bflo(o.z), bfhi(o.z), bflo(o.w), bfhi(o.w));
            if (nn < N) *(GAS v2u*)((GAS unsigned char*)WT + (size_t)orow * ldk + k0 + 8 * c) = o8; }
        else if (f8 != 0.f || (g8 && nn >= 4896)) { int lo8 = 0, hi8 = 0; unsigned char* W8 = (unsigned char*)WT; size_t r8 = (size_t)orow;
            if (g8) { W8 += WIN8_OFF; r8 = (size_t)(nn - 4896); }
            lo8 = __builtin_amdgcn_cvt_pk_fp8_f32(bflo(o.x), bfhi(o.x), lo8, false); lo8 = __builtin_amdgcn_cvt_pk_fp8_f32(bflo(o.y), bfhi(o.y), lo8, true);
            hi8 = __builtin_amdgcn_cvt_pk_fp8_f32(bflo(o.z), bfhi(o.z), hi8, false); hi8 = __builtin_amdgcn_cvt_pk_fp8_f32(bflo(o.w), bfhi(o.w), hi8, true);
            v2u o8; o8.x = (unsigned)lo8; o8.y = (unsigned)hi8;
            if (nn < N) *(GAS v2u*)((GAS unsigned char*)W8 + r8 * ldk + k0 + 8 * c) = o8; }
        else if (nn < N) __builtin_nontemporal_store(o, (GAS v4u*)(WT + (size_t)orow * ldk + k0 + 8 * c)); }
    LDS_WAIT(); asm volatile("" ::: "memory");
}

struct In {
    const float *x, *attn_norm_w, *w_in, *shift_mix, *sinks, *w0, *w_up, *a0, *a_up, *g_up, *k_k, *k_a, *r_k, *ln_w, *ln_b,
                *vres_down, *vres_mix, *vres_up, *vres_v0, *w_a, *w_b, *w_out, *ffn_norm_w, *rg_w, *rg_b, *re_w, *re_b, *e_gate, *e_up, *e_down, *final_w;
};

__device__ __forceinline__ const float* ldptr(const Frame& F, int k) {
    const LAS unsigned* p = (const LAS unsigned*)(F.lds + LDS_PTRS) + 2 * k;
    const unsigned lo = __builtin_amdgcn_readfirstlane(p[0]), hi = __builtin_amdgcn_readfirstlane(p[1]);
    return (const float*)(((unsigned long long)hi << 32) | lo); }
__device__ __forceinline__ In load_in(const Frame& F) {
    In I;
    I.x = ldptr(F, 0); I.attn_norm_w = ldptr(F, 1); I.w_in = ldptr(F, 2); I.shift_mix = ldptr(F, 3); I.sinks = ldptr(F, 4); I.w0 = ldptr(F, 5); I.w_up = ldptr(F, 6); I.a0 = ldptr(F, 7);
    I.a_up = ldptr(F, 8); I.g_up = ldptr(F, 9); I.k_k = ldptr(F, 10); I.k_a = ldptr(F, 11); I.r_k = ldptr(F, 12); I.ln_w = ldptr(F, 13); I.ln_b = ldptr(F, 14); I.vres_down = ldptr(F, 15);
    I.vres_mix = ldptr(F, 16); I.vres_up = ldptr(F, 17); I.vres_v0 = ldptr(F, 18); I.w_a = ldptr(F, 19); I.w_b = ldptr(F, 20); I.w_out = ldptr(F, 21); I.ffn_norm_w = ldptr(F, 22);
    I.rg_w = ldptr(F, 23); I.rg_b = ldptr(F, 24); I.re_w = ldptr(F, 25); I.re_b = ldptr(F, 26); I.e_gate = ldptr(F, 27); I.e_up = ldptr(F, 28); I.e_down = ldptr(F, 29); I.final_w = ldptr(F, 30);
    return I; }
constexpr int CV_IN = 32 * 141, CV_VD = 32, CV_BR = 16 * 32, CV_OUT = 32 * 32, CV_EX = 256, CV_MOE = 3 * NEXP * CV_EX;
__device__ __forceinline__ int conv_dense_items(int l) { return CV_IN + ((l == 1) ? CV_VD : 0) + 2 * CV_BR + CV_OUT; }
__device__ __forceinline__ void conv_items(const Frame& F, const In& I, int l, int lo, int hi, int rank, int nwg) {
    LAS bf16* scr = (LAS bf16*)(F.lds + F.wave * 16384);
    bf16* win_t = (bf16*)(F.ws + WS_WIN_T);
    const int n_vd = (l == 1) ? CV_VD : 0;
    for (int it = lo + rank * NWAVES + F.wave; it < hi; it += nwg * NWAVES) {
        int r = it; const float* src; bf16* dst; const float* ksc = nullptr; float f8 = 0.f; int K, N, roff = 0, mode = 0, ldk = 0;
        if (r < CV_IN) { src = I.w_in + (size_t)l * DM * INW; K = DM; N = INW; dst = win_t; mode = 3; f8 = (F8_IN == 2) ? -IN_WS : F8_IN ? 64.f : 0.f; }
        else if ((r -= CV_IN) < n_vd) { src = I.vres_down; K = DM; N = 32; dst = win_t; roff = C_ZV; f8 = (F8_IN == 2) ? -IN_WS : F8_IN ? 64.f : 0.f; }
        else if ((r -= n_vd) < CV_BR) { src = I.w_a + (size_t)l * 1024 * DM; K = 1024; N = DM; dst = (bf16*)(F.ws + WS_WA_T); ldk = 2048; f8 = F8_MRG ? 64.f : 0.f; }
        else if ((r -= CV_BR) < CV_BR) { src = I.w_b + (size_t)l * 1024 * DM; K = 1024; N = DM; dst = (bf16*)(F.ws + WS_WA_T + 1024 * (F8_MRG ? 1 : 2)); ldk = 2048; f8 = F8_MRG ? 64.f : 0.f; }
        else if ((r -= CV_BR) < CV_OUT) { src = I.w_out + (size_t)l * DM * DM; K = DM; N = DM; dst = (bf16*)(F.ws + WS_WOUT_T); f8 = F8_OUT ? 64.f : 0.f; }
        else { r -= CV_OUT; const int kind = r / (NEXP * CV_EX); r -= kind * (NEXP * CV_EX); const int e = r / CV_EX; r -= e * CV_EX;
            constexpr size_t EB = F8_MOE ? 1 : 2;
            if (kind == 0)      { src = I.e_gate + ((size_t)l * NEXP + e) * DM * EH; K = DM; N = EH; dst = (bf16*)(F.ws + WS_WGU_T + (size_t)e * 1024 * DM * EB); mode = 1; ksc = I.ffn_norm_w + l * DM; f8 = I8_UP ? -IN_WS : F8_MOE ? 64.f : 0.f; }
            else if (kind == 1) { src = I.e_up   + ((size_t)l * NEXP + e) * DM * EH; K = DM; N = EH; dst = (bf16*)(F.ws + WS_WGU_T + (size_t)e * 1024 * DM * EB); mode = 2; ksc = I.ffn_norm_w + l * DM; f8 = I8_UP ? -IN_WS : F8_MOE ? 64.f : 0.f; }
            else                { src = I.e_down + ((size_t)l * NEXP + e) * EH * DM; K = EH; N = DM; dst = (bf16*)(F.ws + WS_WD_T + (size_t)e * DM * EH * EB); f8 = F8_MOE ? 32.f : 0.f; } }
        transpose_item(src, K, N, dst, ldk ? ldk : K, roff, mode, scr, r, F.lane, ksc, f8);
    }
}
__device__ __forceinline__ void conv_small(const Frame& F, const In& I, int l) {
    const int gw = F.vcu * NWAVES + F.wave, NGW = F.G * NWAVES;
    bf16* win_t = (bf16*)(F.ws + WS_WIN_T);
    { const int r0 = C_ZV + ((l == 1) ? 32 : 0); const size_t n16 = (size_t)(C_GATE - r0) * DM * (F8_IN ? 1 : 2) / 16; GAS v4u* z = (GAS v4u*)((GAS unsigned char*)win_t + (size_t)r0 * DM * (F8_IN ? 1 : 2));
      for (size_t i = (size_t)gw * 64 + F.lane; i < n16; i += (size_t)NGW * 64) z[i] = (v4u){0u, 0u, 0u, 0u}; }
    bf16* lo = (bf16*)(F.ws + WS_LORA);
    const int gt = gw * 64 + F.lane, NGT = NGW * 64;
    for (int i = gt; i < 1024 * 64; i += NGT) { const int n = i >> 6, k = i & 63;
        lo[LO_WUP + i] = (bf16)f2bf(I.w_up[(size_t)l * 65536 + k * 1024 + n]); lo[LO_AUP + i] = (bf16)f2bf(I.a_up[(size_t)l * 65536 + k * 1024 + n]); }
    for (int i = gt; i < 1024 * 160; i += NGT) { const int n = i / 160, k = i % 160; lo[LO_GUP + i] = (bf16)f2bf(I.g_up[(size_t)l * 163840 + k * 1024 + n]); }
    if (l == 1) for (int i = gt; i < 1024 * 32; i += NGT) { const int n = i >> 5, k = i & 31; lo[LO_VUP + i] = (bf16)f2bf(I.vres_up[k * 1024 + n]); }
    for (int i = gt; i < 48 * 2048; i += NGT) { const int n = i >> 11, k = i & 2047;
        const float v = ((n < 32) ? I.re_w[(size_t)l * 65536 + k * 32 + n] : ((n < 36) ? I.rg_w[(size_t)l * 8192 + k * 4 + (n - 32)] : 0.f)) * I.ffn_norm_w[l * DM + k];
        const unsigned h = f2bf(v); lo[LO_RH + i] = (bf16)h; lo[LO_RL + i] = (bf16)f2bf(v - bflo(h)); }
}
#ifndef CV_B1
#define CV_B1 9216
#endif
#ifndef CV_B2
#define CV_B2 16384
#endif
__device__ __forceinline__ int conv_first_items(int l, int G) { return (G == 256) ? CV_IN + ((l == 1) ? CV_VD : 0) : conv_dense_items(l); }
__device__ __forceinline__ void conv_phase(const Frame& F, const In& I, int l, int lo = 0) {
    conv_items(F, I, l, lo, conv_first_items(l, F.G), F.vcu, F.G); conv_small(F, I, l);
}
__device__ __forceinline__ int moe_r2(int np, int G) { const int n_up = np * 4; return (n_up > G) ? ((n_up - G < G / 2) ? n_up - G : G / 2) : 0; }
__device__ __forceinline__ int moe_n_early(int np, int G) {
    const int R2 = moe_r2(np, G), avail = ((np < G / 4) ? np : G / 4) * 8, nd = np * 8, W = G - R2;
    int best = 0, bestc = 1 << 30;
#pragma unroll
    for (int r = 2; r <= 3; ++r) { int ne = r * W; if (ne > avail) ne = avail; const int zr = (nd - ne + G - 1) / G; const int yc = (R2 > 0 && r * 10 < 22) ? 22 : r * 10; const int c = yc + zr * 10; if (c < bestc) { bestc = c; best = ne; } }
    return best; }
__device__ __forceinline__ int cv_z_idle(int np, int G) { const int n_late = np * 8 - moe_n_early(np, G); const int rem = n_late % G; return (n_late > 0 && rem != 0) ? G - rem : 0; }
__device__ __forceinline__ int cv_z_items(int np, int G) { const int idle = cv_z_idle(np, G); const int n = idle * 16; const int d = conv_first_items(1, G); return n < d ? n : d; }

__device__ __forceinline__ void rms_row_bf16(const float* xrow, const float* w, bf16* orow, int lane, unsigned char* orow8 = nullptr, float* asc = nullptr) {
    const GAS f32x4* xr = (const GAS f32x4*)xrow + lane; const GAS f32x4* wr = (const GAS f32x4*)w + lane;
    f32x4 v[8]; float s = 0.f;
#pragma unroll
    for (int j = 0; j < 8; ++j) { v[j] = __builtin_nontemporal_load(xr + 64 * j); s += (v[j].x * v[j].x + v[j].y * v[j].y) + (v[j].z * v[j].z + v[j].w * v[j].w); }
    const float rstd = __builtin_amdgcn_rsqf(wave_sum(s) * (1.f / DM) + NORM_EPS);
    if (F8_GATE) { GAS unsigned* o4 = (GAS unsigned*)orow8 + lane;
#pragma unroll
        for (int j = 0; j < 8; ++j) { const f32x4 ww = wr[64 * j]; int p = 0; p = __builtin_amdgcn_cvt_pk_fp8_f32(v[j].x * rstd * ww.x, v[j].y * rstd * ww.y, p, false); p = __builtin_amdgcn_cvt_pk_fp8_f32(v[j].z * rstd * ww.z, v[j].w * rstd * ww.w, p, true); o4[64 * j] = (unsigned)p; } }
    if (F8_IN == 2) { GAS unsigned* o4 = (GAS unsigned*)orow + lane; float mx = 0.f; f32x4 hv[8];
#pragma unroll
        for (int j = 0; j < 8; ++j) { hv[j] = v[j] * rstd * wr[64 * j]; mx = fmaxf(mx, fmaxf(fmaxf(fabsf(hv[j].x), fabsf(hv[j].y)), fmaxf(fabsf(hv[j].z), fabsf(hv[j].w)))); }
        mx = fmaxf(wave_max(mx), 1e-20f); const float qs = 127.f / mx;
#pragma unroll
        for (int j = 0; j < 8; ++j) o4[64 * j] = pack_i8x4(hv[j].x * qs, hv[j].y * qs, hv[j].z * qs, hv[j].w * qs);
        if (lane == 0) *asc = mx * (1.f / (127.f * IN_WS));
        return; }
    if (F8_IN) { GAS unsigned* o4 = (GAS unsigned*)orow + lane;
#pragma unroll
        for (int j = 0; j < 8; ++j) { const f32x4 ww = wr[64 * j]; int p = 0; p = __builtin_amdgcn_cvt_pk_fp8_f32(v[j].x * rstd * ww.x, v[j].y * rstd * ww.y, p, false); p = __builtin_amdgcn_cvt_pk_fp8_f32(v[j].z * rstd * ww.z, v[j].w * rstd * ww.w, p, true); o4[64 * j] = (unsigned)p; }
        return; }
    GAS v2u* o8 = (GAS v2u*)orow + lane;
#pragma unroll
    for (int j = 0; j < 8; ++j) { const f32x4 ww = wr[64 * j]; v2u o; o.x = pk2(v[j].x * rstd * ww.x, v[j].y * rstd * ww.y); o.y = pk2(v[j].z * rstd * ww.z, v[j].w * rstd * ww.w); o8[64 * j] = o; }
}
#ifndef ROW_LOCAL
#define ROW_LOCAL 0
#endif
__device__ __forceinline__ int row_of(int gw, int r, int NGW) { return (ROW_LOCAL && NGW == 2048) ? 4 * gw + r : gw + r * NGW; }
__device__ __forceinline__ void norm_phase(const Frame& F, const float* x, const float* w, bf16* out) {
    const int gw = F.vcu * NWAVES + F.wave, NGW = F.G * NWAVES;
    for (int r = 0; r * NGW < NTOK; ++r) { const int m = row_of(gw, r, NGW); if (m < NTOK) rms_row_bf16(x + (size_t)m * DM, w, (bf16*)((unsigned char*)out + (size_t)m * DM * (F8_IN ? 1 : 2)), F.lane, F.ws + WS_H8 + (size_t)m * DM, (float*)(F.ws + WS_ASC) + m); }
}

namespace pg8 {
struct EpiStoreBf16 {
    static constexpr bool PERM = true, AFTER_DRAIN = false, HAS_MID = false;
    bf16_t* O; int ldc; unsigned char* G8; int pn0; const float* asc;
    static __device__ __forceinline__ f32x4 cvt_acc(const f32x4 a, float s, bool isint) { if (!isint) return a; const i32x4_ q = __builtin_bit_cast(i32x4_, a); f32x4 r; r[0] = (float)q[0] * s; r[1] = (float)q[1] * s; r[2] = (float)q[2] * s; r[3] = (float)q[3] * s; return r; }
    __device__ __forceinline__ void operator()(const f32x4 (&acc)[2][2][4][2], const Unit& u, int wr, int wc, int fr, int fq) const {
        const int row0 = u.pm * BM + wr * 64 + fr;
        const int tp = u.pn + pn0;
        float rsc[2][4];
#pragma unroll
        for (int ai = 0; ai < 2; ++ai)
#pragma unroll
            for (int m = 0; m < 4; ++m) rsc[ai][m] = asc ? asc[row0 + ai * HALF + m * 16] : 1.f;
        if (tp < C_GATE / BM) {
            const int col0 = tp * BM + wc * 32 + 8 * fq;
#pragma unroll
            for (int ai = 0; ai < 2; ++ai)
#pragma unroll
                for (int m = 0; m < 4; ++m) { bf16_t* rowp = O + (size_t)(row0 + ai * HALF + m * 16) * ldc + col0;
#pragma unroll
                    for (int bj = 0; bj < 2; ++bj) { const f32x4 v0 = cvt_acc(acc[ai][bj][m][0], rsc[ai][m], asc != nullptr), v1 = cvt_acc(acc[ai][bj][m][1], rsc[ai][m], asc != nullptr);
                        u32x4 w; w.x = cvt_pk_bf16(v0[0], v0[1]); w.y = cvt_pk_bf16(v0[2], v0[3]); w.z = cvt_pk_bf16(v1[0], v1[1]); w.w = cvt_pk_bf16(v1[2], v1[3]);
                        *(u32x4*)(rowp + bj * HALF) = w; } }
        } else {
            const int col0 = (tp - C_GATE / BM) * BM + wc * 32 + 8 * fq;
#pragma unroll
            for (int ai = 0; ai < 2; ++ai)
#pragma unroll
                for (int m = 0; m < 4; ++m) { unsigned char* rowp = G8 + (size_t)(row0 + ai * HALF + m * 16) * 4096 + col0;
#pragma unroll
                    for (int bj = 0; bj < 2; ++bj) { const f32x4 v0 = cvt_acc(acc[ai][bj][m][0], rsc[ai][m], asc != nullptr), v1 = cvt_acc(acc[ai][bj][m][1], rsc[ai][m], asc != nullptr);
                        int lo = 0, hi = 0;
                        lo = __builtin_amdgcn_cvt_pk_fp8_f32(v0[0], v0[1], lo, false); lo = __builtin_amdgcn_cvt_pk_fp8_f32(v0[2], v0[3], lo, true);
                        hi = __builtin_amdgcn_cvt_pk_fp8_f32(v1[0], v1[1], hi, false); hi = __builtin_amdgcn_cvt_pk_fp8_f32(v1[2], v1[3], hi, true);
                        u32x2 w; w.x = (unsigned)lo; w.y = (unsigned)hi; *(u32x2*)(rowp + bj * HALF) = w; } }
        }
    }
};
struct EpiGateA {
    static constexpr bool PERM = false, AFTER_DRAIN = false, HAS_MID = false;
    float* T; const bf16_t* Gt; int ldg;
    __device__ __forceinline__ void operator()(const f32x4 (&acc)[2][2][4][2], const Unit& u, int wr, int wc, int fr, int fq) const {
        const int row0 = u.pm * BM + wr * 64 + fr, col0 = u.pn * BM + wc * 32 + 4 * fq;
#pragma unroll
        for (int ai = 0; ai < 2; ++ai)
#pragma unroll
            for (int m = 0; m < 4; ++m) { const int row = row0 + ai * HALF + m * 16;
#pragma unroll
                for (int bj = 0; bj < 2; ++bj)
#pragma unroll
                    for (int n = 0; n < 2; ++n) { const int col = col0 + bj * HALF + n * 16;
                        const u32x2 g = *(const u32x2*)(Gt + (size_t)row * ldg + col); const f32x4 a = acc[ai][bj][m][n];
                        f32x4 o; o[0] = a[0] * sigmoidf_(bflo(g.x)); o[1] = a[1] * sigmoidf_(bfhi(g.x)); o[2] = a[2] * sigmoidf_(bflo(g.y)); o[3] = a[3] * sigmoidf_(bfhi(g.y));
                        *(f32x4*)(T + (size_t)row * DM + col) = o; } }
    }
};
struct EpiGateB {
    static constexpr bool PERM = true, AFTER_DRAIN = false, HAS_MID = false;
    const float* T; const bf16_t* Gt; int ldg; bf16_t* O;
    __device__ __forceinline__ void operator()(const f32x4 (&acc)[2][2][4][2], const Unit& u, int wr, int wc, int fr, int fq) const {
        const int row0 = u.pm * BM + wr * 64 + fr, col0 = u.pn * BM + wc * 32 + 8 * fq;
#pragma unroll
        for (int ai = 0; ai < 2; ++ai)
#pragma unroll
            for (int m = 0; m < 4; ++m) { const int row = row0 + ai * HALF + m * 16;
#pragma unroll
                for (int bj = 0; bj < 2; ++bj) { const int col = col0 + bj * HALF;
                    const u32x4 g = *(const u32x4*)(Gt + (size_t)row * ldg + col);
                    const f32x4 t0 = *(const f32x4*)(T + (size_t)row * DM + col), t1 = *(const f32x4*)(T + (size_t)row * DM + col + 4);
                    const f32x4 a0 = acc[ai][bj][m][0], a1 = acc[ai][bj][m][1];
                    u32x4 w;
                    w.x = cvt_pk_bf16(t0[0] + a0[0] * sigmoidf_(bflo(g.x)), t0[1] + a0[1] * sigmoidf_(bfhi(g.x)));
                    w.y = cvt_pk_bf16(t0[2] + a0[2] * sigmoidf_(bflo(g.y)), t0[3] + a0[3] * sigmoidf_(bfhi(g.y)));
                    w.z = cvt_pk_bf16(t1[0] + a1[0] * sigmoidf_(bflo(g.z)), t1[1] + a1[1] * sigmoidf_(bfhi(g.z)));
                    w.w = cvt_pk_bf16(t1[2] + a1[2] * sigmoidf_(bflo(g.w)), t1[3] + a1[3] * sigmoidf_(bfhi(g.w)));
                    *(u32x4*)(O + (size_t)row * DM + col) = w; } }
    }
};
struct MergeOrder {
    StaticOrder base;
    __device__ __forceinline__ bool next(int i, Unit& u) const { if (!base.next(i >> 1, u)) return false; u.kq = (i & 1) * (F8_MRG ? 512 : 1024); return true; }
    __device__ __forceinline__ void a_ready(const Unit&) const {}
    __device__ __forceinline__ void done(const Unit&) const {}
};
struct EpiMerge {
    static constexpr bool PERM = true, AFTER_DRAIN = false, HAS_MID = true;
    const unsigned char* Ga; const unsigned char* Gb; int ldg; bf16_t* O;
    static __device__ __forceinline__ float f8(unsigned w, int i) { return (i == 0) ? __builtin_amdgcn_cvt_f32_fp8((int)w, 0) : (i == 1) ? __builtin_amdgcn_cvt_f32_fp8((int)w, 1) : (i == 2) ? __builtin_amdgcn_cvt_f32_fp8((int)w, 2) : __builtin_amdgcn_cvt_f32_fp8((int)w, 3); }
    __device__ __forceinline__ void mid(f32x4 (&acc)[2][2][4][2], const Unit& u, int wr, int wc, int fr, int fq) const {
        const int row0 = u.pm * BM + wr * 64 + fr, col0 = u.pn * BM + wc * 32 + 8 * fq;
#pragma unroll
        for (int ai = 0; ai < 2; ++ai)
#pragma unroll
            for (int m = 0; m < 4; ++m) { const size_t ro = (size_t)(row0 + ai * HALF + m * 16) * ldg + col0;
#pragma unroll
                for (int bj = 0; bj < 2; ++bj) { const u32x2 a = *(const u32x2*)(Ga + ro + bj * HALF), b = *(const u32x2*)(Gb + ro + bj * HALF);
#pragma unroll
                    for (int e = 0; e < 8; ++e) { const float ga = f8((e < 4) ? a.x : a.y, e & 3), gb = f8((e < 4) ? b.x : b.y, e & 3);
                        acc[ai][bj][m][e >> 2][e & 3] *= (1.f + __expf(-gb)) * __builtin_amdgcn_rcpf(1.f + __expf(-ga)); } } }
    }
    __device__ __forceinline__ void operator()(const f32x4 (&acc)[2][2][4][2], const Unit& u, int wr, int wc, int fr, int fq) const {
        const int row0 = u.pm * BM + wr * 64 + fr, col0 = u.pn * BM + wc * 32 + 8 * fq;
#pragma unroll
        for (int ai = 0; ai < 2; ++ai)
#pragma unroll
            for (int m = 0; m < 4; ++m) { const int row = row0 + ai * HALF + m * 16;
#pragma unroll
                for (int bj = 0; bj < 2; ++bj) { const int col = col0 + bj * HALF;
                    const u32x2 g = *(const u32x2*)(Gb + (size_t)row * ldg + col);
                    const f32x4 a0 = acc[ai][bj][m][0], a1 = acc[ai][bj][m][1];
                    u32x4 w;
                    w.x = cvt_pk_bf16(a0[0] * sigmoidf_(f8(g.x, 0)), a0[1] * sigmoidf_(f8(g.x, 1)));
                    w.y = cvt_pk_bf16(a0[2] * sigmoidf_(f8(g.x, 2)), a0[3] * sigmoidf_(f8(g.x, 3)));
                    w.z = cvt_pk_bf16(a1[0] * sigmoidf_(f8(g.y, 0)), a1[1] * sigmoidf_(f8(g.y, 1)));
                    w.w = cvt_pk_bf16(a1[2] * sigmoidf_(f8(g.y, 2)), a1[3] * sigmoidf_(f8(g.y, 3)));
                    if (F8_OUT) { int lo8 = 0, hi8 = 0;
                        lo8 = __builtin_amdgcn_cvt_pk_fp8_f32(16.f * bflo(w.x), 16.f * bfhi(w.x), lo8, false); lo8 = __builtin_amdgcn_cvt_pk_fp8_f32(16.f * bflo(w.y), 16.f * bfhi(w.y), lo8, true);
                        hi8 = __builtin_amdgcn_cvt_pk_fp8_f32(16.f * bflo(w.z), 16.f * bfhi(w.z), hi8, false); hi8 = __builtin_amdgcn_cvt_pk_fp8_f32(16.f * bflo(w.w), 16.f * bfhi(w.w), hi8, true);
                        u32x2 w8; w8.x = (unsigned)lo8; w8.y = (unsigned)hi8; *(u32x2*)((unsigned char*)O + (size_t)row * DM + col) = w8; }
                    else *(u32x4*)(O + (size_t)row * DM + col) = w; } }
    }
};
template <bool IN_F32> struct EpiResid {
    static constexpr bool PERM = true, AFTER_DRAIN = false, HAS_MID = false;
    const float* XiF; const bf16_t* XiB; bf16_t* Xo; unsigned char* X8;
    __device__ __forceinline__ void operator()(const f32x4 (&acc)[2][2][4][2], const Unit& u, int wr, int wc, int fr, int fq) const {
        const int row0 = u.pm * BM + wr * 64 + fr, col0 = u.pn * BM + wc * 32 + 8 * fq;
#pragma unroll
        for (int ai = 0; ai < 2; ++ai)
#pragma unroll
            for (int m = 0; m < 4; ++m) { const size_t ro = (size_t)(row0 + ai * HALF + m * 16) * DM + col0;
#pragma unroll
                for (int bj = 0; bj < 2; ++bj) { const size_t o = ro + bj * HALF; f32x4 x0, x1;
                    if constexpr (IN_F32) { x0 = *(const f32x4*)(XiF + o); x1 = *(const f32x4*)(XiF + o + 4); }
                    else { const u32x4 xb = *(const u32x4*)(XiB + o); x0[0] = bflo(xb.x); x0[1] = bfhi(xb.x); x0[2] = bflo(xb.y); x0[3] = bfhi(xb.y); x1[0] = bflo(xb.z); x1[1] = bfhi(xb.z); x1[2] = bflo(xb.w); x1[3] = bfhi(xb.w); }
                    x0 += acc[ai][bj][m][0]; x1 += acc[ai][bj][m][1];
                    u32x4 w; w.x = cvt_pk_bf16(x0[0], x0[1]); w.y = cvt_pk_bf16(x0[2], x0[3]); w.z = cvt_pk_bf16(x1[0], x1[1]); w.w = cvt_pk_bf16(x1[2], x1[3]);
                    *(u32x4*)(Xo + o) = w;
                    if (F8_MOE && !I8_UP) { int lo8 = 0, hi8 = 0; lo8 = __builtin_amdgcn_cvt_pk_fp8_f32(x0[0], x0[1], lo8, false); lo8 = __builtin_amdgcn_cvt_pk_fp8_f32(x0[2], x0[3], lo8, true);
                        hi8 = __builtin_amdgcn_cvt_pk_fp8_f32(x1[0], x1[1], hi8, false); hi8 = __builtin_amdgcn_cvt_pk_fp8_f32(x1[2], x1[3], hi8, true);
                        u32x2 w8; w8.x = (unsigned)lo8; w8.y = (unsigned)hi8; *(u32x2*)(X8 + o) = w8; } } }
    }
};
struct MoeOrder {
    int first, stride, limit, nN; const PG8_LAS int* panel_e; const PG8_LAS int* panel_sb;
    __device__ __forceinline__ bool next(int i, Unit& u) const {
        const int L = first + i * stride; if (L >= limit) return false;
        const int p = L / nN, t = L - p * nN; u.pm = p; u.pn = __builtin_amdgcn_readfirstlane(panel_e[p]) * nN + t; u.kq = 0; u.sb = __builtin_amdgcn_readfirstlane(panel_sb[p]); return true; }
    __device__ __forceinline__ void a_ready(const Unit&) const {}
    __device__ __forceinline__ void done(const Unit&) const {}
};
struct EpiSwiGlu {
    static constexpr bool PERM = true, AFTER_DRAIN = false, HAS_MID = false;
    bf16_t* Hd; const int* slot_tok; const float* rstd;
    __device__ __forceinline__ void operator()(const f32x4 (&acc)[2][2][4][2], const Unit& u, int wr, int wc, int fr, int fq) const {
        const int row0 = u.pm * BM + wr * 64 + fr, t = u.pn & 3, j0 = t * 128 + wc * 16 + 4 * fq, s0 = u.sb + wr * 64 + fr;
        int tk[2][4]; float rs[2][4];
#pragma unroll
        for (int ai = 0; ai < 2; ++ai)
#pragma unroll
            for (int m = 0; m < 4; ++m) tk[ai][m] = slot_tok[s0 + ai * HALF + m * 16];
#pragma unroll
        for (int ai = 0; ai < 2; ++ai)
#pragma unroll
            for (int m = 0; m < 4; ++m) rs[ai][m] = (tk[ai][m] >= 0) ? rstd[tk[ai][m] >> 1] : 0.f;
#pragma unroll
        for (int ai = 0; ai < 2; ++ai)
#pragma unroll
            for (int m = 0; m < 4; ++m) { bf16_t* rowp = Hd + (size_t)(row0 + ai * HALF + m * 16) * EH + j0;
#pragma unroll
                for (int bj = 0; bj < 2; ++bj) { f32x4 g, up;
                    if (I8_UP) { const i32x4_ gi = __builtin_bit_cast(i32x4_, acc[ai][bj][m][0]), ui = __builtin_bit_cast(i32x4_, acc[ai][bj][m][1]);
#pragma unroll
                        for (int e = 0; e < 4; ++e) { g[e] = (float)gi[e] * rs[ai][m]; up[e] = (float)ui[e] * rs[ai][m]; } }
                    else { g = acc[ai][bj][m][0] * rs[ai][m]; up = acc[ai][bj][m][1] * rs[ai][m]; }
                    if (F8_MOE) { int p8 = 0; p8 = __builtin_amdgcn_cvt_pk_fp8_f32(8.f * g[0] * sigmoidf_(g[0]) * up[0], 8.f * g[1] * sigmoidf_(g[1]) * up[1], p8, false);
                        p8 = __builtin_amdgcn_cvt_pk_fp8_f32(8.f * g[2] * sigmoidf_(g[2]) * up[2], 8.f * g[3] * sigmoidf_(g[3]) * up[3], p8, true);
                        *(unsigned*)((unsigned char*)Hd + (size_t)(row0 + ai * HALF + m * 16) * EH + j0 + bj * 64) = (unsigned)p8; }
                    else { u32x2 w; w.x = cvt_pk_bf16(g[0] * sigmoidf_(g[0]) * up[0], g[1] * sigmoidf_(g[1]) * up[1]); w.y = cvt_pk_bf16(g[2] * sigmoidf_(g[2]) * up[2], g[3] * sigmoidf_(g[3]) * up[3]);
                    *(u32x2*)(rowp + bj * 64) = w; } } }
    }
};
struct EpiMoeDown {
    static constexpr bool PERM = true, AFTER_DRAIN = false, HAS_MID = false;
    bf16_t* Out; const int* slot_tok; const float* slot_w;
    __device__ __forceinline__ void operator()(const f32x4 (&acc)[2][2][4][2], const Unit& u, int wr, int wc, int fr, int fq) const {
        const int row0 = u.sb + wr * 64 + fr, col0 = (u.pn & 7) * BM + wc * 32 + 8 * fq;
        int tk[2][4]; float wv[2][4];
#pragma unroll
        for (int ai = 0; ai < 2; ++ai)
#pragma unroll
            for (int m = 0; m < 4; ++m) { const int slot = row0 + ai * HALF + m * 16; tk[ai][m] = slot_tok[slot]; wv[ai][m] = slot_w[slot]; }
#pragma unroll
        for (int ai = 0; ai < 2; ++ai)
#pragma unroll
            for (int m = 0; m < 4; ++m) { const int t = tk[ai][m]; const float w = wv[ai][m];
                if (t >= 0) { bf16_t* rowp = Out + ((size_t)(t & 1) * NTOK + (size_t)(t >> 1)) * DM + col0;
#pragma unroll
                    for (int bj = 0; bj < 2; ++bj) { const f32x4 v0 = acc[ai][bj][m][0] * w, v1 = acc[ai][bj][m][1] * w;
                        u32x4 o; o.x = cvt_pk_bf16(v0[0], v0[1]); o.y = cvt_pk_bf16(v0[2], v0[3]); o.z = cvt_pk_bf16(v1[0], v1[1]); o.w = cvt_pk_bf16(v1[2], v1[3]);
                        __builtin_nontemporal_store(o, (u32x4*)(rowp + bj * HALF)); } } }
    }
};
}

constexpr int KS_STRIDE = 72;
constexpr int VT_STRIDE = 260;
constexpr int ATT_KS_OFF = 0, ATT_VT_OFF = 256 * KS_STRIDE * 2;
__device__ __forceinline__ void attn_phase(const Frame& F, const In& I, int l) {
    const bf16* proj = (const bf16*)(F.ws + WS_PROJ); bf16* attn = (bf16*)(F.ws + WS_AY);
    LAS bf16* Ks = (LAS bf16*)(F.lds + ATT_KS_OFF); LAS bf16* Vt = (LAS bf16*)(F.lds + ATT_VT_OFF);
    const int lane = F.lane, r32 = lane & 31, h = lane >> 5;
    for (int u = F.vcu; u < 256; u += F.G) {
        const int kvh = u & 3, n = (u >> 2) & 31, b = u >> 7;
#pragma unroll
        for (int i = 0; i < 4; ++i) { const int c = F.tid + 512 * i, key = c >> 3, ch = c & 7;
            int s = 128 * (n - 1) + key; if (s < 0) s = 0;
            const bf16* rowp = proj + (size_t)(b * SEQ + s) * INP;
            const v4u kv = *(const GAS v4u*)(rowp + C_K + kvh * 64 + ch * 8);
            const v4u vv = *(const GAS v4u*)(rowp + C_V + kvh * 64 + ch * 8);
            *(LAS v4u*)(Ks + key * KS_STRIDE + ch * 8) = kv;
            LAS bf16* vp = Vt + (ch * 8) * VT_STRIDE + key;
            vp[0 * VT_STRIDE] = (bf16)(vv.x & 0xffff); vp[1 * VT_STRIDE] = (bf16)(vv.x >> 16); vp[2 * VT_STRIDE] = (bf16)(vv.y & 0xffff); vp[3 * VT_STRIDE] = (bf16)(vv.y >> 16);
            vp[4 * VT_STRIDE] = (bf16)(vv.z & 0xffff); vp[5 * VT_STRIDE] = (bf16)(vv.z >> 16); vp[6 * VT_STRIDE] = (bf16)(vv.w & 0xffff); vp[7 * VT_STRIDE] = (bf16)(vv.w >> 16); }
        __syncthreads();
        const int g = F.wave & 3, half = F.wave >> 2, hq = kvh * 4 + g;
        const float slope2 = exp2f(-0.5f * (float)(hq + 1)) * LOG2E;
        const float sink2 = I.sinks[l * 16 + hq] * LOG2E;
#pragma unroll 1
        for (int qt = 0; qt < 2; ++qt) {
            const int qrel = 64 * half + 32 * qt;
            const int tpos = 128 * n + qrel + r32;
            const bf16* qp = proj + (size_t)(b * SEQ + tpos) * INP + C_Q + hq * 64 + h * 8;
            bf16x8 qf[4];
#pragma unroll
            for (int ks = 0; ks < 4; ++ks) qf[ks] = *(const GAS bf16x8*)(qp + ks * 16);
            float mx = sink2, lsum = 0.f;
            f32x16 o0, o1;
#pragma unroll
            for (int i = 0; i < 16; ++i) { o0[i] = 0.f; o1[i] = 0.f; }
#pragma unroll 1
            for (int j = 0; j < 5; ++j) {
                f32x16 a;
#pragma unroll
                for (int i = 0; i < 16; ++i) a[i] = 0.f;
#pragma unroll
                for (int ks = 0; ks < 4; ++ks) { const bf16x8 kf = *(const LAS bf16x8*)(Ks + (qrel + 32 * j + r32) * KS_STRIDE + ks * 16 + h * 8);
                    a = __builtin_amdgcn_mfma_f32_32x32x16_bf16(kf, qf[ks], a, 0, 0, 0); }
                float tm = -1e30f;
#pragma unroll
                for (int i = 0; i < 16; ++i) { const int row = (i & 3) + 8 * (i >> 2) + 4 * h;
                    const int dist = r32 + 128 - 32 * j - row;
                    const int spos = tpos - dist;
                    const bool ok = (dist >= 0) && (dist < 128) && (spos >= 0);
                    const float v = ok ? (a[i] * (0.125f * LOG2E) - slope2 * (float)dist) : -1e30f;
                    a[i] = v; tm = fmaxf(tm, v); }
                tm = fmaxf(tm, __shfl_xor(tm, 32));
                const float mn = fmaxf(mx, tm), alpha = exp2f(mx - mn); mx = mn;
                lsum *= alpha;
#pragma unroll
                for (int i = 0; i < 16; ++i) { o0[i] *= alpha; o1[i] *= alpha; }
#pragma unroll
                for (int i = 0; i < 16; ++i) { const float p = exp2f(a[i] - mx); a[i] = p; lsum += p; }
#pragma unroll
                for (int s = 0; s < 2; ++s) {
                    bf16x8 pf; { v4u w; w.x = pk2(a[8 * s + 0], a[8 * s + 1]); w.y = pk2(a[8 * s + 2], a[8 * s + 3]); w.z = pk2(a[8 * s + 4], a[8 * s + 5]); w.w = pk2(a[8 * s + 6], a[8 * s + 7]); pf = __builtin_bit_cast(bf16x8, w); }
                    const int kb = qrel + 32 * j + 16 * s + 4 * h;
                    { const LAS bf16* vp = Vt + r32 * VT_STRIDE + kb; const v2u lo = *(const LAS v2u*)vp, hi = *(const LAS v2u*)(vp + 8);
                      v4u w; w.x = lo.x; w.y = lo.y; w.z = hi.x; w.w = hi.y; o0 = __builtin_amdgcn_mfma_f32_32x32x16_bf16(__builtin_bit_cast(bf16x8, w), pf, o0, 0, 0, 0); }
                    { const LAS bf16* vp = Vt + (32 + r32) * VT_STRIDE + kb; const v2u lo = *(const LAS v2u*)vp, hi = *(const LAS v2u*)(vp + 8);
                      v4u w; w.x = lo.x; w.y = lo.y; w.z = hi.x; w.w = hi.y; o1 = __builtin_amdgcn_mfma_f32_32x32x16_bf16(__builtin_bit_cast(bf16x8, w), pf, o1, 0, 0, 0); }
                }
            }
            lsum += __shfl_xor(lsum, 32);
            const float inv = rcpf_(lsum + exp2f(sink2 - mx));
            bf16* op = attn + (size_t)(b * SEQ + tpos) * 2048 + hq * 64 + 4 * h;
#pragma unroll
            for (int gi = 0; gi < 4; ++gi) {
                if (F8_MRG) { GAS unsigned char* op8 = (GAS unsigned char*)attn + (size_t)(b * SEQ + tpos) * 2048 + hq * 64 + 4 * h; const float i16 = 16.f * inv;
                    int p0 = 0, p1 = 0; p0 = __builtin_amdgcn_cvt_pk_fp8_f32(o0[4 * gi + 0] * i16, o0[4 * gi + 1] * i16, p0, false); p0 = __builtin_amdgcn_cvt_pk_fp8_f32(o0[4 * gi + 2] * i16, o0[4 * gi + 3] * i16, p0, true);
                    p1 = __builtin_amdgcn_cvt_pk_fp8_f32(o1[4 * gi + 0] * i16, o1[4 * gi + 1] * i16, p1, false); p1 = __builtin_amdgcn_cvt_pk_fp8_f32(o1[4 * gi + 2] * i16, o1[4 * gi + 3] * i16, p1, true);
                    *(GAS unsigned*)(op8 + 8 * gi) = (unsigned)p0; *(GAS unsigned*)(op8 + 32 + 8 * gi) = (unsigned)p1; }
                else {
                v2u w0; w0.x = pk2(o0[4 * gi + 0] * inv, o0[4 * gi + 1] * inv); w0.y = pk2(o0[4 * gi + 2] * inv, o0[4 * gi + 3] * inv); *(GAS v2u*)(op + 8 * gi) = w0;
                v2u w1; w1.x = pk2(o1[4 * gi + 0] * inv, o1[4 * gi + 1] * inv); w1.y = pk2(o1[4 * gi + 2] * inv, o1[4 * gi + 3] * inv); *(GAS v2u*)(op + 32 + 8 * gi) = w1; } }
        }
        __syncthreads();
    }
}

constexpr int ACT_STRIDE = 328;
__device__ __forceinline__ float lerp_bf(unsigned cur, unsigned prv, float mix, bool hi) {
    const float c = hi ? bfhi(cur) : bflo(cur), p = hi ? bfhi(prv) : bflo(prv); return c + (p - c) * mix; }
__device__ __forceinline__ f32x4 lerp4(const bf16* cur, const bf16* prv, bool has_prev, const float* mix) {
    const v2u c = *(const GAS v2u*)cur; v2u p = (v2u){0u, 0u}; if (has_prev) p = *(const GAS v2u*)prv; const f32x4 m = *(const GAS f32x4*)mix;
    f32x4 o; o[0] = lerp_bf(c.x, p.x, m[0], false); o[1] = lerp_bf(c.x, p.x, m[1], true); o[2] = lerp_bf(c.y, p.y, m[2], false); o[3] = lerp_bf(c.y, p.y, m[3], true); return o; }
__device__ __forceinline__ void prep_phase(const Frame& F, const In& I, int l) {
    const bf16* proj = (const bf16*)(F.ws + WS_PROJ);
    const bf16* lw = (const bf16*)(F.ws + WS_LORA);
    float* SC = (float*)(F.ws + WS_SCAN); float* Gout = (float*)(F.ws + WS_G); float* VF = (float*)(F.ws + WS_VFIRST);
    LAS bf16* act = (LAS bf16*)F.lds;
    const float* mixz = I.shift_mix + (size_t)l * ZW;
    const int lane = F.lane, tl = lane & 15, q4 = lane >> 4;
    for (int u = F.vcu; u < NTOK / 32; u += F.G) {
        const int tok0 = u * 32;
        for (int idx = F.tid; idx < 32 * 160; idx += NTHR) { const int t = idx / 160, c = (idx - t * 160) * 2; const int tok = tok0 + t; const bool hp = (tok & (SEQ - 1)) != 0;
            float v0 = 0.f, v1 = 0.f;
            if (c < 288 || l == 1) {
                const int col = (c < 288) ? (C_Z + 3072 + c) : (C_ZV + (c - 288));
                const float* mp = (c < 288) ? (mixz + 3072 + c) : (I.vres_mix + (c - 288));
                const unsigned cu = *(const GAS unsigned*)(proj + (size_t)tok * INP + col); unsigned pu = 0u; if (hp) pu = *(const GAS unsigned*)(proj + (size_t)(tok - 1) * INP + col);
                v0 = lerp_bf(cu, pu, mp[0], false); v1 = lerp_bf(cu, pu, mp[1], true);
                if (c < 64) { v0 = tanhf(v0); v1 = tanhf(v1); } else if (c >= 128 && c < 288) { v0 = sigmoidf_(v0); v1 = sigmoidf_(v1); }
            }
            *(LAS unsigned*)(act + t * ACT_STRIDE + c) = pk2(v0, v1); }
        __syncthreads();
#pragma unroll 1
        for (int hh = 0; hh < 2; ++hh) {
            const int H = 2 * F.wave + hh, cb = 64 * H + 4 * q4;
            float inv[2];
#pragma unroll
            for (int mt = 0; mt < 2; ++mt) { const int tok = tok0 + 16 * mt + tl; const bool hp = (tok & (SEQ - 1)) != 0; float ss = 0.f;
#pragma unroll
                for (int rt = 0; rt < 4; ++rt) { const int c = cb + 16 * rt;
                    const f32x4 kr = lerp4(proj + (size_t)tok * INP + C_Z + 1024 + c, proj + (size_t)(tok - 1) * INP + C_Z + 1024 + c, hp, mixz + 1024 + c);
                    const f32x4 kk = kr * *(const GAS f32x4*)(I.k_k + l * 1024 + c); ss += (kk[0] * kk[0] + kk[1] * kk[1]) + (kk[2] * kk[2] + kk[3] * kk[3]); }
                ss += __shfl_xor(ss, 16); ss += __shfl_xor(ss, 32);
                inv[mt] = 1.f / fmaxf(sqrtf(ss), 1e-12f); }
#pragma unroll 1
            for (int rt = 0; rt < 4; ++rt) {
                const int c = cb + 16 * rt;
                const int arow = 64 * H + 16 * rt + tl;
                bf16x8 fw[2], fa[2], fg[5], fv;
#pragma unroll
                for (int ks = 0; ks < 2; ++ks) { fw[ks] = *(const GAS bf16x8*)(lw + LO_WUP + (size_t)arow * 64 + ks * 32 + 8 * q4); fa[ks] = *(const GAS bf16x8*)(lw + LO_AUP + (size_t)arow * 64 + ks * 32 + 8 * q4); }
#pragma unroll
                for (int ks = 0; ks < 5; ++ks) fg[ks] = *(const GAS bf16x8*)(lw + LO_GUP + (size_t)arow * 160 + ks * 32 + 8 * q4);
                if (l == 1) fv = *(const GAS bf16x8*)(lw + LO_VUP + (size_t)arow * 32 + 8 * q4); else fv = (bf16x8){0, 0, 0, 0, 0, 0, 0, 0};
                const f32x4 w0 = *(const GAS f32x4*)(I.w0 + l * 1024 + c), a0 = *(const GAS f32x4*)(I.a0 + l * 1024 + c), kkc = *(const GAS f32x4*)(I.k_k + l * 1024 + c), kac = *(const GAS f32x4*)(I.k_a + l * 1024 + c);
                f32x4 v0c = (f32x4){0.f, 0.f, 0.f, 0.f}; if (l == 1) v0c = *(const GAS f32x4*)(I.vres_v0 + c);
#pragma unroll
                for (int mt = 0; mt < 2; ++mt) {
                    const int tok = tok0 + 16 * mt + tl; const bool hp = (tok & (SEQ - 1)) != 0;
                    const LAS bf16* ap = act + (16 * mt + tl) * ACT_STRIDE + 8 * q4;
                    f32x4 aw = (f32x4){0.f, 0.f, 0.f, 0.f}, aa = aw, ag = aw, av = aw;
#pragma unroll
                    for (int ks = 0; ks < 2; ++ks) { aw = __builtin_amdgcn_mfma_f32_16x16x32_bf16(fw[ks], *(const LAS bf16x8*)(ap + ks * 32), aw, 0, 0, 0);
                                                     aa = __builtin_amdgcn_mfma_f32_16x16x32_bf16(fa[ks], *(const LAS bf16x8*)(ap + 64 + ks * 32), aa, 0, 0, 0); }
#pragma unroll
                    for (int ks = 0; ks < 5; ++ks) ag = __builtin_amdgcn_mfma_f32_16x16x32_bf16(fg[ks], *(const LAS bf16x8*)(ap + 128 + ks * 32), ag, 0, 0, 0);
                    if (l == 1) av = __builtin_amdgcn_mfma_f32_16x16x32_bf16(fv, *(const LAS bf16x8*)(ap + 288), av, 0, 0, 0);
                    const bf16* pc = proj + (size_t)tok * INP + C_Z + c; const bf16* pp = proj + (size_t)(tok - 1) * INP + C_Z + c;
                    const f32x4 r = lerp4(pc, pp, hp, mixz + c), kr = lerp4(pc + 1024, pp + 1024, hp, mixz + 1024 + c), vr = lerp4(pc + 2048, pp + 2048, hp, mixz + 2048 + c);
                    f32x4 dec, a, vv, kkn, k2, bb;
                    const size_t o = (size_t)tok * 1024 + c;
                    f32x4 vf = (f32x4){0.f, 0.f, 0.f, 0.f}; if (l == 1) vf = *(const GAS f32x4*)(VF + o);
#pragma unroll
                    for (int e = 0; e < 4; ++e) {
                        const float xw = -(w0[e] + aw[e]);
                        const float sp = fmaxf(xw, 0.f) + __logf(1.f + __expf(-fabsf(xw)));
                        dec[e] = __expf(-__expf(-sp - 0.5f));
                        a[e] = sigmoidf_(a0[e] + aa[e]);
                        vv[e] = (l == 1) ? (vr[e] + (vf[e] - vr[e]) * sigmoidf_(v0c[e] + av[e])) : vr[e];
                        kkn[e] = kr[e] * kkc[e] * inv[mt];
                        k2[e] = kr[e] * (1.f + (a[e] - 1.f) * kac[e]);
                        bb[e] = kkn[e] * a[e];
                    }
                    *(GAS f32x4*)(SC + 0 * SCAN_STRIDE + o) = r; *(GAS f32x4*)(SC + 1 * SCAN_STRIDE + o) = dec; *(GAS f32x4*)(SC + 2 * SCAN_STRIDE + o) = k2;
                    *(GAS f32x4*)(SC + 3 * SCAN_STRIDE + o) = vv; *(GAS f32x4*)(SC + 4 * SCAN_STRIDE + o) = kkn; *(GAS f32x4*)(SC + 5 * SCAN_STRIDE + o) = bb;
                    *(GAS f32x4*)(Gout + o) = ag;
                    if (l == 0) *(GAS f32x4*)(VF + o) = vr;
                }
            }
        }
        __syncthreads();
    }
}

__device__ __forceinline__ float red16(float v) {
    v += __builtin_bit_cast(float, __builtin_amdgcn_update_dpp(0, __builtin_bit_cast(int, v), 0xB1, 0xF, 0xF, false));
    v += __builtin_bit_cast(float, __builtin_amdgcn_update_dpp(0, __builtin_bit_cast(int, v), 0x4E, 0xF, 0xF, false));
    v += __builtin_bit_cast(float, __builtin_amdgcn_update_dpp(0, __builtin_bit_cast(int, v), 0x141, 0xF, 0xF, false));
    v += __builtin_bit_cast(float, __builtin_amdgcn_update_dpp(0, __builtin_bit_cast(int, v), 0x140, 0xF, 0xF, false));
    return v;
}
struct ScanIn { f32x4 w, kk, b, k, r; float v; };
__device__ __forceinline__ ScanIn scan_load(const float* SC, size_t base, int kq, int row) {
    ScanIn s; const size_t o = base + 4 * kq;
    s.r = *(const GAS f32x4*)(SC + 0 * SCAN_STRIDE + o); s.w = *(const GAS f32x4*)(SC + 1 * SCAN_STRIDE + o); s.k = *(const GAS f32x4*)(SC + 2 * SCAN_STRIDE + o);
    s.kk = *(const GAS f32x4*)(SC + 4 * SCAN_STRIDE + o); s.b = *(const GAS f32x4*)(SC + 5 * SCAN_STRIDE + o); s.v = *(const GAS float*)(SC + 3 * SCAN_STRIDE + base + row); return s; }
__device__ __forceinline__ void scan_phase(const Frame& F) {
    const float* SC = (const float*)(F.ws + WS_SCAN); float* Y = (float*)(F.ws + WS_Y);
    const int lane = F.lane, kq = lane & 15;
    for (int u = F.vcu; u < 64; u += F.G) {
        const int half = u & 1, H = (u >> 1) & 15, b = u >> 5;
        const int row = 32 * half + 4 * F.wave + (lane >> 4);
        const size_t base0 = (size_t)b * SEQ * 1024 + H * 64;
        f32x4 S = (f32x4){0.f, 0.f, 0.f, 0.f};
        ScanIn in0 = scan_load(SC, base0, kq, row), in1 = scan_load(SC, base0 + 1024, kq, row), in2 = scan_load(SC, base0 + 2048, kq, row), in3 = scan_load(SC, base0 + 3072, kq, row);
#define SCAN_STEP(IN, T) do { \
            float p = (S[0] * IN.kk[0] + S[1] * IN.kk[1]) + (S[2] * IN.kk[2] + S[3] * IN.kk[3]); p = red16(p); const float sa = -p; \
            S[0] = S[0] * IN.w[0] + (sa * IN.b[0] + IN.v * IN.k[0]); S[1] = S[1] * IN.w[1] + (sa * IN.b[1] + IN.v * IN.k[1]); \
            S[2] = S[2] * IN.w[2] + (sa * IN.b[2] + IN.v * IN.k[2]); S[3] = S[3] * IN.w[3] + (sa * IN.b[3] + IN.v * IN.k[3]); \
            float y = (S[0] * IN.r[0] + S[1] * IN.r[1]) + (S[2] * IN.r[2] + S[3] * IN.r[3]); y = red16(y); \
            if (kq == 0) Y[base0 + (size_t)(T) * 1024 + row] = y; \
            const int tn = (T) + 4; if (tn < SEQ) IN = scan_load(SC, base0 + (size_t)tn * 1024, kq, row); } while (0)
#pragma unroll 1
        for (int t = 0; t < SEQ; t += 4) { SCAN_STEP(in0, t); SCAN_STEP(in1, t + 1); SCAN_STEP(in2, t + 2); SCAN_STEP(in3, t + 3); }
#undef SCAN_STEP
    }
}

__device__ __forceinline__ void post_phase(const Frame& F, const In& I, int l) {
    const float* SC = (const float*)(F.ws + WS_SCAN); const float* Y = (const float*)(F.ws + WS_Y); const float* Gv = (const float*)(F.ws + WS_G); bf16* YB = (bf16*)(F.ws + WS_YB);
    const int gw = F.vcu * NWAVES + F.wave, NGW = F.G * NWAVES, lane = F.lane;
    for (int p = gw; p < NTOK * 16; p += NGW) {
        const size_t o = (size_t)p * 64 + lane; const int c = (p & 15) * 64 + lane;
        const float y = Y[o], r = SC[o], k = SC[2 * SCAN_STRIDE + o], v = SC[3 * SCAN_STRIDE + o], g = Gv[o];
        const float mu = wave_sum(y) * (1.f / 64.f); const float d = y - mu; const float var = wave_sum(d * d) * (1.f / 64.f);
        const float rk = wave_sum(r * k * I.r_k[l * 1024 + c]);
        const float yn = d * (__builtin_amdgcn_rsqf(var + GN_EPS)) * I.ln_w[l * 1024 + c] + I.ln_b[l * 1024 + c];
        YB[o] = (bf16)f2bf((yn + rk * v) * g);
    }
}

typedef short s16x4_t __attribute__((ext_vector_type(4)));
constexpr int CS = 72;
constexpr int L_At = 0, L_Rt = 9216, L_Bt = 18432, L_Kt = 27648, L_BT = 36864, L_KT = 46080, L_VT = 55296, L_NLab = 64512, L_Lak = 73728, L_Mrb = 82944, L_Mrk = 92160,
              L_G = 101376, L_Ld = 117760, L_Tbb = 121856, L_SEG = 123904;
static_assert(L_SEG + 2048 <= RING_BYTES, "scanA LDS");
constexpr size_t WS_PF = WS_TMP, WS_RWF = WS_TMP + 16 * MiB, WS_QF = WS_TMP + 32 * MiB, WS_Y0F = WS_TMP + 64 * MiB;
constexpr size_t WS_S0F = WS_H, WS_RK = WS_H + 16 * MiB;
static_assert(WS_Y0F + 32 * MiB <= WS_ROUTE, "scan scratch");
__device__ __forceinline__ s16x4_t pk4(float a, float b, float c, float d) { v2u w; w.x = pk2(a, b); w.y = pk2(c, d); return __builtin_bit_cast(s16x4_t, w); }
__device__ __forceinline__ f32x4 mfma16(s16x4_t a, s16x4_t b, f32x4 c) { return __builtin_amdgcn_mfma_f32_16x16x16bf16_1k(a, b, c, 0, 0, 0); }
__device__ __forceinline__ s16x4_t lds4(const LAS bf16* p) { return *(const LAS s16x4_t*)p; }

__device__ __forceinline__ void scanA_phase(const Frame& F, const In& I, int l) {
    const float* SC = (const float*)(F.ws + WS_SCAN);
    LAS unsigned char* L = F.lds;
    LAS bf16* At = (LAS bf16*)(L + L_At); LAS bf16* Rt = (LAS bf16*)(L + L_Rt); LAS bf16* Bt = (LAS bf16*)(L + L_Bt); LAS bf16* Kt = (LAS bf16*)(L + L_Kt);
    LAS bf16* BT = (LAS bf16*)(L + L_BT); LAS bf16* KT = (LAS bf16*)(L + L_KT); LAS bf16* VT = (LAS bf16*)(L + L_VT);
    LAS bf16* NLab = (LAS bf16*)(L + L_NLab); LAS bf16* Lak = (LAS bf16*)(L + L_Lak); LAS bf16* Mrb = (LAS bf16*)(L + L_Mrb); LAS bf16* Mrk = (LAS bf16*)(L + L_Mrk);
    LAS float* Gs = (LAS float*)(L + L_G); LAS float* Ld = (LAS float*)(L + L_Ld); LAS bf16* Tbb = (LAS bf16*)(L + L_Tbb); LAS float* SEG = (LAS float*)(L + L_SEG);
    const int lane = F.lane, w = F.wave, c16 = lane & 15, q = lane >> 4;
    for (int u = F.vcu; u < 2048; u += F.G) {
        const int c = u & 63, H = (u >> 6) & 15, b = u >> 10;
        const size_t base = ((size_t)(b * SEQ + c * 64)) * 1024 + H * 64;
        { float loc[8]; float p = 1.f;
#pragma unroll
          for (int i = 0; i < 8; ++i) { p *= SC[1 * SCAN_STRIDE + base + (size_t)(8 * w + i) * 1024 + lane]; loc[i] = p; }
          SEG[w * 64 + lane] = p;
          __syncthreads();
          float pre = 1.f;
          for (int s = 0; s < w; ++s) pre *= SEG[s * 64 + lane];
#pragma unroll
          for (int i = 0; i < 8; ++i) Gs[(8 * w + i) * 64 + lane] = loc[i] * pre; }
        __syncthreads();
#pragma unroll
        for (int it = 0; it < 2; ++it) { const int item = F.tid + 512 * it, t = item >> 4, kq = item & 15; const size_t o = base + (size_t)t * 1024 + 4 * kq;
            const f32x4 r4 = *(const GAS f32x4*)(SC + o), k4 = *(const GAS f32x4*)(SC + 2 * SCAN_STRIDE + o), v4 = *(const GAS f32x4*)(SC + 3 * SCAN_STRIDE + o),
                        a4 = *(const GAS f32x4*)(SC + 4 * SCAN_STRIDE + o), b4 = *(const GAS f32x4*)(SC + 5 * SCAN_STRIDE + o);
            const f32x4 g4 = *(const LAS f32x4*)(Gs + t * 64 + 4 * kq); f32x4 gp4 = (f32x4){1.f, 1.f, 1.f, 1.f}; if (t > 0) gp4 = *(const LAS f32x4*)(Gs + (t - 1) * 64 + 4 * kq);
            const f32x4 rk4 = *(const GAS f32x4*)(I.r_k + l * 1024 + H * 64 + 4 * kq);
            f32x4 ig; ig[0] = rcpf_(g4[0]); ig[1] = rcpf_(g4[1]); ig[2] = rcpf_(g4[2]); ig[3] = rcpf_(g4[3]);
            const f32x4 at = a4 * gp4, bt = b4 * ig, kt = k4 * ig, rt = r4 * g4;
            *(LAS s16x4_t*)(At + t * CS + 4 * kq) = pk4(at[0], at[1], at[2], at[3]); *(LAS s16x4_t*)(Rt + t * CS + 4 * kq) = pk4(rt[0], rt[1], rt[2], rt[3]);
            *(LAS s16x4_t*)(Bt + t * CS + 4 * kq) = pk4(bt[0], bt[1], bt[2], bt[3]); *(LAS s16x4_t*)(Kt + t * CS + 4 * kq) = pk4(kt[0], kt[1], kt[2], kt[3]);
#pragma unroll
            for (int e = 0; e < 4; ++e) { BT[(4 * kq + e) * CS + t] = (bf16)f2bf(bt[e]); KT[(4 * kq + e) * CS + t] = (bf16)f2bf(kt[e]); VT[(4 * kq + e) * CS + t] = (bf16)f2bf(v4[e]); }
            float rk = (r4[0] * k4[0] * rk4[0] + r4[1] * k4[1] * rk4[1]) + (r4[2] * k4[2] * rk4[2] + r4[3] * k4[3] * rk4[3]);
            rk = red16(rk);
            if (kq == 0) ((float*)(F.ws + WS_RK))[(size_t)u * 64 + t] = rk; }
        __syncthreads();
        { const int tt = w & 3; const LAS bf16* Arow = ((w < 4) ? At : Rt) + (16 * tt + c16) * CS + 4 * q;
          s16x4_t af[4];
#pragma unroll
          for (int ks = 0; ks < 4; ++ks) af[ks] = lds4(Arow + 16 * ks);
          for (int jt = 0; jt <= tt; ++jt) {
#pragma unroll
              for (int which = 0; which < 2; ++which) {
                  const LAS bf16* Brow = (which ? Kt : Bt) + (16 * jt + c16) * CS + 4 * q;
                  f32x4 acc = (f32x4){0.f, 0.f, 0.f, 0.f};
#pragma unroll
                  for (int ks = 0; ks < 4; ++ks) acc = mfma16(af[ks], lds4(Brow + 16 * ks), acc);
                  LAS bf16* dst = (w < 4) ? (which ? Lak : NLab) : (which ? Mrk : Mrb);
#pragma unroll
                  for (int e = 0; e < 4; ++e) { const int t = 16 * tt + 4 * q + e, j = 16 * jt + c16;
                      const bool keep = (w < 4) ? (j < t) : (j <= t); float v = keep ? acc[e] : 0.f;
                      if (w < 4 && which == 0) { if (jt == tt) Ld[(tt * 16 + c16) * 16 + 4 * q + e] = v; v = -v; }
                      dst[t * CS + j] = (bf16)f2bf(v); } } } }
        __syncthreads();
        if (w == 0) { float s[16]; const LAS float* Lb = Ld + q * 256;
#pragma unroll
            for (int i = 0; i < 16; ++i) s[i] = (i == c16) ? 1.f : 0.f;
#pragma unroll
            for (int j = 0; j < 16; ++j) { const float Tj = s[j]; Tbb[(q * 16 + j) * 16 + c16] = (bf16)f2bf(Tj);
#pragma unroll
                for (int ci = (j + 1) / 4; ci < 4; ++ci) { const f32x4 lc = *(const LAS f32x4*)(Lb + j * 16 + 4 * ci);
#pragma unroll
                    for (int e = 0; e < 4; ++e) if (4 * ci + e > j) s[4 * ci + e] -= lc[e] * Tj; } } }
        f32x4 X[4]; s16x4_t vB[4];
        if (w < 4) {
#pragma unroll
            for (int bb = 0; bb < 4; ++bb)
#pragma unroll
                for (int e = 0; e < 4; ++e) X[bb][e] = bflo((unsigned)At[(16 * bb + 4 * q + e) * CS + 16 * w + c16]);
#pragma unroll
            for (int bb = 0; bb < 4; ++bb) vB[bb] = (s16x4_t){0, 0, 0, 0};
        } else {
#pragma unroll
            for (int bb = 0; bb < 4; ++bb) vB[bb] = lds4(VT + (16 * (w - 4) + c16) * CS + 16 * bb + 4 * q);
#pragma unroll
            for (int bb = 0; bb < 4; ++bb) { f32x4 acc = (f32x4){0.f, 0.f, 0.f, 0.f};
#pragma unroll
                for (int jb = 0; jb <= bb; ++jb) acc = mfma16(lds4(Lak + (16 * bb + c16) * CS + 16 * jb + 4 * q), vB[jb], acc);
                X[bb] = acc; }
        }
        __syncthreads();
        s16x4_t XB[4];
#pragma unroll
        for (int bb = 0; bb < 4; ++bb) {
            f32x4 r = X[bb];
#pragma unroll
            for (int jb = 0; jb < bb; ++jb) r = mfma16(lds4(NLab + (16 * bb + c16) * CS + 16 * jb + 4 * q), pk4(X[jb][0], X[jb][1], X[jb][2], X[jb][3]), r);
            const f32x4 z = (f32x4){0.f, 0.f, 0.f, 0.f};
            X[bb] = mfma16(lds4(Tbb + (bb * 16 + c16) * 16 + 4 * q), pk4(r[0], r[1], r[2], r[3]), z);
        }
#pragma unroll
        for (int bb = 0; bb < 4; ++bb) XB[bb] = pk4(-X[bb][0], -X[bb][1], -X[bb][2], -X[bb][3]);
        if (w < 4) {
            s16x4_t* PF = (s16x4_t*)(F.ws + WS_PF) + ((size_t)u * 16 + w * 4) * 64 + lane;
#pragma unroll
            for (int ct = 0; ct < 4; ++ct) { f32x4 acc = (f32x4){0.f, 0.f, 0.f, 0.f};
#pragma unroll
                for (int bb = 0; bb < 4; ++bb) acc = mfma16(XB[bb], lds4(BT + (16 * ct + c16) * CS + 16 * bb + 4 * q), acc);
                const float g63 = Gs[63 * 64 + 16 * ct + c16];
#pragma unroll
                for (int e = 0; e < 4; ++e) acc[e] = (acc[e] + ((ct == w && 4 * q + e == c16) ? 1.f : 0.f)) * g63;
                PF[ct * 64] = pk4(acc[0], acc[1], acc[2], acc[3]); }
            s16x4_t* RWF = (s16x4_t*)(F.ws + WS_RWF) + ((size_t)u * 16 + w) * 64 + lane;
#pragma unroll
            for (int tt = 0; tt < 4; ++tt) { const v2u rr = *(const LAS v2u*)(Rt + (16 * tt + c16) * CS + 16 * w + 4 * q);
                f32x4 acc; acc[0] = bflo(rr.x); acc[1] = bfhi(rr.x); acc[2] = bflo(rr.y); acc[3] = bfhi(rr.y);
#pragma unroll
                for (int bb = 0; bb <= tt; ++bb) acc = mfma16(XB[bb], lds4(Mrb + (16 * tt + c16) * CS + 16 * bb + 4 * q), acc);
                RWF[tt * 4 * 64] = pk4(acc[0], acc[1], acc[2], acc[3]); }
        } else {
            const int vt = w - 4;
            f32x4* QF = (f32x4*)(F.ws + WS_QF) + ((size_t)u * 16 + vt * 4) * 64 + lane;
#pragma unroll
            for (int ct = 0; ct < 4; ++ct) { f32x4 acc = (f32x4){0.f, 0.f, 0.f, 0.f};
#pragma unroll
                for (int bb = 0; bb < 4; ++bb) { acc = mfma16(lds4(BT + (16 * ct + c16) * CS + 16 * bb + 4 * q), XB[bb], acc); acc = mfma16(lds4(KT + (16 * ct + c16) * CS + 16 * bb + 4 * q), vB[bb], acc); }
                const f32x4 g63 = *(const LAS f32x4*)(Gs + 63 * 64 + 16 * ct + 4 * q);
                QF[ct * 64] = acc * g63; }
            f32x4* Y0F = (f32x4*)(F.ws + WS_Y0F) + ((size_t)u * 16 + vt * 4) * 64 + lane;
#pragma unroll
            for (int tt = 0; tt < 4; ++tt) { f32x4 acc = (f32x4){0.f, 0.f, 0.f, 0.f};
#pragma unroll
                for (int bb = 0; bb <= tt; ++bb) { acc = mfma16(lds4(Mrb + (16 * tt + c16) * CS + 16 * bb + 4 * q), XB[bb], acc); acc = mfma16(lds4(Mrk + (16 * tt + c16) * CS + 16 * bb + 4 * q), vB[bb], acc); }
                Y0F[tt * 64] = acc; }
        }
        __syncthreads();
    }
}


constexpr size_t WS_ACT = WS_YB, WS_INVN = WS_YB + 8 * MiB;
__device__ __forceinline__ void acts_phase(const Frame& F, const In& I, int l) {
    const bf16* proj = (const bf16*)(F.ws + WS_PROJ); bf16* ACT = (bf16*)(F.ws + WS_ACT); float* INV = (float*)(F.ws + WS_INVN);
    const float* mixz = I.shift_mix + (size_t)l * ZW;
    for (int u = F.vcu; u < NTOK / 32; u += F.G) {
        const int tok0 = 32 * u;
        { unsigned cu[10], pu[10];
#pragma unroll
          for (int i = 0; i < 10; ++i) { const int idx = F.tid + NTHR * i, t = idx / 160, cc = (idx - t * 160) * 2; const int tok = tok0 + t; const bool hp = (tok & (SEQ - 1)) != 0;
              cu[i] = 0u; pu[i] = 0u;
              if (cc < 288 || l == 1) {
                  const int col = (cc < 288) ? (C_Z + 3072 + cc) : (C_ZV + (cc - 288));
                  cu[i] = *(const GAS unsigned*)(proj + (size_t)tok * INP + col); if (hp) pu[i] = *(const GAS unsigned*)(proj + (size_t)(tok - 1) * INP + col); } }
#pragma unroll
          for (int i = 0; i < 10; ++i) { const int idx = F.tid + NTHR * i, t = idx / 160, cc = (idx - t * 160) * 2;
              float v0 = 0.f, v1 = 0.f;
              if (cc < 288 || l == 1) { const float* mp = (cc < 288) ? (mixz + 3072 + cc) : (I.vres_mix + (cc - 288));
                  v0 = lerp_bf(cu[i], pu[i], mp[0], false); v1 = lerp_bf(cu[i], pu[i], mp[1], true);
                  if (cc < 64) { v0 = tanhf(v0); v1 = tanhf(v1); } else if (cc >= 128 && cc < 288) { v0 = sigmoidf_(v0); v1 = sigmoidf_(v1); } }
              *(GAS unsigned*)(ACT + (size_t)(tok0 + t) * 320 + cc) = pk2(v0, v1); } }
#pragma unroll 4
        for (int it = 0; it < 16; ++it) { const int item = F.tid + NTHR * it, kq = item & 15, hh = (item >> 4) & 15, t = item >> 8; const int tok = tok0 + t; const bool hp = (tok & (SEQ - 1)) != 0; const int ch = 64 * hh + 4 * kq;
            const f32x4 kr = lerp4(proj + (size_t)tok * INP + C_Z + 1024 + ch, proj + (size_t)(tok - 1) * INP + C_Z + 1024 + ch, hp, mixz + 1024 + ch);
            const f32x4 kk = kr * *(const GAS f32x4*)(I.k_k + l * 1024 + ch); float ss = (kk[0] * kk[0] + kk[1] * kk[1]) + (kk[2] * kk[2] + kk[3] * kk[3]);
            ss = red16(ss);
            if (kq == 0) INV[(size_t)tok * 16 + hh] = 1.f / fmaxf(sqrtf(ss), 1e-12f); }
    }
}

__device__ __forceinline__ int chunk_unit(int vcu, int i, int G) {
#ifndef CHUNK_LOCAL
#define CHUNK_LOCAL 0
#endif
    if (!CHUNK_LOCAL || G != 256) return vcu + i * G;
    const int x = vcu >> 5, j = vcu & 31; const int b = x >> 2, cc = 16 * (x & 3) + (j & 15), H = (j >> 4) + 2 * i;
    return (b << 10) | (H << 6) | cc; }
constexpr int L_ACT = 64512;
constexpr int L_G2 = 106496, L_Ld2 = 122880, L_Tbb2 = 126976, L_SEG2 = 129024;
constexpr int L_INVN = LDSCTL_OFF + 4096, L_RKS = LDSCTL_OFF + 4096 + 256, L_GT = LDSCTL_OFF + 6144;
constexpr size_t WS_VGF = WS_G;
static_assert(L_ACT + 64 * ACT_STRIDE * 2 <= L_G2 && L_SEG2 + 2048 <= RING_BYTES && L_RKS + 1024 <= L_GT && L_GT + 64 * CS * 2 <= LDS_BYTES, "chunk LDS");
__device__ __forceinline__ float scan16_mul(float v) {
    v *= __builtin_bit_cast(float, __builtin_amdgcn_update_dpp(0x3f800000, __builtin_bit_cast(int, v), 0x111, 0xF, 0xF, false));
    v *= __builtin_bit_cast(float, __builtin_amdgcn_update_dpp(0x3f800000, __builtin_bit_cast(int, v), 0x112, 0xF, 0xF, false));
    v *= __builtin_bit_cast(float, __builtin_amdgcn_update_dpp(0x3f800000, __builtin_bit_cast(int, v), 0x114, 0xF, 0xF, false));
    v *= __builtin_bit_cast(float, __builtin_amdgcn_update_dpp(0x3f800000, __builtin_bit_cast(int, v), 0x118, 0xF, 0xF, false));
    return v; }
__device__ __forceinline__ void chunk_phase(const Frame& F, const In& I, int l) {
    const bf16* proj = (const bf16*)(F.ws + WS_PROJ); const bf16* lw = (const bf16*)(F.ws + WS_LORA);
    bf16* VF = (bf16*)(F.ws + WS_VFIRST);
    LAS unsigned char* L = F.lds;
    LAS bf16* At = (LAS bf16*)(L + L_At); LAS bf16* Rt = (LAS bf16*)(L + L_Rt); LAS bf16* Bt = (LAS bf16*)(L + L_Bt); LAS bf16* Kt = (LAS bf16*)(L + L_Kt);
    LAS bf16* BT = (LAS bf16*)(L + L_BT); LAS bf16* KT = (LAS bf16*)(L + L_KT); LAS bf16* VT = (LAS bf16*)(L + L_VT);
    LAS bf16* NLab = (LAS bf16*)(L + L_NLab); LAS bf16* Lak = (LAS bf16*)(L + L_Lak); LAS bf16* Mrb = (LAS bf16*)(L + L_Mrb); LAS bf16* Mrk = (LAS bf16*)(L + L_Mrk);
    LAS float* Gs = (LAS float*)(L + L_G2); LAS float* Ld = (LAS float*)(L + L_Ld2); LAS bf16* Tbb = (LAS bf16*)(L + L_Tbb2); LAS float* SEG = (LAS float*)(L + L_SEG2);
    LAS float* RKS = (LAS float*)(L + L_RKS); LAS bf16* GT = (LAS bf16*)(L + L_GT); LAS bf16* act = (LAS bf16*)(L + L_ACT); const bf16* ACT = (const bf16*)(F.ws + WS_ACT); const float* INV = (const float*)(F.ws + WS_INVN);
    const float* mixz = I.shift_mix + (size_t)l * ZW;
    const int lane = F.lane, w = F.wave, c16 = lane & 15, q = lane >> 4;
    for (int it = 0; it * F.G < 2048; ++it) { const int u = chunk_unit(F.vcu, it, F.G); if (u >= 2048) break;
        const int c = u & 63, H = (u >> 6) & 15, b = u >> 10;
        const int tok0 = b * SEQ + c * 64;
        const bool hp0 = (c != 0);
        f32x4 rr[2], kn[2], k2r[2], bbr[2], dcv[2];
        { const int rt = w & 3, chl = 16 * rt + 4 * q, ch = 64 * H + chl;
          const int arow = 64 * H + 16 * rt + c16;
          v4u ac[5];
#pragma unroll
          for (int i = 0; i < 5; ++i) ac[i] = *(const GAS v4u*)(ACT + (size_t)(tok0 + (F.tid >> 3)) * 320 + ((F.tid & 7) + 8 * i) * 8);
          bf16x8 fw[2], fa[2], fg[5], fv;
#pragma unroll
          for (int ks = 0; ks < 2; ++ks) { fw[ks] = *(const GAS bf16x8*)(lw + LO_WUP + (size_t)arow * 64 + ks * 32 + 8 * q); fa[ks] = *(const GAS bf16x8*)(lw + LO_AUP + (size_t)arow * 64 + ks * 32 + 8 * q); }
#pragma unroll
          for (int ks = 0; ks < 5; ++ks) fg[ks] = *(const GAS bf16x8*)(lw + LO_GUP + (size_t)arow * 160 + ks * 32 + 8 * q);
          if (l == 1) fv = *(const GAS bf16x8*)(lw + LO_VUP + (size_t)arow * 32 + 8 * q); else fv = (bf16x8){0, 0, 0, 0, 0, 0, 0, 0};
          v2u zc[2][3], zp[2][3]; f32x4 vfv[2]; float invv[2];
#pragma unroll
          for (int mi = 0; mi < 2; ++mi) { const int t = 16 * (2 * (w >> 2) + mi) + c16, tok = tok0 + t; const bool hp = hp0 || (t != 0);
              const bf16* pc = proj + (size_t)tok * INP + C_Z + ch; const bf16* pp = proj + (size_t)(tok - 1) * INP + C_Z + ch;
#pragma unroll
              for (int j = 0; j < 3; ++j) { zc[mi][j] = *(const GAS v2u*)(pc + 1024 * j); zp[mi][j] = (v2u){0u, 0u}; if (hp) zp[mi][j] = *(const GAS v2u*)(pp + 1024 * j); }
              vfv[mi] = (f32x4){0.f, 0.f, 0.f, 0.f}; if (l == 1) { const v2u vb_ = *(const GAS v2u*)(VF + (size_t)tok * 1024 + ch); vfv[mi][0] = bflo(vb_.x); vfv[mi][1] = bfhi(vb_.x); vfv[mi][2] = bflo(vb_.y); vfv[mi][3] = bfhi(vb_.y); }
              invv[mi] = INV[(size_t)tok * 16 + H]; }
#pragma unroll
          for (int i = 0; i < 5; ++i) *(LAS v4u*)(act + (F.tid >> 3) * ACT_STRIDE + ((F.tid & 7) + 8 * i) * 8) = ac[i];
          __syncthreads();
          const f32x4 w0 = *(const GAS f32x4*)(I.w0 + l * 1024 + ch), a0 = *(const GAS f32x4*)(I.a0 + l * 1024 + ch), kkc = *(const GAS f32x4*)(I.k_k + l * 1024 + ch), kac = *(const GAS f32x4*)(I.k_a + l * 1024 + ch);
          const f32x4 rkc = *(const GAS f32x4*)(I.r_k + l * 1024 + ch);
          f32x4 v0c = (f32x4){0.f, 0.f, 0.f, 0.f}; if (l == 1) v0c = *(const GAS f32x4*)(I.vres_v0 + ch);
          const f32x4 mxr = *(const GAS f32x4*)(mixz + ch), mxk = *(const GAS f32x4*)(mixz + 1024 + ch), mxv = *(const GAS f32x4*)(mixz + 2048 + ch);
#pragma unroll
          for (int mi = 0; mi < 2; ++mi) {
              const int mt = 2 * (w >> 2) + mi, t = 16 * mt + c16, tok = tok0 + t;
              const LAS bf16* ap = act + t * ACT_STRIDE + 8 * q;
              f32x4 aw = (f32x4){0.f, 0.f, 0.f, 0.f}, aa = aw, ag = aw, av = aw;
#pragma unroll
              for (int ks = 0; ks < 2; ++ks) { aw = __builtin_amdgcn_mfma_f32_16x16x32_bf16(fw[ks], *(const LAS bf16x8*)(ap + ks * 32), aw, 0, 0, 0);
                                               aa = __builtin_amdgcn_mfma_f32_16x16x32_bf16(fa[ks], *(const LAS bf16x8*)(ap + 64 + ks * 32), aa, 0, 0, 0); }
#pragma unroll
              for (int ks = 0; ks < 5; ++ks) ag = __builtin_amdgcn_mfma_f32_16x16x32_bf16(fg[ks], *(const LAS bf16x8*)(ap + 128 + ks * 32), ag, 0, 0, 0);
              if (l == 1) av = __builtin_amdgcn_mfma_f32_16x16x32_bf16(fv, *(const LAS bf16x8*)(ap + 288), av, 0, 0, 0);
              f32x4 r, kr, vr;
              { const v2u* C = zc[mi]; const v2u* P = zp[mi];
                r[0] = lerp_bf(C[0].x, P[0].x, mxr[0], false); r[1] = lerp_bf(C[0].x, P[0].x, mxr[1], true); r[2] = lerp_bf(C[0].y, P[0].y, mxr[2], false); r[3] = lerp_bf(C[0].y, P[0].y, mxr[3], true);
                kr[0] = lerp_bf(C[1].x, P[1].x, mxk[0], false); kr[1] = lerp_bf(C[1].x, P[1].x, mxk[1], true); kr[2] = lerp_bf(C[1].y, P[1].y, mxk[2], false); kr[3] = lerp_bf(C[1].y, P[1].y, mxk[3], true);
                vr[0] = lerp_bf(C[2].x, P[2].x, mxv[0], false); vr[1] = lerp_bf(C[2].x, P[2].x, mxv[1], true); vr[2] = lerp_bf(C[2].y, P[2].y, mxv[2], false); vr[3] = lerp_bf(C[2].y, P[2].y, mxv[3], true); }
              const size_t o = (size_t)tok * 1024 + ch;
              const f32x4 vf = vfv[mi];
              const float invn = invv[mi];
              f32x4 dec, vv; float rkp = 0.f;
#pragma unroll
              for (int e = 0; e < 4; ++e) {
                  const float xw = -(w0[e] + aw[e]);
                  const float sp = fmaxf(xw, 0.f) + __logf(1.f + __expf(-fabsf(xw)));
                  dec[e] = __expf(-__expf(-sp - 0.5f));
                  const float a = sigmoidf_(a0[e] + aa[e]);
                  vv[e] = (l == 1) ? (vr[e] + (vf[e] - vr[e]) * sigmoidf_(v0c[e] + av[e])) : vr[e];
                  kn[mi][e] = kr[e] * kkc[e] * invn;
                  k2r[mi][e] = kr[e] * (1.f + (a - 1.f) * kac[e]);
                  bbr[mi][e] = kn[mi][e] * a;
                  rkp += r[e] * k2r[mi][e] * rkc[e];
              }
              rr[mi] = r;
              dcv[mi] = dec;
#pragma unroll
              for (int e = 0; e < 4; ++e) { VT[(chl + e) * CS + t] = (bf16)f2bf(vv[e]); GT[(chl + e) * CS + t] = (bf16)f2bf(ag[e]); }
              if (l == 0) { v2u vb_; vb_.x = pk2(vr[0], vr[1]); vb_.y = pk2(vr[2], vr[3]); *(GAS v2u*)(VF + o) = vb_; }
              rkp += __shfl_xor(rkp, 16); rkp += __shfl_xor(rkp, 32);
              if (q == 0) RKS[rt * 64 + t] = rkp;
          } }
        f32x4 G[2];
        { const int rt = w & 3, chl = 16 * rt + 4 * q;
          LAS float* TOT = SEG; LAS float* G63 = SEG + 64;
#pragma unroll
          for (int mi = 0; mi < 2; ++mi)
#pragma unroll
              for (int e = 0; e < 4; ++e) G[mi][e] = scan16_mul(dcv[mi][e]);
#pragma unroll
          for (int e = 0; e < 4; ++e) G[1][e] *= __shfl(G[0][e], (lane & 48) | 15);
          if (w < 4 && c16 == 15) *(LAS f32x4*)(TOT + chl) = G[1];
          __syncthreads();
          if (w >= 4) { const f32x4 tq = *(const LAS f32x4*)(TOT + chl); G[0] *= tq; G[1] *= tq; if (c16 == 15) *(LAS f32x4*)(G63 + chl) = G[1]; }
#pragma unroll
          for (int mi = 0; mi < 2; ++mi) { const int t = 16 * (2 * (w >> 2) + mi) + c16;
              const f32x4 g4 = G[mi];
              f32x4 ig; ig[0] = rcpf_(g4[0]); ig[1] = rcpf_(g4[1]); ig[2] = rcpf_(g4[2]); ig[3] = rcpf_(g4[3]);
              f32x4 gp4; gp4[0] = g4[0] * rcpf_(dcv[mi][0]); gp4[1] = g4[1] * rcpf_(dcv[mi][1]); gp4[2] = g4[2] * rcpf_(dcv[mi][2]); gp4[3] = g4[3] * rcpf_(dcv[mi][3]);
              const f32x4 at = kn[mi] * gp4, bt = bbr[mi] * ig, kt = k2r[mi] * ig, rt_ = rr[mi] * g4;
              *(LAS s16x4_t*)(At + t * CS + chl) = pk4(at[0], at[1], at[2], at[3]); *(LAS s16x4_t*)(Rt + t * CS + chl) = pk4(rt_[0], rt_[1], rt_[2], rt_[3]);
              *(LAS s16x4_t*)(Bt + t * CS + chl) = pk4(bt[0], bt[1], bt[2], bt[3]); *(LAS s16x4_t*)(Kt + t * CS + chl) = pk4(kt[0], kt[1], kt[2], kt[3]);
#pragma unroll
              for (int e = 0; e < 4; ++e) { BT[(chl + e) * CS + t] = (bf16)f2bf(bt[e]); KT[(chl + e) * CS + t] = (bf16)f2bf(kt[e]); } }
          if (F.tid < 64) ((float*)(F.ws + WS_RK))[(size_t)u * 64 + F.tid] = (RKS[F.tid] + RKS[64 + F.tid]) + (RKS[128 + F.tid] + RKS[192 + F.tid]); }
        __syncthreads();
        { const int tt = w & 3; const LAS bf16* Arow = ((w < 4) ? At : Rt) + (16 * tt + c16) * CS + 4 * q;
          s16x4_t af[4];
#pragma unroll
          for (int ks = 0; ks < 4; ++ks) af[ks] = lds4(Arow + 16 * ks);
          for (int jt = 0; jt <= tt; ++jt) {
#pragma unroll
              for (int which = 0; which < 2; ++which) {
                  const LAS bf16* Brow = (which ? Kt : Bt) + (16 * jt + c16) * CS + 4 * q;
                  f32x4 acc = (f32x4){0.f, 0.f, 0.f, 0.f};
#pragma unroll
                  for (int ks = 0; ks < 4; ++ks) acc = mfma16(af[ks], lds4(Brow + 16 * ks), acc);
                  LAS bf16* dst = (w < 4) ? (which ? Lak : NLab) : (which ? Mrk : Mrb);
#pragma unroll
                  for (int e = 0; e < 4; ++e) { const int t = 16 * tt + 4 * q + e, j = 16 * jt + c16;
                      const bool keep = (w < 4) ? (j < t) : (j <= t); float v = keep ? acc[e] : 0.f;
                      if (w < 4 && which == 0) { if (jt == tt) Ld[(tt * 16 + c16) * 16 + 4 * q + e] = v; v = -v; }
                      dst[t * CS + j] = (bf16)f2bf(v); } } } }
        __syncthreads();
        if (w == 0) { float s[16]; const LAS float* Lb = Ld + q * 256;
#pragma unroll
            for (int i = 0; i < 16; ++i) s[i] = (i == c16) ? 1.f : 0.f;
#pragma unroll
            for (int j = 0; j < 16; ++j) { const float Tj = s[j]; Tbb[(q * 16 + j) * 16 + c16] = (bf16)f2bf(Tj);
#pragma unroll
                for (int ci = (j + 1) / 4; ci < 4; ++ci) { const f32x4 lc = *(const LAS f32x4*)(Lb + j * 16 + 4 * ci);
#pragma unroll
                    for (int e = 0; e < 4; ++e) if (4 * ci + e > j) s[4 * ci + e] -= lc[e] * Tj; } } }
        f32x4 X[4]; s16x4_t vB[4]; f32x4 qv[4], yv[4];
        if (w < 4) {
#pragma unroll
            for (int bb = 0; bb < 4; ++bb)
#pragma unroll
                for (int e = 0; e < 4; ++e) X[bb][e] = bflo((unsigned)At[(16 * bb + 4 * q + e) * CS + 16 * w + c16]);
#pragma unroll
            for (int bb = 0; bb < 4; ++bb) { vB[bb] = (s16x4_t){0, 0, 0, 0}; qv[bb] = (f32x4){0.f, 0.f, 0.f, 0.f}; yv[bb] = qv[bb]; }
        } else {
#pragma unroll
            for (int bb = 0; bb < 4; ++bb) vB[bb] = lds4(VT + (16 * (w - 4) + c16) * CS + 16 * bb + 4 * q);
#pragma unroll
            for (int bb = 0; bb < 4; ++bb) { f32x4 acc = (f32x4){0.f, 0.f, 0.f, 0.f};
#pragma unroll
                for (int jb = 0; jb <= bb; ++jb) acc = mfma16(lds4(Lak + (16 * bb + c16) * CS + 16 * jb + 4 * q), vB[jb], acc);
                X[bb] = acc; }
#pragma unroll
            for (int ct = 0; ct < 4; ++ct) { f32x4 acc = (f32x4){0.f, 0.f, 0.f, 0.f};
#pragma unroll
                for (int bb = 0; bb < 4; ++bb) acc = mfma16(lds4(KT + (16 * ct + c16) * CS + 16 * bb + 4 * q), vB[bb], acc);
                qv[ct] = acc; }
#pragma unroll
            for (int tt = 0; tt < 4; ++tt) { f32x4 acc = (f32x4){0.f, 0.f, 0.f, 0.f};
#pragma unroll
                for (int bb = 0; bb <= tt; ++bb) acc = mfma16(lds4(Mrk + (16 * tt + c16) * CS + 16 * bb + 4 * q), vB[bb], acc);
                yv[tt] = acc; }
            { const int vt = w - 4; v4u* VGF = (v4u*)(F.ws + WS_VGF) + ((size_t)u * 16 + vt * 4) * 64 + lane;
#pragma unroll
              for (int tt = 0; tt < 4; ++tt) { const v2u vv2 = __builtin_bit_cast(v2u, vB[tt]); const v2u gg2 = *(const LAS v2u*)(GT + (16 * vt + c16) * CS + 16 * tt + 4 * q);
                  v4u o; o.x = vv2.x; o.y = vv2.y; o.z = gg2.x; o.w = gg2.y; __builtin_nontemporal_store(o, VGF + tt * 64); } }
        }
        __syncthreads();
        s16x4_t XB[4];
#pragma unroll
        for (int bb = 0; bb < 4; ++bb) {
            f32x4 r = X[bb];
#pragma unroll
            for (int jb = 0; jb < bb; ++jb) r = mfma16(lds4(NLab + (16 * bb + c16) * CS + 16 * jb + 4 * q), pk4(X[jb][0], X[jb][1], X[jb][2], X[jb][3]), r);
            const f32x4 z = (f32x4){0.f, 0.f, 0.f, 0.f};
            X[bb] = mfma16(lds4(Tbb + (bb * 16 + c16) * 16 + 4 * q), pk4(r[0], r[1], r[2], r[3]), z);
        }
#pragma unroll
        for (int bb = 0; bb < 4; ++bb) XB[bb] = pk4(-X[bb][0], -X[bb][1], -X[bb][2], -X[bb][3]);
        if (w < 4) {
            s16x4_t* PF = (s16x4_t*)(F.ws + WS_PF) + ((size_t)u * 16 + w * 4) * 64 + lane;
#pragma unroll
            for (int ct = 0; ct < 4; ++ct) { f32x4 acc = (f32x4){0.f, 0.f, 0.f, 0.f};
#pragma unroll
                for (int bb = 0; bb < 4; ++bb) acc = mfma16(XB[bb], lds4(BT + (16 * ct + c16) * CS + 16 * bb + 4 * q), acc);
                const float g63 = SEG[64 + 16 * ct + c16];
#pragma unroll
                for (int e = 0; e < 4; ++e) acc[e] = (acc[e] + ((ct == w && 4 * q + e == c16) ? 1.f : 0.f)) * g63;
                __builtin_nontemporal_store(pk4(acc[0], acc[1], acc[2], acc[3]), PF + ct * 64); }
            s16x4_t* RWF = (s16x4_t*)(F.ws + WS_RWF) + ((size_t)u * 16 + w) * 64 + lane;
#pragma unroll
            for (int tt = 0; tt < 4; ++tt) { const v2u rr = *(const LAS v2u*)(Rt + (16 * tt + c16) * CS + 16 * w + 4 * q);
                f32x4 acc; acc[0] = bflo(rr.x); acc[1] = bfhi(rr.x); acc[2] = bflo(rr.y); acc[3] = bfhi(rr.y);
#pragma unroll
                for (int bb = 0; bb <= tt; ++bb) acc = mfma16(XB[bb], lds4(Mrb + (16 * tt + c16) * CS + 16 * bb + 4 * q), acc);
                __builtin_nontemporal_store(pk4(acc[0], acc[1], acc[2], acc[3]), RWF + tt * 4 * 64); }
        } else {
            const int vt = w - 4;
            s16x4_t* QF = (s16x4_t*)(F.ws + WS_QF) + ((size_t)u * 16 + vt * 4) * 64 + lane;
#pragma unroll
            for (int ct = 0; ct < 4; ++ct) { f32x4 acc = qv[ct];
#pragma unroll
                for (int bb = 0; bb < 4; ++bb) acc = mfma16(lds4(BT + (16 * ct + c16) * CS + 16 * bb + 4 * q), XB[bb], acc);
                const f32x4 g63 = *(const LAS f32x4*)(SEG + 64 + 16 * ct + 4 * q);
                { const f32x4 qq = acc * g63; __builtin_nontemporal_store(pk4(qq[0], qq[1], qq[2], qq[3]), QF + ct * 64); } }
            s16x4_t* Y0F = (s16x4_t*)(F.ws + WS_Y0F) + ((size_t)u * 16 + vt * 4) * 64 + lane;
#pragma unroll
            for (int tt = 0; tt < 4; ++tt) { f32x4 acc = yv[tt];
#pragma unroll
                for (int bb = 0; bb <= tt; ++bb) acc = mfma16(lds4(Mrb + (16 * tt + c16) * CS + 16 * bb + 4 * q), XB[bb], acc);
                __builtin_nontemporal_store(pk4(acc[0], acc[1], acc[2], acc[3]), Y0F + tt * 64); }
        }
        __syncthreads();
    }
}

__device__ __forceinline__ void scanB_phase(const Frame& F) {
    const int task = F.vcu >> 1;
    if (F.wave != 0 || (F.vcu & 1) || task >= 128) return;
    const int lane = F.lane, bh = task >> 2, vt = task & 3;
    const s16x4_t* PF = (const s16x4_t*)(F.ws + WS_PF) + (size_t)bh * 64 * 16 * 64 + lane;
    const s16x4_t* QF = (const s16x4_t*)(F.ws + WS_QF) + ((size_t)bh * 64 * 16 + vt * 4) * 64 + lane;
    s16x4_t* S0F = (s16x4_t*)(F.ws + WS_S0F) + ((size_t)bh * 64 * 16 + vt * 4) * 64 + lane;
    f32x4 S[4];
#pragma unroll
    for (int i = 0; i < 4; ++i) S[i] = (f32x4){0.f, 0.f, 0.f, 0.f};
    s16x4_t P0[16], P1[16], P2[16]; s16x4_t Q0[4], Q1[4], Q2[4];
#define SB_LOAD(P, Q, C) do { _Pragma("unroll") for (int i = 0; i < 16; ++i) P[i] = __builtin_nontemporal_load(PF + ((size_t)(C) * 16 + i) * 64); _Pragma("unroll") for (int i = 0; i < 4; ++i) Q[i] = __builtin_nontemporal_load(QF + ((size_t)(C) * 16 + i) * 64); } while (0)
#define SB_STEP(P, Q, C) do { s16x4_t Sb[4]; \
        _Pragma("unroll") for (int i = 0; i < 4; ++i) { Sb[i] = pk4(S[i][0], S[i][1], S[i][2], S[i][3]); __builtin_nontemporal_store(Sb[i], S0F + ((size_t)(C) * 16 + i) * 64); } \
        _Pragma("unroll") for (int ct = 0; ct < 4; ++ct) { const v2u qb_ = __builtin_bit_cast(v2u, Q[ct]); f32x4 acc; acc[0] = bflo(qb_.x); acc[1] = bfhi(qb_.x); acc[2] = bflo(qb_.y); acc[3] = bfhi(qb_.y); \
            _Pragma("unroll") for (int kb = 0; kb < 4; ++kb) acc = mfma16(P[kb * 4 + ct], Sb[kb], acc); \
            S[ct] = acc; } } while (0)
    SB_LOAD(P0, Q0, 0); SB_LOAD(P1, Q1, 1); SB_LOAD(P2, Q2, 2);
#pragma unroll 1
    for (int c = 0; c < 63; c += 3) {
        SB_STEP(P0, Q0, c);     SB_LOAD(P0, Q0, c + 3);
        SB_STEP(P1, Q1, c + 1); if (c + 4 < 64) SB_LOAD(P1, Q1, c + 4);
        SB_STEP(P2, Q2, c + 2); if (c + 5 < 64) SB_LOAD(P2, Q2, c + 5);
    }
    SB_STEP(P0, Q0, 63);
#undef SB_LOAD
#undef SB_STEP
}

__device__ __forceinline__ void scanC_phase(const Frame& F, const In& I, int l) {
    bf16* YB = (bf16*)(F.ws + WS_AY) + 1024;
    const int gw = F.vcu * NWAVES + F.wave, NGW = F.G * NWAVES, lane = F.lane, c16 = lane & 15, q = lane >> 4;
    for (int it = 0; it * NGW < 2048; ++it) { const int u = (CHUNK_LOCAL && F.G == 256) ? chunk_unit(F.vcu, F.wave, F.G) : gw + it * NGW; if (u >= 2048) break;
        const int c = u & 63, H = (u >> 6) & 15, b = u >> 10;
        const s16x4_t* RWF = (const s16x4_t*)(F.ws + WS_RWF) + (size_t)u * 16 * 64 + lane;
        const s16x4_t* S0F = (const s16x4_t*)(F.ws + WS_S0F) + (size_t)u * 16 * 64 + lane;
        const s16x4_t* Y0F = (const s16x4_t*)(F.ws + WS_Y0F) + (size_t)u * 16 * 64 + lane;
        const v4u* VGF = (const v4u*)(F.ws + WS_VGF) + (size_t)u * 16 * 64 + lane;
        const float* RK = (const float*)(F.ws + WS_RK) + (size_t)u * 64;
        s16x4_t rw[16], s0[16];
#pragma unroll
        for (int i = 0; i < 16; ++i) { rw[i] = __builtin_nontemporal_load(RWF + i * 64); s0[i] = __builtin_nontemporal_load(S0F + i * 64); }
        float lnw[4], lnb[4];
#pragma unroll
        for (int vt = 0; vt < 4; ++vt) { lnw[vt] = I.ln_w[l * 1024 + H * 64 + 16 * vt + c16]; lnb[vt] = I.ln_b[l * 1024 + H * 64 + 16 * vt + c16]; }
        bf16* yb = YB + ((size_t)(b * SEQ + c * 64)) * 2048 + H * 64;
        s16x4_t yn[4]; v4u vgn[4]; f32x4 rkn;
#pragma unroll
        for (int vt = 0; vt < 4; ++vt) { yn[vt] = __builtin_nontemporal_load(Y0F + (vt * 4) * 64); vgn[vt] = __builtin_nontemporal_load(VGF + (vt * 4) * 64); }
        rkn = *(const GAS f32x4*)(RK + 4 * q);
#pragma unroll
        for (int tt = 0; tt < 4; ++tt) {
            f32x4 y[4]; v4u vg[4]; const f32x4 rk4 = rkn;
#pragma unroll
            for (int vt = 0; vt < 4; ++vt) { const v2u yb_ = __builtin_bit_cast(v2u, yn[vt]); y[vt][0] = bflo(yb_.x); y[vt][1] = bfhi(yb_.x); y[vt][2] = bflo(yb_.y); y[vt][3] = bfhi(yb_.y); vg[vt] = vgn[vt]; }
            if (tt < 3) {
#pragma unroll
                for (int vt = 0; vt < 4; ++vt) { yn[vt] = __builtin_nontemporal_load(Y0F + (vt * 4 + tt + 1) * 64); vgn[vt] = __builtin_nontemporal_load(VGF + (vt * 4 + tt + 1) * 64); }
                rkn = *(const GAS f32x4*)(RK + 16 * (tt + 1) + 4 * q); }
            __builtin_amdgcn_sched_barrier(0);
#pragma unroll
            for (int vt = 0; vt < 4; ++vt) { f32x4 acc = y[vt];
#pragma unroll
                for (int kb = 0; kb < 4; ++kb) acc = mfma16(rw[tt * 4 + kb], s0[vt * 4 + kb], acc);
                y[vt] = acc; }
#pragma unroll
            for (int e = 0; e < 4; ++e) {
                float s = (y[0][e] + y[1][e]) + (y[2][e] + y[3][e]); s = red16(s); const float mu = s * (1.f / 64.f);
                const float d0 = y[0][e] - mu, d1 = y[1][e] - mu, d2 = y[2][e] - mu, d3 = y[3][e] - mu;
                float s2 = (d0 * d0 + d1 * d1) + (d2 * d2 + d3 * d3); s2 = red16(s2);
                const float rs = __builtin_amdgcn_rsqf(s2 * (1.f / 64.f) + GN_EPS);
                y[0][e] = d0 * rs; y[1][e] = d1 * rs; y[2][e] = d2 * rs; y[3][e] = d3 * rs; }
#pragma unroll
            for (int vt = 0; vt < 4; ++vt) { const unsigned vw[2] = {vg[vt].x, vg[vt].y}, gw_[2] = {vg[vt].z, vg[vt].w};
#pragma unroll
                for (int e = 0; e < 4; ++e) { const float vv = (e & 1) ? bfhi(vw[e >> 1]) : bflo(vw[e >> 1]), gg = (e & 1) ? bfhi(gw_[e >> 1]) : bflo(gw_[e >> 1]);
                    const float o = (y[vt][e] * lnw[vt] + lnb[vt] + rk4[e] * vv) * gg;
                    if (F8_MRG) ((GAS unsigned char*)(F.ws + WS_AY))[1024 + ((size_t)(b * SEQ + c * 64) + 16 * tt + 4 * q + e) * 2048 + H * 64 + 16 * vt + c16] = (unsigned char)__builtin_amdgcn_cvt_pk_fp8_f32(16.f * o, 0.f, 0, false);
                    else yb[(size_t)(16 * tt + 4 * q + e) * 2048 + 16 * vt + c16] = (bf16)f2bf(o); } }
        }
    }
}

__device__ __forceinline__ void router_phase(const Frame& F, const In& I, int l, const bf16* X, int cslot = -1, size_t rt_off = 0) {
    const bf16* lw = (const bf16*)(F.ws + WS_LORA); float* RS = (float*)(F.ws + WS_RSTD);
    if (cslot < 0) cslot = l;
    int* ST = (int*)(F.ws + WS_SLOT_TOK + rt_off) + (size_t)l * NEXP * ECAP; float* SW = (float*)(F.ws + WS_SLOT_W + rt_off) + (size_t)l * NEXP * ECAP;
    LAS float* ssq = (LAS float*)(F.lds); LAS float* part = (LAS float*)(F.lds + 1024); LAS float* logit = (LAS float*)(F.lds + 1024 + 49152);
    LAS int* lcnt = (LAS int*)(F.lds + 1024 + 49152 + 6144); LAS int* lbase = lcnt + 32; LAS int* tsel = lbase + 32; LAS float* twt = (LAS float*)(tsel + 128);
    const int lane = F.lane, tl = lane & 15, q4 = lane >> 4;
    LAS float* mxq = (LAS float*)(F.lds + 57344); LAS float* qsl = (LAS float*)(F.lds + 58368);
    for (int u = F.vcu; u < NTOK / 32; u += F.G) {
        const int tok0 = 32 * u;
        if (F.tid < 32) lcnt[F.tid] = 0;
        const unsigned kb2 = (unsigned)(256 * F.wave + 8 * q4) * 2u; const unsigned xoff[2] = {(unsigned)((tok0 + tl) * DM) * 2u + kb2, (unsigned)((tok0 + 16 + tl) * DM) * 2u + kb2};
        const unsigned woff[3] = {(unsigned)(tl * 2048) * 2u + kb2, (unsigned)((16 + tl) * 2048) * 2u + kb2, (unsigned)((32 + tl) * 2048) * 2u + kb2};
        bf16x8 ah[2][8];
        { f32x4 acc[2][3]; float ss[2] = {0.f, 0.f}, mxv[2] = {0.f, 0.f};
#pragma unroll
          for (int mt = 0; mt < 2; ++mt)
#pragma unroll
              for (int nt = 0; nt < 3; ++nt) acc[mt][nt] = (f32x4){0.f, 0.f, 0.f, 0.f};
#pragma unroll
          for (int ks = 0; ks < 8; ++ks)
#pragma unroll
              for (int mt = 0; mt < 2; ++mt) ah[mt][ks] = __builtin_bit_cast(bf16x8, *(const GAS v4u*)((const GAS unsigned char*)X + (xoff[mt] + 64u * ks)));
#pragma unroll
          for (int ks = 0; ks < 8; ++ks) {
#pragma unroll
              for (int mt = 0; mt < 2; ++mt) { const v4u xb = __builtin_bit_cast(v4u, ah[mt][ks]);
                  const float a0 = bflo(xb.x), a1 = bfhi(xb.x), a2 = bflo(xb.y), a3 = bfhi(xb.y), a4 = bflo(xb.z), a5 = bfhi(xb.z), a6 = bflo(xb.w), a7 = bfhi(xb.w);
                  ss[mt] += ((a0 * a0 + a1 * a1) + (a2 * a2 + a3 * a3)) + ((a4 * a4 + a5 * a5) + (a6 * a6 + a7 * a7));
                  mxv[mt] = fmaxf(mxv[mt], fmaxf(fmaxf(fmaxf(fabsf(a0), fabsf(a1)), fmaxf(fabsf(a2), fabsf(a3))), fmaxf(fmaxf(fabsf(a4), fabsf(a5)), fmaxf(fabsf(a6), fabsf(a7))))); }
#pragma unroll
              for (int nt = 0; nt < 3; ++nt) {
                  const bf16x8 bh = *(const GAS bf16x8*)((const GAS unsigned char*)(lw + LO_RH) + (woff[nt] + 64u * ks)), bl = *(const GAS bf16x8*)((const GAS unsigned char*)(lw + LO_RL) + (woff[nt] + 64u * ks));
#pragma unroll
                  for (int mt = 0; mt < 2; ++mt) { acc[mt][nt] = __builtin_amdgcn_mfma_f32_16x16x32_bf16(ah[mt][ks], bh, acc[mt][nt], 0, 0, 0);
                      acc[mt][nt] = __builtin_amdgcn_mfma_f32_16x16x32_bf16(ah[mt][ks], bl, acc[mt][nt], 0, 0, 0); } }
              if (ks & 1) __builtin_amdgcn_sched_barrier(0); }
#pragma unroll
          for (int mt = 0; mt < 2; ++mt) { ss[mt] += __shfl_xor(ss[mt], 16); ss[mt] += __shfl_xor(ss[mt], 32); mxv[mt] = fmaxf(mxv[mt], __shfl_xor(mxv[mt], 16)); mxv[mt] = fmaxf(mxv[mt], __shfl_xor(mxv[mt], 32));
              if (q4 == 0) { ssq[F.wave * 32 + 16 * mt + tl] = ss[mt]; mxq[F.wave * 32 + 16 * mt + tl] = mxv[mt]; } }
#pragma unroll
          for (int mt = 0; mt < 2; ++mt)
#pragma unroll
              for (int nt = 0; nt < 3; ++nt)
#pragma unroll
                  for (int e = 0; e < 4; ++e) part[(F.wave * 32 + 16 * mt + 4 * q4 + e) * 48 + 16 * nt + tl] = acc[mt][nt][e]; }
        __syncthreads();
        for (int idx = F.tid; idx < 32 * 36; idx += NTHR) { const int t = idx / 36, c = idx - t * 36; float s = 0.f, q = 0.f, mx = 0.f;
#pragma unroll
            for (int w = 0; w < 8; ++w) { s += part[(w * 32 + t) * 48 + c]; q += ssq[w * 32 + t]; mx = fmaxf(mx, mxq[w * 32 + t]); }
            const float rstd = __builtin_amdgcn_rsqf(q * (1.f / DM) + NORM_EPS);
            if (c == 0) { mx = fmaxf(mx, 1e-20f); RS[tok0 + t] = rstd * mx * (1.f / (127.f * IN_WS)); qsl[t] = 127.f / mx; }
            s = s * rstd + ((c < 32) ? I.re_b[l * 32 + c] : I.rg_b[l * 4 + (c - 32)]); logit[t * 48 + c] = s; }
        __syncthreads();
        { unsigned char* X8 = F.ws + WS_H;
#pragma unroll
          for (int mt = 0; mt < 2; ++mt) { const float qs = qsl[16 * mt + tl];
#pragma unroll
              for (int ks = 0; ks < 8; ++ks) { const v4u xb = __builtin_bit_cast(v4u, ah[mt][ks]); v2u o;
                  o.x = pack_i8x4(bflo(xb.x) * qs, bfhi(xb.x) * qs, bflo(xb.y) * qs, bfhi(xb.y) * qs); o.y = pack_i8x4(bflo(xb.z) * qs, bfhi(xb.z) * qs, bflo(xb.w) * qs, bfhi(xb.w) * qs);
                  *(GAS v2u*)((GAS unsigned char*)X8 + ((xoff[mt] >> 1) + 32u * ks)) = o; } } }
        if (F.tid < 32) { const int t = F.tid; const LAS float* lg = logit + t * 48;
            int gs = 0; float gm = lg[32];
#pragma unroll
            for (int j = 1; j < 4; ++j) if (lg[32 + j] > gm) { gm = lg[32 + j]; gs = j; }
            float den = 0.f;
#pragma unroll
            for (int j = 0; j < 4; ++j) den += __expf(lg[32 + j] - gm);
            const float gp = 1.f / den;
            int i1 = 0; float v1 = lg[gs * 8];
#pragma unroll
            for (int j = 1; j < 8; ++j) if (lg[gs * 8 + j] > v1) { v1 = lg[gs * 8 + j]; i1 = j; }
            int i2 = -1; float v2 = -3.0e38f;
#pragma unroll
            for (int j = 0; j < 8; ++j) if (j != i1 && lg[gs * 8 + j] > v2) { v2 = lg[gs * 8 + j]; i2 = j; }
            const float e2 = __expf(v2 - v1); const float wa = gp / (1.f + e2), wb = gp * e2 / (1.f + e2);
            const int ea = gs * 8 + i1, eb = gs * 8 + i2;
            tsel[t * 4 + 0] = ea; tsel[t * 4 + 1] = eb; tsel[t * 4 + 2] = atomicAdd((int*)(lcnt + ea), 1); tsel[t * 4 + 3] = atomicAdd((int*)(lcnt + eb), 1);
            twt[t * 2] = wa; twt[t * 2 + 1] = wb; }
        __syncthreads();
        if (F.tid < 32) lbase[F.tid] = (int)atomicAdd(F.ctl + CW_CNT + 64 * cslot + F.tid, (unsigned)lcnt[F.tid]);
        __syncthreads();
        if (F.tid < 64) { const int t = F.tid >> 1, k = F.tid & 1; const int e = tsel[t * 4 + k]; const int i = (tok0 + t) * 2 + k;
            const int slot = e * ECAP + lbase[e] + tsel[t * 4 + 2 + k]; ST[slot] = i; SW[slot] = twt[t * 2 + k]; }
        __syncthreads();
    }
}

__device__ __forceinline__ void moe_tables(const Frame& F, int l) {
    LAS int* panel_e = (LAS int*)(F.lds + LDS_PANEL); LAS int* panel_sb = (LAS int*)(F.lds + LDS_PSB); LAS int* tab = (LAS int*)(F.lds + LDS_TAB);
    if (F.tid < 32) tab[F.tid] = (int)__hip_atomic_load(F.ctl + CW_CNT + 64 * l + F.tid, __ATOMIC_RELAXED, __HIP_MEMORY_SCOPE_AGENT);
    __syncthreads();
    if (F.tid == 0) { int pp = 0;
        for (int e = 0; e < 32; ++e) { const int np = (tab[e] + 255) >> 8; for (int j = 0; j < np; ++j) { panel_e[pp + j] = e; panel_sb[pp + j] = e * ECAP + 256 * j; } pp += np; }
        tab[65] = pp; }
    __syncthreads();
}
__device__ __forceinline__ void combine_phase(const Frame& F, const In& I, int l, const bf16* X, float* out, bool dummy = false) {
    const bf16* MO = (const bf16*)(F.ws + WS_MOEOUT); bf16* XC = (bf16*)(F.ws + (dummy ? WS_TMP : WS_X)); bf16* Hn = (bf16*)(F.ws + (dummy ? WS_ATTN : WS_H));
    const int gw = F.vcu * NWAVES + F.wave, NGW = F.G * NWAVES, lane = F.lane;
    const float* w = (l == 0) ? (I.attn_norm_w + DM) : I.final_w;
    for (int rp_ = 0; rp_ * 2 * NGW < NTOK; ++rp_) {
        f32x4 v[2][8]; float s[2] = {0.f, 0.f};
#pragma unroll
        for (int r = 0; r < 2; ++r) { const int m = row_of(gw, 2 * rp_ + r, NGW); if (m < NTOK) {
            const GAS v2u* xr = (const GAS v2u*)(X + (size_t)m * DM) + lane; const GAS v2u* m0 = (const GAS v2u*)(MO + (size_t)m * DM) + lane; const GAS v2u* m1 = (const GAS v2u*)(MO + ((size_t)NTOK + m) * DM) + lane;
#pragma unroll
            for (int j = 0; j < 8; ++j) { const v2u a = __builtin_nontemporal_load(m0 + 64 * j), b = __builtin_nontemporal_load(m1 + 64 * j); { const v2u xb = xr[64 * j]; v[r][j].x = bflo(xb.x); v[r][j].y = bfhi(xb.x); v[r][j].z = bflo(xb.y); v[r][j].w = bfhi(xb.y); }
                v[r][j].x += bflo(a.x) + bflo(b.x); v[r][j].y += bfhi(a.x) + bfhi(b.x); v[r][j].z += bflo(a.y) + bflo(b.y); v[r][j].w += bfhi(a.y) + bfhi(b.y);
                s[r] += (v[r][j].x * v[r][j].x + v[r][j].y * v[r][j].y) + (v[r][j].z * v[r][j].z + v[r][j].w * v[r][j].w); } } }
#pragma unroll
        for (int r = 0; r < 2; ++r) { const int m = row_of(gw, 2 * rp_ + r, NGW); if (m < NTOK) {
            const GAS f32x4* wr = (const GAS f32x4*)w + lane;
            const float rstd = __builtin_amdgcn_rsqf(wave_sum(s[r]) * (1.f / DM) + NORM_EPS);
            if (l == 0) { GAS v2u* xo = (GAS v2u*)(XC + (size_t)m * DM) + lane; GAS v2u* o8 = (GAS v2u*)(Hn + (size_t)m * DM) + lane; GAS unsigned* o4 = (GAS unsigned*)((GAS unsigned char*)Hn + (size_t)m * DM) + lane;
                float qs = 0.f;
                if (F8_IN == 2) { float mx = 0.f;
#pragma unroll
                    for (int j = 0; j < 8; ++j) { const f32x4 hh = v[r][j] * rstd * wr[64 * j]; mx = fmaxf(mx, fmaxf(fmaxf(fabsf(hh.x), fabsf(hh.y)), fmaxf(fabsf(hh.z), fabsf(hh.w)))); }
                    mx = fmaxf(wave_max(mx), 1e-20f); qs = 127.f / mx; if (lane == 0) ((float*)(F.ws + WS_ASC))[m] = mx * (1.f / (127.f * IN_WS)); }
#pragma unroll
                for (int j = 0; j < 8; ++j) { { v2u xq; xq.x = pk2(v[r][j].x, v[r][j].y); xq.y = pk2(v[r][j].z, v[r][j].w); xo[64 * j] = xq; } const f32x4 ww = wr[64 * j];
                    if (F8_IN == 2) { o4[64 * j] = pack_i8x4(v[r][j].x * rstd * ww.x * qs, v[r][j].y * rstd * ww.y * qs, v[r][j].z * rstd * ww.z * qs, v[r][j].w * rstd * ww.w * qs); continue; }
                    if (F8_GATE) { int p = 0; p = __builtin_amdgcn_cvt_pk_fp8_f32(v[r][j].x * rstd * ww.x, v[r][j].y * rstd * ww.y, p, false); p = __builtin_amdgcn_cvt_pk_fp8_f32(v[r][j].z * rstd * ww.z, v[r][j].w * rstd * ww.w, p, true); ((GAS unsigned*)(F.ws + WS_H8 + (size_t)m * DM) + lane)[64 * j] = (unsigned)p; }
                    if (F8_IN) { int p = 0; p = __builtin_amdgcn_cvt_pk_fp8_f32(v[r][j].x * rstd * ww.x, v[r][j].y * rstd * ww.y, p, false); p = __builtin_amdgcn_cvt_pk_fp8_f32(v[r][j].z * rstd * ww.z, v[r][j].w * rstd * ww.w, p, true); o4[64 * j] = (unsigned)p; }
                    else { v2u o; o.x = pk2(v[r][j].x * rstd * ww.x, v[r][j].y * rstd * ww.y); o.y = pk2(v[r][j].z * rstd * ww.z, v[r][j].w * rstd * ww.w); o8[64 * j] = o; } } }
            else { GAS f32x4* oo = (GAS f32x4*)(out + (size_t)m * DM) + lane;
#pragma unroll
                for (int j = 0; j < 8; ++j) __builtin_nontemporal_store(v[r][j] * rstd * wr[64 * j], oo + 64 * j); } } }
    }
}

#ifndef MERGE_WGM
#define MERGE_WGM 8
#endif
#ifndef GEMMIN_WGM
#define GEMMIN_WGM 8
#endif
#ifndef DOWN_ALIGN
#define DOWN_ALIGN true
#endif
#ifndef CV_T1
#define CV_T1 4608
#endif
#ifndef GEMMIN_SP2
#define GEMMIN_SP2 true
#endif
#ifndef GEMMIN_ALIGN
#define GEMMIN_ALIGN true
#endif
#ifndef PROBE_MASK
#define PROBE_MASK 0
#endif
#ifndef CUT
#define CUT 0
#endif
__device__ __forceinline__ void finalize_phase(const Frame& F, const In& I, const bf16* X, float* out) {
    const int gw = F.vcu * NWAVES + F.wave, NGW = F.G * NWAVES, lane = F.lane;
    for (int m = gw; m < NTOK; m += NGW) {
        const GAS v2u* xr = (const GAS v2u*)(X + (size_t)m * DM) + lane; const GAS f32x4* wr = (const GAS f32x4*)I.final_w + lane;
        f32x4 v[8]; float s = 0.f;
#pragma unroll
        for (int j = 0; j < 8; ++j) { const v2u xb = xr[64 * j]; v[j].x = bflo(xb.x); v[j].y = bfhi(xb.x); v[j].z = bflo(xb.y); v[j].w = bfhi(xb.y); s += (v[j].x * v[j].x + v[j].y * v[j].y) + (v[j].z * v[j].z + v[j].w * v[j].w); }
        const float rstd = __builtin_amdgcn_rsqf(wave_sum(s) * (1.f / DM) + NORM_EPS);
        GAS f32x4* oo = (GAS f32x4*)(out + (size_t)m * DM) + lane;
#pragma unroll
        for (int j = 0; j < 8; ++j) oo[64 * j] = v[j] * rstd * wr[64 * j];
    }
}
struct Args { const float* in[31]; float* out; unsigned char* ws; int ph_lo, ph_hi; };
#define PHASE_BEGIN if (ph >= lo && ph < hi) { { int t_ = threadIdx.x; asm volatile("" : "+v"(t_)); F.tid = t_; F.lane = t_ & 63; F.wave = __builtin_amdgcn_readfirstlane(t_ >> 6); unsigned char* w_ = args.ws; asm volatile("" : "+s"(w_)); F.ws = w_; F.ctl = (unsigned*)(w_ + WS_CTL); } const In I = load_in(F); \
    bf16* Hb = (bf16*)(F.ws + WS_H); bf16* PROJ = (bf16*)(F.ws + WS_PROJ); bf16* XC = (bf16*)(F.ws + WS_X); (void)Hb; (void)PROJ; (void)XC;
#define PHASE_END(last) if (ph + 1 < hi && !(last)) xcd_barrier(bar); } ++ph;
template <int l> __device__ __forceinline__ bool layer_body(Frame& F, const Args& args, const XcdBarrier& bar, int& ph, const int lo, const int hi) {

#if (PROBE_MASK & 1)
        if (l == 1) { PHASE_BEGIN conv_phase(F, I, 1); PHASE_END(false) }
#endif
#if F8_GATE
        PHASE_BEGIN { { pg8::Gemm g{Hb, (const bf16*)(F.ws + WS_WIN_T), NTOK, C_GATE, DM}; pg8::StaticOrder S; S.init(NTOK, C_GATE, F.G, (int)blockIdx.x, GEMMIN_WGM);
              pg8::EpiStoreBf16 E{PROJ, INP, (unsigned char*)(F.ws + WS_GATE8), 0, nullptr}; pg8::gemm_phase<pg8::EpiStoreBf16, pg8::StaticOrder, GEMMIN_ALIGN, GEMMIN_SP2>(F.lds, g, S, E); }
            { pg8::Gemm g{(const bf16*)(F.ws + WS_H8), (const bf16*)(F.ws + WS_WIN_T + WIN8_OFF), NTOK, INP - C_GATE, DM / 2}; pg8::ListOrder S; S.base.init(NTOK, INP - C_GATE, F.G, 0, GEMMIN_WGM);
              const int bx = (int)blockIdx.x; if (F.G == 256) { S.first = (bx < 128) ? bx : bx; S.stride = 128; S.cnt = (bx < 128) ? 1 : 3; if (bx >= 128) S.first = bx; } else { S.first = bx; S.stride = F.G; S.cnt = 1 << 20; }
              pg8::EpiStoreBf16 E{PROJ, INP, (unsigned char*)(F.ws + WS_GATE8), C_GATE / 256, nullptr}; pg8::gemm_phase<pg8::EpiStoreBf16, pg8::ListOrder, GEMMIN_ALIGN, GEMMIN_SP2, false, 124>(F.lds, g, S, E); }
            { __syncthreads(); const int d = conv_dense_items(l); conv_items(F, I, l, conv_first_items(l, F.G), d + ((F.G == 256) ? CV_B1 : 0), F.vcu, F.G); } } PHASE_END(false)
#else
        PHASE_BEGIN { pg8::Gemm g{Hb, (const bf16*)(F.ws + WS_WIN_T), NTOK, INP, F8_IN ? DM / 2 : DM}; pg8::StaticOrder S; S.init(NTOK, INP, F.G, (int)blockIdx.x, GEMMIN_WGM);
            pg8::EpiStoreBf16 E{PROJ, INP, (unsigned char*)(F.ws + WS_GATE8), 0, (F8_IN == 2) ? (const float*)(F.ws + WS_ASC) : nullptr}; pg8::gemm_phase<pg8::EpiStoreBf16, pg8::StaticOrder, GEMMIN_ALIGN, GEMMIN_SP2, false, (F8_IN == 1 ? 124 : 0), (F8_IN == 2)>(F.lds, g, S, E);
            if (F.G == 256) { const int d = conv_dense_items(l), c0 = conv_first_items(l, F.G), c1 = (F8_IN ? c0 + CV_T1 : d + CV_B1);
                if ((int)blockIdx.x >= 128) conv_items(F, I, l, c0, c1, (int)blockIdx.x - 128, 128);
                if (c1 < d + CV_B1) { __syncthreads(); conv_items(F, I, l, c1, d + CV_B1, F.vcu, F.G); } } } PHASE_END(false)
#endif
#if (PROBE_MASK & 2)
        PHASE_BEGIN { pg8::Gemm g{Hb, (const bf16*)(F.ws + WS_WIN_T), NTOK, INP, DM}; pg8::StaticOrder S; S.init(NTOK, INP, F.G, (int)blockIdx.x, GEMMIN_WGM);
            pg8::EpiStoreBf16 E{PROJ, INP, (unsigned char*)(F.ws + WS_GATE8), 0, nullptr}; pg8::gemm_phase<pg8::EpiStoreBf16, pg8::StaticOrder, true, true>(F.lds, g, S, E); } PHASE_END(false)
#endif
#ifdef UNFUSED_PREP
        PHASE_BEGIN attn_phase(F, I, l); prep_phase(F, I, l); PHASE_END(false)
#else
        PHASE_BEGIN acts_phase(F, I, l); attn_phase(F, I, l); PHASE_END(false)
        PHASE_BEGIN chunk_phase(F, I, l); PHASE_END(false)
#endif
#if (PROBE_MASK & 4)
        PHASE_BEGIN acts_phase(F, I, l); attn_phase(F, I, l); PHASE_END(false)
#endif
#if (PROBE_MASK & 64)
        PHASE_BEGIN attn_phase(F, I, l); PHASE_END(false)
#endif
#ifdef SEQ_SCAN
        PHASE_BEGIN scan_phase(F); PHASE_END(false)
#else
#ifdef UNFUSED_PREP
        PHASE_BEGIN scanA_phase(F, I, l); PHASE_END(false)
#endif
        PHASE_BEGIN scanB_phase(F); if (F.G == 256 && (F.vcu & 1)) { const int d = conv_dense_items(l); conv_items(F, I, l, d + CV_B1, d + CV_B2, F.vcu >> 1, 128); } PHASE_END(false)
        PHASE_BEGIN scanC_phase(F, I, l); PHASE_END(false)
#endif
#if (PROBE_MASK & 512)
        PHASE_BEGIN scanC_phase(F, I, l); PHASE_END(false)
#endif
#if (PROBE_MASK & 128)
        PHASE_BEGIN chunk_phase(F, I, l); PHASE_END(false)
#endif
#if (PROBE_MASK & 256)
        PHASE_BEGIN scanB_phase(F); PHASE_END(false)
#endif
#if defined(SEQ_SCAN)
        PHASE_BEGIN post_phase(F, I, l); PHASE_END(false)
#endif
        PHASE_BEGIN { pg8::Gemm g{(const bf16*)(F.ws + WS_AY), (const bf16*)(F.ws + WS_WA_T), NTOK, DM, F8_MRG ? 512 : 1024, F8_MRG ? DM / 2 : DM}; pg8::MergeOrder S; S.base.init(NTOK, DM, F.G, (int)blockIdx.x, MERGE_WGM);
            pg8::EpiMerge E{(const unsigned char*)(F.ws + WS_GATE8), (const unsigned char*)(F.ws + WS_GATE8) + 2048, 4096, (bf16*)(F.ws + WS_MERGED)}; pg8::gemm_phase<pg8::EpiMerge, pg8::MergeOrder, true, true, false, (F8_MRG ? 122 : 0)>(F.lds, g, S, E); } PHASE_END(false)
#if (PROBE_MASK & 32)
        PHASE_BEGIN { pg8::Gemm g{(const bf16*)(F.ws + WS_AY), (const bf16*)(F.ws + WS_WA_T), NTOK, DM, 1024, DM}; pg8::MergeOrder S; S.base.init(NTOK, DM, F.G, (int)blockIdx.x, MERGE_WGM);
            pg8::EpiMerge E{(const unsigned char*)(F.ws + WS_GATE8), (const unsigned char*)(F.ws + WS_GATE8) + 2048, 4096, (bf16*)(F.ws + WS_MERGED)}; pg8::gemm_phase<pg8::EpiMerge, pg8::MergeOrder, true, true>(F.lds, g, S, E); } PHASE_END(false)
#endif
        PHASE_BEGIN { pg8::Gemm g{(const bf16*)(F.ws + WS_MERGED), (const bf16*)(F.ws + WS_WOUT_T), NTOK, DM, F8_OUT ? DM / 2 : DM}; pg8::StaticOrder S; S.init(NTOK, DM, F.G, (int)blockIdx.x, MERGE_WGM);
            pg8::EpiResid<l == 0> E{I.x, XC, XC, (unsigned char*)(F.ws + WS_H)}; pg8::gemm_phase<pg8::EpiResid<l == 0>, pg8::StaticOrder, true, true, false, (F8_OUT ? 122 : 0)>(F.lds, g, S, E); } PHASE_END(false)
#if (PROBE_MASK & 1024)
        if (l == 0) { PHASE_BEGIN { pg8::Gemm g{(const bf16*)(F.ws + WS_MERGED), (const bf16*)(F.ws + WS_WOUT_T), NTOK, DM, DM}; pg8::StaticOrder S; S.init(NTOK, DM, F.G, (int)blockIdx.x, MERGE_WGM);
            pg8::EpiResid<true> E{I.x, XC, XC, (unsigned char*)(F.ws + WS_H)}; pg8::gemm_phase<pg8::EpiResid<true>, pg8::StaticOrder, true, true>(F.lds, g, S, E); } PHASE_END(false) }
#endif
        if (CUT == 1 + 2 * l) { PHASE_BEGIN finalize_phase(F, I, XC, args.out); PHASE_END(true) return true; }
#if (PROBE_MASK & 4096)
        PHASE_BEGIN router_phase(F, I, l, XC, 2 + l, 8 * MiB); PHASE_END(false)
#endif
        PHASE_BEGIN router_phase(F, I, l, XC); { const int d = conv_dense_items(l); conv_items(F, I, l, (F.G == 256) ? d + CV_B2 : d, d + CV_MOE, F.vcu, F.G); } PHASE_END(false)
#define MOE_UP(FIRST, STRIDE, LIMIT) do { pg8::Gemm g{(const bf16*)(F.ws + (F8_MOE ? WS_H : WS_X)), (const bf16*)(F.ws + WS_WGU_T), MAXSLOT, NEXP * 1024, F8_MOE ? DM / 2 : DM}; \
            pg8::MoeOrder S{(FIRST), (STRIDE), (LIMIT), 4, (const LAS int*)(F.lds + LDS_PANEL), (const LAS int*)(F.lds + LDS_PSB)}; \
            pg8::EpiSwiGlu E{(bf16*)(F.ws + WS_HID), (const int*)(F.ws + WS_SLOT_TOK) + (size_t)l * NEXP * ECAP, (const float*)(F.ws + WS_RSTD)}; pg8::gemm_phase<pg8::EpiSwiGlu, pg8::MoeOrder, true, true, true, ((F8_MOE && !I8_UP) ? 124 : 0), (I8_UP != 0)>(F.lds, g, S, E, (const int*)(F.ws + WS_SLOT_TOK) + (size_t)l * NEXP * ECAP); } while (0)
#define MOE_DOWN(FIRST, STRIDE, LIMIT) do { pg8::Gemm g{(const bf16*)(F.ws + WS_HID), (const bf16*)(F.ws + WS_WD_T), MAXSLOT, NEXP * DM, F8_MOE ? EH / 2 : EH}; \
            pg8::MoeOrder S{(FIRST), (STRIDE), (LIMIT), 8, (const LAS int*)(F.lds + LDS_PANEL), (const LAS int*)(F.lds + LDS_PSB)}; \
            pg8::EpiMoeDown E{(bf16*)(F.ws + WS_MOEOUT), (const int*)(F.ws + WS_SLOT_TOK) + (size_t)l * NEXP * ECAP, (const float*)(F.ws + WS_SLOT_W) + (size_t)l * NEXP * ECAP}; \
            pg8::gemm_phase<pg8::EpiMoeDown, pg8::MoeOrder, DOWN_ALIGN, true, false, (F8_MOE ? 123 : 0)>(F.lds, g, S, E); } while (0)
        PHASE_BEGIN { moe_tables(F, l); const int np = ((const LAS int*)(F.lds + LDS_TAB))[65], n_up = np * 4, G = F.G, c = F.vcu;
            MOE_UP(c, G, (n_up < G ? n_up : G)); } PHASE_END(false)
        PHASE_BEGIN { const int np = ((const LAS int*)(F.lds + LDS_TAB))[65], n_up = np * 4, G = F.G, c = F.vcu;
            const int R2 = moe_r2(np, G), n_early = moe_n_early(np, G);
            if (c < R2) MOE_UP(G + c, R2, n_up); else MOE_DOWN(c - R2, G - R2, n_early); } PHASE_END(false)
        PHASE_BEGIN { const int np = ((const LAS int*)(F.lds + LDS_TAB))[65], G = F.G, c = F.vcu;
            const int n_early = moe_n_early(np, G);
            MOE_DOWN(n_early + c, G, np * 8);
            if (l == 0) { const int idle = cv_z_idle(np, G); if (idle > 0 && c >= G - idle) conv_items(F, I, 1, 0, cv_z_items(np, G), c - (G - idle), idle); } } PHASE_END(false)
#if (PROBE_MASK & 16)
        PHASE_BEGIN { moe_tables(F, l); const int np = ((const LAS int*)(F.lds + LDS_TAB))[65], n_up = np * 4, G = F.G, c = F.vcu;
            MOE_UP(c, G, (n_up < G ? n_up : G)); } PHASE_END(false)
        PHASE_BEGIN { const int np = ((const LAS int*)(F.lds + LDS_TAB))[65], n_up = np * 4, G = F.G, c = F.vcu;
            const int R2 = moe_r2(np, G), n_early = moe_n_early(np, G);
            if (c < R2) MOE_UP(G + c, R2, n_up); else MOE_DOWN(c - R2, G - R2, n_early); } PHASE_END(false)
        PHASE_BEGIN { const int np = ((const LAS int*)(F.lds + LDS_TAB))[65], G = F.G, c = F.vcu;
            const int n_early = moe_n_early(np, G);
            MOE_DOWN(n_early + c, G, np * 8);
            if (false) { const int idle = cv_z_idle(np, G); if (idle > 0 && c >= G - idle) conv_items(F, I, 1, 0, cv_z_items(np, G), c - (G - idle), idle); } } PHASE_END(false)
#endif
#undef MOE_UP
#undef MOE_DOWN
#if (PROBE_MASK & 8192)
        PHASE_BEGIN combine_phase(F, I, 0, XC, args.out, true); PHASE_END(false)
#endif
        PHASE_BEGIN combine_phase(F, I, l, XC, args.out); if (l == 0) { __syncthreads(); conv_phase(F, I, 1, cv_z_items(((const LAS int*)(F.lds + LDS_TAB))[65], F.G)); } PHASE_END(l == 1)
        if (CUT == 2 && l == 0) { PHASE_BEGIN finalize_phase(F, I, XC, args.out); PHASE_END(true) return true; }
        return false;
}
__global__ void __launch_bounds__(NTHR, 2) hybrid_fwd(Args args) {
    extern __shared__ __attribute__((aligned(16))) unsigned char lds_raw[];
    Frame F;
    F.lds = (LAS unsigned char*)lds_raw; F.ws = args.ws; F.ctl = (unsigned*)(args.ws + WS_CTL);
    F.tid = threadIdx.x; F.lane = F.tid & 63; F.wave = __builtin_amdgcn_readfirstlane(F.tid >> 6);
    F.G = gridDim.x; { const int bx = blockIdx.x; F.vcu = (F.G % 8 == 0) ? (bx % 8) * (F.G / 8) + bx / 8 : bx; }
    for (int u = F.tid; u < (LDS_BYTES - LDSCTL_OFF) / 4; u += NTHR) ((LAS unsigned*)(F.lds + LDSCTL_OFF))[u] = 0u;
    __syncthreads();
    if (F.tid == 0) {
#pragma unroll
        for (int k = 0; k < 31; ++k) *(LAS unsigned long long*)(F.lds + LDS_PTRS + 8 * k) = (unsigned long long)args.in[k]; }
    __syncthreads();
    XcdBarrier bar = xcd_barrier_post(F.ctl + CW_BAR, (volatile LAS unsigned*)(F.lds + LDSCTL_OFF));
    const int lo = args.ph_lo, hi = args.ph_hi;
    int ph = 0;

    PHASE_BEGIN conv_phase(F, I, 0); norm_phase(F, I.x, I.attn_norm_w, Hb); PHASE_END(false)
#if (PROBE_MASK & 1)
    PHASE_BEGIN conv_phase(F, I, 0); PHASE_END(false)
#endif
    if (layer_body<0>(F, args, bar, ph, lo, hi)) return;
    (void)layer_body<1>(F, args, bar, ph, lo, hi);
}

extern "C" void kernel_launch(void* const* d_in, const int* in_sizes, int n_in, void* d_out, int out_size, void* d_ws, size_t ws_size, hipStream_t stream) {
    static int grid = 0;
    if (grid == 0) {
        if (n_in != 31 || out_size != NTOK * DM || ws_size < WS_END) { fprintf(stderr, "kernel_launch: unexpected shapes: n_in %d out %d ws %zu (need %zu)\n", n_in, out_size, ws_size, (size_t)WS_END); grid = -1; return; }
        int dev = 0, cus = 0, per_cu = 0;
        if (hipGetDevice(&dev) != hipSuccess || hipDeviceGetAttribute(&cus, hipDeviceAttributeMultiprocessorCount, dev) != hipSuccess) { grid = -1; return; }
        if (hipFuncSetAttribute((const void*)hybrid_fwd, hipFuncAttributeMaxDynamicSharedMemorySize, LDS_BYTES) != hipSuccess) { fprintf(stderr, "kernel_launch: hipFuncSetAttribute failed\n"); grid = -1; return; }
        if (hipOccupancyMaxActiveBlocksPerMultiprocessor(&per_cu, (const void*)hybrid_fwd, NTHR, LDS_BYTES) != hipSuccess || per_cu < 1) fprintf(stderr, "kernel_launch: occupancy query says %d\n", per_cu);
        (void)hipGetLastError();
        grid = cus;
    }
    if (grid < 0) return;
    (void)hipMemsetAsync((char*)d_ws + WS_CTL, 0, CTL_ZERO_BYTES, stream);
    (void)hipMemsetAsync((char*)d_ws + WS_SLOT_TOK, 0xFF, 2 * MiB, stream);
    Args a{};
    for (int i = 0; i < 31; ++i) a.in[i] = (const float*)d_in[i];
    a.out = (float*)d_out; a.ws = (unsigned char*)d_ws; a.ph_lo = 0; a.ph_hi = 1000;
    hipLaunchKernelGGL(hybrid_fwd, dim3(grid), dim3(NTHR), LDS_BYTES, stream, a);
}
```

```cpp
#include <hip/hip_runtime.h>
#include <cstdio>
#include <cstdint>

namespace pg8 {
#define PG8_LAS __attribute__((address_space(3)))
typedef unsigned short bf16_t;
typedef short bf16x8 __attribute__((ext_vector_type(8)));
typedef float f32x4 __attribute__((ext_vector_type(4)));
typedef unsigned u32x4 __attribute__((ext_vector_type(4)));
typedef unsigned u32x2 __attribute__((ext_vector_type(2)));
constexpr int BM = 256, BK = 64, HALF = 128, HTB = HALF * BK * 2  , STAGE_BYTES = 8 * HTB, NXCD = 8, WGM = 8;

__host__ __device__ __forceinline__ int lds_byte(int r, int c) { const int st = (r >> 4) * 2 + (c >> 5), rr = r & 15, cc = c & 31, ob = rr * 64 + cc * 2; return st * 1024 + (ob ^ (((ob >> 9) & 1) << 5)); }
__host__ __device__ __forceinline__ void stage_rc(int b, int& R, int& C) { const int st = b / 1024, sb = b % 1024, swz = sb ^ (((sb >> 9) & 1) << 5); R = (st >> 1) * 16 + swz / 64; C = (st & 1) * 32 + (swz % 64) / 2; }
__host__ __device__ __forceinline__ int perm32(int rho) { const int n = rho >> 4, i = rho & 15; return 8 * (i >> 2) + 4 * n + (i & 3); }

struct Unit { int pm, pn, kq, sb; };
struct Gemm { const bf16_t* A; const bf16_t* Bt; int M, N, K, ld; };

struct StaticOrder {
    int nM, nN, nwg, G, c, wgm;
    __host__ __device__ void init(int M, int N, int G_, int c_, int wgm_ = WGM) { nM = M / BM; nN = N / BM; nwg = nM * nN; G = G_; c = c_; wgm = wgm_; }
    __host__ __device__ bool next(int i, Unit& u) const { return at((long)i * G + c, u); }
    __host__ __device__ bool at(const long L, Unit& u) const {
        if (L >= nwg) return false;
        int wgid = (int)L; { const int q = nwg / NXCD, r = nwg % NXCD, xcd = wgid % NXCD, off = wgid / NXCD; wgid = (xcd < r ? xcd * (q + 1) : r * (q + 1) + (xcd - r) * q) + off; }
        const int nig = wgm * nN, gid = wgid / nig, fm = gid * wgm, gsz = (nM - fm) < wgm ? (nM - fm) : wgm;
        u.pm = fm + ((wgid % nig) % gsz); u.pn = (wgid % nig) / gsz; u.kq = 0; u.sb = 0; return true;
    }
    __device__ __forceinline__ void a_ready(const Unit&) const {}
    __device__ __forceinline__ void done(const Unit&) const {}
};
struct ListOrder {
    StaticOrder base; int first, stride, cnt;
    __device__ __forceinline__ bool next(int i, Unit& u) const { return (i < cnt) && base.at((long)first + (long)i * stride, u); }
    __device__ __forceinline__ void a_ready(const Unit&) const {}
    __device__ __forceinline__ void done(const Unit&) const {}
};
__device__ __forceinline__ unsigned cvt_pk_bf16(float lo, float hi) { unsigned r; asm volatile("v_cvt_pk_bf16_f32 %0, %1, %2" : "=v"(r) : "v"(lo), "v"(hi)); return r; }
typedef int i32x4_ __attribute__((ext_vector_type(4))); typedef int i32x8_ __attribute__((ext_vector_type(8)));
template <class Epi, class Sched, bool ALIGN_EPI = false, bool SP2 = false, bool GATHER = false, int F8 = 0, bool I8 = false>
__device__ __forceinline__ void gemm_phase(PG8_LAS unsigned char* lds, const Gemm g, const Sched& S, const Epi& E, const int* slot_tok = nullptr) {
    static_assert(!GATHER || SP2, "row-gathered A panels: SP2 loop only");
    int tid_ = threadIdx.x; asm volatile("" : "+v"(tid_));
    const int tid = tid_, wid = __builtin_amdgcn_readfirstlane(tid >> 6), lane = tid & 63, wr = wid >> 2, wc = wid & 3, fr = lane & 15, fq = lane >> 4;
    const int K = g.K, nt = K / BK, LD = g.ld ? g.ld : g.K;
    unsigned voffA[2], voffB[2];
#pragma unroll
    for (int i = 0; i < 2; ++i) { int R, C; stage_rc(tid * 16 + i * 8192, R, C); const int Rb = Epi::PERM ? ((R & ~31) + perm32(R & 31)) : R;
        voffA[i] = (unsigned)(R * LD + C) * 2u; voffB[i] = (unsigned)(Rb * LD + C) * 2u; }
    const size_t kstep = (size_t)(BK * 2);
    const size_t hstep = (size_t)HALF * LD * 2;
    const size_t tstep = 2 * hstep;
    const unsigned ldsw = (unsigned)wid * 1024u;
    const int aoff = lds_byte(wr * 64 + fr, fq * 8), boff = lds_byte(wc * 32 + fr, fq * 8);
#define PG8_SA(b, h) (((b) * 2 + (h)) * HTB)
#define PG8_SB(b, h) ((4 + (b) * 2 + (h)) * HTB)
#define PG8_STAGE(bufoff, gbase, voff) do { _Pragma("unroll") for (int _i = 0; _i < 2; ++_i) \
        __builtin_amdgcn_global_load_lds((const unsigned*)((const char*)(gbase) + (voff)[_i]), (PG8_LAS unsigned*)(lds + (bufoff) + ldsw + _i * 8192), 16, 0, 0); } while (0)
#define PG8_LDA(dst, b, h) do { _Pragma("unroll") for (int m = 0; m < 4; ++m) _Pragma("unroll") for (int k = 0; k < 2; ++k) dst[m][k] = *(const PG8_LAS bf16x8*)(lds + PG8_SA(b, h) + aoff + m * 2048 + k * 1024); } while (0)
#define PG8_LDB(dst, b, h) do { _Pragma("unroll") for (int n = 0; n < 2; ++n) _Pragma("unroll") for (int k = 0; k < 2; ++k) dst[n][k] = *(const PG8_LAS bf16x8*)(lds + PG8_SB(b, h) + boff + n * 2048 + k * 1024); } while (0)
#define PG8_CAT(x0, x1) __builtin_shufflevector(__builtin_bit_cast(i32x4_, x0), __builtin_bit_cast(i32x4_, x1), 0, 1, 2, 3, 4, 5, 6, 7)
#define PG8_MMA(ai, bj, At, Bt) do { __builtin_amdgcn_s_setprio(1); if constexpr (F8 != 0) { _Pragma("unroll") for (int m = 0; m < 4; ++m) _Pragma("unroll") for (int n = 0; n < 2; ++n) \
        { const i32x8_ _b8 = PG8_CAT(Bt[n][0], Bt[n][1]), _a8 = PG8_CAT(At[m][0], At[m][1]); asm volatile("v_mfma_scale_f32_16x16x128_f8f6f4 %0, %1, %2, %0, %3, %3 op_sel_hi:[0,0,0]" : "+v"(acc[ai][bj][m][n]) : "v"(_b8), "v"(_a8), "v"(f8scale)); } } else { \
        _Pragma("unroll") for (int m = 0; m < 4; ++m) _Pragma("unroll") for (int n = 0; n < 2; ++n) _Pragma("unroll") for (int k = 0; k < 2; ++k) { \
        if constexpr (I8) acc[ai][bj][m][n] = __builtin_bit_cast(f32x4, __builtin_amdgcn_mfma_i32_16x16x64_i8(__builtin_bit_cast(i32x4_, Bt[n][k]), __builtin_bit_cast(i32x4_, At[m][k]), __builtin_bit_cast(i32x4_, acc[ai][bj][m][n]), 0, 0, 0)); \
        else acc[ai][bj][m][n] = __builtin_amdgcn_mfma_f32_16x16x32_bf16(Bt[n][k], At[m][k], acc[ai][bj][m][n], 0, 0, 0); } } __builtin_amdgcn_s_setprio(0); } while (0)
#define PG8_WAIT_V(n) asm volatile("s_waitcnt vmcnt(" #n ")" ::: "memory")
#define PG8_WAIT_L(n) asm volatile("s_waitcnt lgkmcnt(" #n ")" ::: "memory")
#define PG8_BAR __builtin_amdgcn_s_barrier()
#define PG8_SCHED __builtin_amdgcn_sched_barrier(0)
    int gR[2]; unsigned gC[2]; unsigned gv[2][2], gn[2][2];
#pragma unroll
    for (int i = 0; i < 2; ++i) { int R, C; stage_rc(tid * 16 + i * 8192, R, C); gR[i] = R; gC[i] = (unsigned)C * 2u; gv[0][i] = gv[1][i] = gn[0][i] = gn[1][i] = 0u; }
#define PG8_GOFF(dst, u) do { _Pragma("unroll") for (int _h = 0; _h < 2; ++_h) _Pragma("unroll") for (int _i = 0; _i < 2; ++_i) { \
        const int _tk = slot_tok[(u).sb + _h * HALF + gR[_i]]; dst[_h][_i] = (unsigned)((_tk < 0 ? 0 : (_tk >> 1)) * LD) * 2u + gC[_i]; } } while (0)
#define PG8_STAGE_A(bufoff, gbase, H, NX) do { _Pragma("unroll") for (int _i = 0; _i < 2; ++_i) { unsigned _o; const char* _b; \
        if constexpr (GATHER) { _o = (NX) ? gn[H][_i] : gv[H][_i]; _b = (const char*)(gbase); } else { _o = voffA[_i]; _b = (const char*)(gbase) + (H) * hstep; } \
        __builtin_amdgcn_global_load_lds((const unsigned*)(_b + _o), (PG8_LAS unsigned*)(lds + (bufoff) + ldsw + _i * 8192), 16, 0, 0); } } while (0)
    int f8scale = F8; asm volatile("" : "+v"(f8scale));
    Unit cur, nxt; int ui = 0;
    if (!S.next(0, cur)) return;
    if constexpr (GATHER) PG8_GOFF(gv, cur);
    f32x4 acc[2][2][4][2];
#pragma unroll
    for (int a = 0; a < 2; ++a)
#pragma unroll
        for (int b = 0; b < 2; ++b)
#pragma unroll
            for (int m = 0; m < 4; ++m)
#pragma unroll
                for (int n = 0; n < 2; ++n) acc[a][b][m][n] = (f32x4){0.f, 0.f, 0.f, 0.f};
    bf16x8 At[4][2], B0[2][2], B1[2][2];
    const char* cA = (const char*)g.A + (GATHER ? (size_t)0 : (size_t)cur.pm * tstep) + (size_t)cur.kq * 2; const char* cB = (const char*)g.Bt + (size_t)cur.pn * tstep + (size_t)cur.kq * 2;
    S.a_ready(cur);
    if constexpr (SP2) {
        PG8_STAGE(PG8_SB(0, 0), cB, voffB); PG8_STAGE(PG8_SB(0, 1), cB + hstep, voffB); PG8_STAGE_A(PG8_SA(0, 0), cA, 0, false); PG8_STAGE_A(PG8_SA(0, 1), cA, 1, false);
        if (wr == 1) PG8_BAR;
        PG8_WAIT_V(2); PG8_BAR;
        PG8_STAGE(PG8_SB(1, 0), cB + kstep, voffB); PG8_STAGE_A(PG8_SA(1, 0), cA + kstep, 0, false); PG8_STAGE(PG8_SB(1, 1), cB + hstep + kstep, voffB);
        PG8_WAIT_V(6); PG8_BAR;
    } else {
        PG8_STAGE(PG8_SB(0, 0), cB, voffB); PG8_STAGE(PG8_SA(0, 0), cA, voffA); PG8_STAGE(PG8_SB(0, 1), cB + hstep, voffB); PG8_STAGE(PG8_SA(0, 1), cA + hstep, voffA);
        if (wr == 1) PG8_BAR;
        PG8_WAIT_V(4); PG8_BAR;
        PG8_STAGE(PG8_SB(1, 0), cB + kstep, voffB); PG8_STAGE(PG8_SA(1, 0), cA + kstep, voffA); PG8_STAGE(PG8_SB(1, 1), cB + hstep + kstep, voffB);
        PG8_WAIT_V(6); PG8_BAR;
    }
    for (;;) {
        const bool has_next = S.next(ui + 1, nxt);
        const char* nA = has_next ? (const char*)g.A + (GATHER ? (size_t)0 : (size_t)nxt.pm * tstep) + (size_t)nxt.kq * 2 : cA; const char* nB = has_next ? (const char*)g.Bt + (size_t)nxt.pn * tstep + (size_t)nxt.kq * 2 : cB;
        for (int t = 0; t < nt; t += 2) {
            const bool last = (t == nt - 2);
            const char* a1 = cA + (size_t)(t + 1) * kstep;
            const char* a2 = last ? nA : cA + (size_t)(t + 2) * kstep; const char* b2 = last ? nB : cB + (size_t)(t + 2) * kstep;
            const char* a3 = a2 + kstep; const char* b3 = b2 + kstep;
            if (last && has_next) { S.a_ready(nxt); if constexpr (GATHER) PG8_GOFF(gn, nxt); }
            const bool nx = last && has_next;
            if constexpr (SP2) {
            PG8_LDB(B0, 0, 0); PG8_LDB(B1, 0, 1); PG8_SCHED; PG8_LDA(At, 0, 0); PG8_STAGE_A(PG8_SA(1, 1), a1, 1, false);
            PG8_WAIT_V(8); PG8_WAIT_L(0); PG8_BAR; PG8_MMA(0, 0, At, B0); PG8_MMA(0, 1, At, B1); PG8_BAR; PG8_SCHED;
            PG8_LDA(At, 0, 1); PG8_STAGE(PG8_SB(0, 0), b2, voffB); PG8_STAGE(PG8_SB(0, 1), b2 + hstep, voffB); PG8_STAGE_A(PG8_SA(0, 0), a2, 0, nx);
            PG8_WAIT_V(8); PG8_WAIT_L(0); PG8_BAR; PG8_MMA(1, 0, At, B0); PG8_MMA(1, 1, At, B1); PG8_BAR; PG8_SCHED;
            PG8_LDB(B0, 1, 0); PG8_LDB(B1, 1, 1); PG8_SCHED; PG8_LDA(At, 1, 0); PG8_STAGE_A(PG8_SA(0, 1), a2, 1, nx);
            PG8_WAIT_V(8); PG8_WAIT_L(0); PG8_BAR; PG8_MMA(0, 0, At, B0); PG8_MMA(0, 1, At, B1); PG8_BAR; PG8_SCHED;
            PG8_LDA(At, 1, 1); PG8_STAGE(PG8_SB(1, 0), b3, voffB); PG8_STAGE(PG8_SB(1, 1), b3 + hstep, voffB); PG8_STAGE_A(PG8_SA(1, 0), a3, 0, nx);
            PG8_WAIT_V(8); PG8_WAIT_L(0); PG8_BAR; PG8_MMA(1, 0, At, B0); PG8_MMA(1, 1, At, B1); PG8_BAR; PG8_SCHED;
            } else {
            PG8_LDB(B0, 0, 0); PG8_SCHED; PG8_LDA(At, 0, 0); PG8_STAGE(PG8_SA(1, 1), a1 + hstep, voffA);
            PG8_WAIT_L(8); PG8_BAR; PG8_WAIT_L(0); PG8_MMA(0, 0, At, B0); PG8_BAR; PG8_SCHED;
            PG8_LDB(B1, 0, 1); PG8_STAGE(PG8_SB(0, 0), b2, voffB);
            PG8_BAR; PG8_WAIT_L(0); PG8_MMA(0, 1, At, B1); PG8_BAR;
            PG8_LDA(At, 0, 1); PG8_STAGE(PG8_SA(0, 0), a2, voffA);
            PG8_BAR; PG8_WAIT_L(0); PG8_MMA(1, 0, At, B0); PG8_BAR; PG8_SCHED;
            PG8_STAGE(PG8_SB(0, 1), b2 + hstep, voffB);
            PG8_WAIT_V(6); PG8_BAR; PG8_MMA(1, 1, At, B1); PG8_BAR;
            PG8_LDB(B0, 1, 0); PG8_SCHED; PG8_LDA(At, 1, 0); PG8_STAGE(PG8_SA(0, 1), a2 + hstep, voffA);
            PG8_WAIT_L(8); PG8_BAR; PG8_WAIT_L(0); PG8_MMA(0, 0, At, B0); PG8_BAR; PG8_SCHED;
            PG8_LDB(B1, 1, 1); PG8_STAGE(PG8_SB(1, 0), b3, voffB);
            PG8_BAR; PG8_WAIT_L(0); PG8_MMA(0, 1, At, B1); PG8_BAR;
            PG8_LDA(At, 1, 1); PG8_STAGE(PG8_SA(1, 0), a3, voffA);
            PG8_BAR; PG8_WAIT_L(0); PG8_MMA(1, 0, At, B0); PG8_BAR; PG8_SCHED;
            PG8_STAGE(PG8_SB(1, 1), b3 + hstep, voffB);
            PG8_WAIT_V(6); PG8_BAR; PG8_MMA(1, 1, At, B1); PG8_BAR;
            }
        }
        if constexpr (F8 != 0) { asm volatile("s_nop 15\n\ts_nop 15\n\ts_nop 15" ::: "memory"); }
        if constexpr (ALIGN_EPI) { if (wr == 0) PG8_BAR; }
        bool keep_acc = false;
        if constexpr (!Epi::AFTER_DRAIN) { if constexpr (Epi::HAS_MID) { if (cur.kq == 0) { E.mid(acc, cur, wr, wc, fr, fq); keep_acc = true; } else E(acc, cur, wr, wc, fr, fq); } else E(acc, cur, wr, wc, fr, fq); S.done(cur); }
        if (!has_next) break;
        if (!keep_acc)
#pragma unroll
        for (int a = 0; a < 2; ++a)
#pragma unroll
            for (int b = 0; b < 2; ++b)
#pragma unroll
                for (int m = 0; m < 4; ++m)
#pragma unroll
                    for (int n = 0; n < 2; ++n) acc[a][b][m][n] = (f32x4){0.f, 0.f, 0.f, 0.f};
        cur = nxt; cA = nA; cB = nB; ++ui;
        if constexpr (GATHER) { _Pragma("unroll") for (int _h = 0; _h < 2; ++_h) _Pragma("unroll") for (int _i = 0; _i < 2; ++_i) gv[_h][_i] = gn[_h][_i]; }
        if constexpr (ALIGN_EPI) { if (wr == 1) PG8_BAR; }
    }
    PG8_WAIT_V(0);
    if constexpr (!ALIGN_EPI) { if (wr == 0) PG8_BAR; }
    PG8_BAR;
    if constexpr (Epi::AFTER_DRAIN) { E.fused(acc, cur, wr, wc, fr, fq, lds, wid, lane); S.done(cur); }
#undef PG8_SA
#undef PG8_SB
#undef PG8_STAGE
#undef PG8_STAGE_A
#undef PG8_GOFF
#undef PG8_LDA
#undef PG8_LDB
#undef PG8_MMA
#undef PG8_CAT
#undef PG8_WAIT_V
#undef PG8_WAIT_L
#undef PG8_BAR
#undef PG8_SCHED
}
}

constexpr int NWAVES = 8, NTHR = 512;
constexpr int NTOK = 8192, SEQ = 4096, DM = 2048;
constexpr int INW = 8992, INP = 9216;
constexpr int C_Q = 0, C_K = 1024, C_V = 1280, C_Z = 1536, C_ZV = 4896, C_GATE = 5120;
constexpr float IN_WCLIP = 5.f * 0.0220970869f  , IN_WS = 127.f / IN_WCLIP;
constexpr size_t WIN8_OFF = (size_t)C_GATE * 2048 * 2;
constexpr int GATE_SHIFT = C_GATE - 4896;
constexpr int ZW = 3360;
constexpr int NEXP = 32, EH = 512, MAXSLOT = 16384 + 32 * 256, MAXPANEL = MAXSLOT / 256;
constexpr float NORM_EPS = 1e-5f, GN_EPS = 64e-5f;
constexpr float LOG2E = 1.4426950408889634f;

constexpr size_t MiB = 1u << 20;
constexpr size_t WS_CTL = 0, CTL_ZERO_BYTES = 1 * MiB;
constexpr size_t WS_WIN_T = 2 * MiB;
constexpr size_t WS_WA_T = 38 * MiB;
constexpr size_t WS_WB_T = 42 * MiB;
constexpr size_t WS_WOUT_T = 46 * MiB;
constexpr size_t WS_LORA = 54 * MiB;
constexpr size_t WS_WGU_T = 56 * MiB;
constexpr size_t WS_WD_T = 184 * MiB;
constexpr size_t WS_X = 248 * MiB;
constexpr size_t WS_H = 312 * MiB;
constexpr size_t WS_PROJ = 344 * MiB;
constexpr size_t WS_ATTN = 488 * MiB;
constexpr size_t WS_SCAN = 504 * MiB;
constexpr size_t WS_G = 696 * MiB;
constexpr size_t WS_VFIRST = 728 * MiB;
constexpr size_t WS_Y = 760 * MiB;
constexpr size_t WS_YB = 792 * MiB;
constexpr size_t WS_TMP = 808 * MiB;
constexpr size_t WS_MERGED = 872 * MiB;
constexpr size_t WS_ROUTE = 904 * MiB;
constexpr size_t WS_END = 905 * MiB;
constexpr size_t WS_XG = WS_PROJ;
constexpr size_t WS_SLOT_TOK = WS_Y, WS_SLOT_W = WS_Y + 2 * MiB, WS_H8 = WS_ATTN  , WS_ASC = WS_Y + 7 * MiB  , WS_RSTD = WS_Y + 6 * MiB  ;
constexpr int ECAP = 8192;
constexpr size_t WS_HID = WS_PROJ + 96 * MiB;
constexpr size_t WS_MOEOUT = WS_SCAN;
constexpr size_t WS_GATE8 = WS_SCAN + 96 * MiB;
constexpr size_t WS_AY = WS_SCAN + 64 * MiB;
static_assert(WS_HID + (size_t)MAXSLOT * EH * 2 <= WS_ATTN, "hid overlay");
constexpr size_t SCAN_STRIDE = (size_t)NTOK * 1024;
constexpr size_t LO_WUP = 0, LO_AUP = 65536, LO_GUP = 131072, LO_VUP = 131072 + 163840, LO_RH = 327680 + 0, LO_RL = LO_RH + 48 * 2048;
static_assert((LO_RL + 48 * 2048) * 2 <= 2 * MiB, "lora region");
constexpr size_t RT_E = 0, RT_POS = 65536, RT_W = 131072, RT_SLOT_TOK = 196608, RT_SLOT_W = 196608 + 98304;

constexpr int CW_BAR = 4096;
constexpr int CW_CNT = 8192;

constexpr int RING_BYTES = 131072;
constexpr int LDSCTL_OFF = RING_BYTES;
constexpr int LDS_PANEL = LDSCTL_OFF + 64, LDS_TAB = LDSCTL_OFF + 1024, LDS_PSB = LDSCTL_OFF + 1536, LDS_PTRS = LDSCTL_OFF + 2048;
constexpr int LDS_BYTES = 147456;

#define GAS __attribute__((address_space(1)))
#define LAS __attribute__((address_space(3)))
typedef unsigned short bf16;
typedef unsigned v4u __attribute__((ext_vector_type(4)));
typedef unsigned v2u __attribute__((ext_vector_type(2)));
typedef float f32x4 __attribute__((ext_vector_type(4)));
typedef float f32x2 __attribute__((ext_vector_type(2)));
typedef float f32x16 __attribute__((ext_vector_type(16)));
typedef short bf16x8 __attribute__((ext_vector_type(8)));
typedef short s16x4 __attribute__((ext_vector_type(4)));
#define LDS_WAIT() asm volatile("s_waitcnt lgkmcnt(0)" ::: "memory")
#define VM_WAIT() asm volatile("s_waitcnt vmcnt(0)" ::: "memory")
__device__ __forceinline__ unsigned f2bf(float f) { unsigned u = __builtin_bit_cast(unsigned, f); return (u + 0x7fffu + ((u >> 16) & 1u)) >> 16; }
__device__ __forceinline__ unsigned pk2(float lo, float hi) { return f2bf(lo) | (f2bf(hi) << 16); }
__device__ __forceinline__ float bflo(unsigned u) { return __builtin_bit_cast(float, u << 16); }
__device__ __forceinline__ float bfhi(unsigned u) { return __builtin_bit_cast(float, u & 0xffff0000u); }
__device__ __forceinline__ float rcpf_(float x) { return __builtin_amdgcn_rcpf(x); }
__device__ __forceinline__ float sigmoidf_(float x) { return __builtin_amdgcn_rcpf(1.f + __expf(-x)); }

#define XB_TMO      128
#define XB_XCNT(j)  (256  + 64 * (j))
#define XB_XSUB(j)  (1280 + 64 * (j))
#define XB_XGEN(j)  (2304 + 64 * (j))
#define XB_TOP      3328
#define XB_TOPGEN   3392
#define XCD_BAR_WORDS 3456
#define XB_SPIN_CAP (1u << 18)

__device__ __forceinline__ unsigned xb_ld(unsigned* p)              { return __hip_atomic_load(p, __ATOMIC_RELAXED, __HIP_MEMORY_SCOPE_AGENT); }
__device__ __forceinline__ unsigned xb_add(unsigned* p, unsigned v) { return __hip_atomic_fetch_add(p, v, __ATOMIC_RELAXED, __HIP_MEMORY_SCOPE_AGENT); }
__device__ __forceinline__ unsigned xb_xcc_id() { return (unsigned)__builtin_amdgcn_s_getreg((3 << 11) | 20) & 0xFu; }
#define XB_SPIN(cond, bar) do { unsigned _sp = 0; while (cond) { __builtin_amdgcn_s_sleep(1); \
    if ((++_sp & 255u) == 0u) { if (xb_ld(&(bar)[XB_TMO])) break; if (_sp > XB_SPIN_CAP) { atomicAdd(&(bar)[XB_TMO], 1u); break; } } } } while (0)

struct XcdBarrier {
    unsigned* bar; unsigned x;
    volatile LAS unsigned* st;
};
__device__ __forceinline__ XcdBarrier xcd_barrier_post(unsigned* bar, volatile LAS unsigned* st) {
    XcdBarrier b; b.bar = bar; b.x = xb_xcc_id(); b.st = st;
    if (threadIdx.x == 0) (void)xb_add(&bar[XB_XCNT(b.x)], 1u);
    return b;
}
__device__ __forceinline__ void xcd_barrier_complete(unsigned* bar, unsigned x, unsigned& nloc, unsigned& nx) {
    const unsigned G = gridDim.x * gridDim.y * gridDim.z;
    unsigned sum, cnt, mine, sp = 0u;
    for (;;) {
        sum = 0u; cnt = 0u; mine = 0u;
#pragma unroll
        for (unsigned j = 0; j < 16; ++j) { const unsigned c = xb_ld(&bar[XB_XCNT(j)]); sum += c; cnt += (c > 0u) ? 1u : 0u; mine = (j == x) ? c : mine; }
        if (sum == G) break;
        __builtin_amdgcn_s_sleep(1);
        if ((++sp & 255u) == 0u) { if (xb_ld(&bar[XB_TMO])) break; if (sp > XB_SPIN_CAP) { atomicAdd(&bar[XB_TMO], 1u); break; } }
    }
    nloc = mine > 0u ? mine : 1u; nx = cnt > 0u ? cnt : 1u;
}
__device__ __forceinline__ void xcd_barrier(const XcdBarrier& b) {
    asm volatile("s_waitcnt vmcnt(0)" ::: "memory");
    __syncthreads();
    if (threadIdx.x == 0) {
        unsigned* bar = b.bar;
        __builtin_amdgcn_s_waitcnt(0);
        unsigned nloc = b.st[0], nx = b.st[1];
        if (nloc == 0u) { xcd_barrier_complete(bar, b.x, nloc, nx); b.st[0] = nloc; b.st[1] = nx; }
        const unsigned old = xb_add(&bar[XB_XSUB(b.x)], 1u);
        const unsigned gen = old / nloc;
        if (old + 1u == (gen + 1u) * nloc) {
            __builtin_amdgcn_fence(__ATOMIC_RELEASE, "agent");
            asm volatile("s_waitcnt vmcnt(0)" ::: "memory");
            const unsigned og = xb_add(&bar[XB_TOP], 1u);
            const unsigned tg = og / nx;
            if (og + 1u == (tg + 1u) * nx) xb_add(&bar[XB_TOPGEN], 1u);
            else XB_SPIN(xb_ld(&bar[XB_TOPGEN]) == tg, bar);
            __builtin_amdgcn_fence(__ATOMIC_ACQUIRE, "agent");
            xb_add(&bar[XB_XGEN(b.x)], 1u);
            asm volatile("s_waitcnt vmcnt(0)" ::: "memory");
        } else {
            XB_SPIN(xb_ld(&bar[XB_XGEN(b.x)]) == gen, bar);
            __builtin_amdgcn_fence(__ATOMIC_ACQUIRE, "agent");
            asm volatile("s_waitcnt vmcnt(0)" ::: "memory");
        }
    }
    __syncthreads();
}

struct Frame {
    LAS unsigned char* lds;
    unsigned* ctl;
    unsigned char* ws;
    const float* const* in;
    int tid, lane, wave, vcu, G;
};
__device__ __forceinline__ float wave_max(float v) {
#pragma unroll
    for (int o = 1; o < 64; o <<= 1) v = fmaxf(v, __shfl_xor(v, o));
    return v;
}
__device__ __forceinline__ unsigned pack_i8x4(float a, float b, float c, float d) {
    const int ia = (int)fminf(fmaxf(rintf(a), -127.f), 127.f), ib = (int)fminf(fmaxf(rintf(b), -127.f), 127.f), ic = (int)fminf(fmaxf(rintf(c), -127.f), 127.f), id = (int)fminf(fmaxf(rintf(d), -127.f), 127.f);
    return ((unsigned)ia & 255u) | (((unsigned)ib & 255u) << 8) | (((unsigned)ic & 255u) << 16) | ((unsigned)id << 24);
}
__device__ __forceinline__ float wave_sum(float v) {
#pragma unroll
    for (int o = 1; o < 64; o <<= 1) v += __shfl_xor(v, o);
    return v;
}
#ifndef F8_GATE
#define F8_GATE 0
#endif
#ifndef F8_MRG
#define F8_MRG 0
#endif
#ifndef F8_OUT
#define F8_OUT 1
#endif
#ifndef F8_MOE
#define F8_MOE 1
#endif
#ifndef F8_IN
#define F8_IN 2
#endif

constexpr int TS = 68;
__device__ __forceinline__ void transpose_item(const float* W, int K, int N, bf16* WT, int ldk, int row_off, int mode, LAS bf16* scr, int item, int lane, const float* ksc = nullptr, float f8 = 0.f) {
    const int nblk = (N + 63) / 64, kb = item / nblk, nb = item - kb * nblk, k0 = 64 * kb, n0 = 64 * nb;
    const int lr = lane >> 4, lc = 4 * (lane & 15);
    const bool cv = (n0 + lc) < N;
    f32x4 v[16];
#pragma unroll
    for (int i = 0; i < 16; ++i) { v[i] = (f32x4){0.f, 0.f, 0.f, 0.f}; if (cv) v[i] = __builtin_nontemporal_load((const GAS f32x4*)(W + (size_t)(k0 + 4 * i + lr) * N + n0 + lc)); }
    if (ksc) {
#pragma unroll
        for (int i = 0; i < 16; ++i) v[i] = v[i] * ksc[k0 + 4 * i + lr]; }
    if (f8 != 0.f) { const float f8a = fabsf(f8);
#pragma unroll
        for (int i = 0; i < 16; ++i) v[i] = v[i] * f8a; }
    const bool g8 = F8_GATE && (mode == 3);
    if (g8 && (n0 + lc) >= 4896) {
#pragma unroll
        for (int i = 0; i < 16; ++i) v[i] = v[i] * 64.f; }
#pragma unroll
    for (int i = 0; i < 16; ++i) { v2u o; o.x = pk2(v[i].x, v[i].y); o.y = pk2(v[i].z, v[i].w); *(LAS v2u*)(scr + (4 * i + lr) * TS + lc) = o; }
    LDS_WAIT(); asm volatile("" ::: "memory");
    const int c = lane & 7;
#pragma unroll
    for (int j = 0; j < 8; ++j) { const int n = (lane >> 3) + 8 * j; const LAS bf16* s = scr + (8 * c) * TS + n;
        v4u o; o.x = (unsigned)s[0 * TS] | ((unsigned)s[1 * TS] << 16); o.y = (unsigned)s[2 * TS] | ((unsigned)s[3 * TS] << 16); o.z = (unsigned)s[4 * TS] | ((unsigned)s[5 * TS] << 16); o.w = (unsigned)s[6 * TS] | ((unsigned)s[7 * TS] << 16);
        const int nn = n0 + n; const int orow = (mode == 0) ? (row_off + nn) : (mode == 3) ? (nn + ((nn >= 4896) ? GATE_SHIFT : 0)) : (((nn >> 2) << 3) + (nn & 3) + ((mode == 2) ? 4 : 0));
        if (f8 < 0.f) { v2u o8; o8.x = pack_i8x4(bflo(o.x), bfhi(o.x), bflo(o.y), bfhi(o.y)); o8.y = pack_i8x4(bflo(o.z), bfhi(o.z), bflo(o.w), bfhi(o.w));
            if (nn < N) *(GAS v2u*)((GAS unsigned char*)WT + (size_t)orow * ldk + k0 + 8 * c) = o8; }
        else if (f8 != 0.f || (g8 && nn >= 4896)) { int lo8 = 0, hi8 = 0; unsigned char* W8 = (unsigned char*)WT; size_t r8 = (size_t)orow;
            if (g8) { W8 += WIN8_OFF; r8 = (size_t)(nn - 4896); }
            lo8 = __builtin_amdgcn_cvt_pk_fp8_f32(bflo(o.x), bfhi(o.x), lo8, false); lo8 = __builtin_amdgcn_cvt_pk_fp8_f32(bflo(o.y), bfhi(o.y), lo8, true);
            hi8 = __builtin_amdgcn_cvt_pk_fp8_f32(bflo(o.z), bfhi(o.z), hi8, false); hi8 = __builtin_amdgcn_cvt_pk_fp8_f32(bflo(o.w), bfhi(o.w), hi8, true);
            v2u o8; o8.x = (unsigned)lo8; o8.y = (unsigned)hi8;
            if (nn < N) *(GAS v2u*)((GAS unsigned char*)W8 + r8 * ldk + k0 + 8 * c) = o8; }
        else if (nn < N) __builtin_nontemporal_store(o, (GAS v4u*)(WT + (size_t)orow * ldk + k0 + 8 * c)); }
    LDS_WAIT(); asm volatile("" ::: "memory");
}

struct In {
    const float *x, *attn_norm_w, *w_in, *shift_mix, *sinks, *w0, *w_up, *a0, *a_up, *g_up, *k_k, *k_a, *r_k, *ln_w, *ln_b,
                *vres_down, *vres_mix, *vres_up, *vres_v0, *w_a, *w_b, *w_out, *ffn_norm_w, *rg_w, *rg_b, *re_w, *re_b, *e_gate, *e_up, *e_down, *final_w;
};

__device__ __forceinline__ const float* ldptr(const Frame& F, int k) {
    const LAS unsigned* p = (const LAS unsigned*)(F.lds + LDS_PTRS) + 2 * k;
    const unsigned lo = __builtin_amdgcn_readfirstlane(p[0]), hi = __builtin_amdgcn_readfirstlane(p[1]);
    return (const float*)(((unsigned long long)hi << 32) | lo); }
__device__ __forceinline__ In load_in(const Frame& F) {
    In I;
    I.x = ldptr(F, 0); I.attn_norm_w = ldptr(F, 1); I.w_in = ldptr(F, 2); I.shift_mix = ldptr(F, 3); I.sinks = ldptr(F, 4); I.w0 = ldptr(F, 5); I.w_up = ldptr(F, 6); I.a0 = ldptr(F, 7);
    I.a_up = ldptr(F, 8); I.g_up = ldptr(F, 9); I.k_k = ldptr(F, 10); I.k_a = ldptr(F, 11); I.r_k = ldptr(F, 12); I.ln_w = ldptr(F, 13); I.ln_b = ldptr(F, 14); I.vres_down = ldptr(F, 15);
    I.vres_mix = ldptr(F, 16); I.vres_up = ldptr(F, 17); I.vres_v0 = ldptr(F, 18); I.w_a = ldptr(F, 19); I.w_b = ldptr(F, 20); I.w_out = ldptr(F, 21); I.ffn_norm_w = ldptr(F, 22);
    I.rg_w = ldptr(F, 23); I.rg_b = ldptr(F, 24); I.re_w = ldptr(F, 25); I.re_b = ldptr(F, 26); I.e_gate = ldptr(F, 27); I.e_up = ldptr(F, 28); I.e_down = ldptr(F, 29); I.final_w = ldptr(F, 30);
    return I; }
constexpr int CV_IN = 32 * 141, CV_VD = 32, CV_BR = 16 * 32, CV_OUT = 32 * 32, CV_EX = 256, CV_MOE = 3 * NEXP * CV_EX;
__device__ __forceinline__ int conv_dense_items(int l) { return CV_IN + ((l == 1) ? CV_VD : 0) + 2 * CV_BR + CV_OUT; }
__device__ __forceinline__ void conv_items(const Frame& F, const In& I, int l, int lo, int hi, int rank, int nwg) {
    LAS bf16* scr = (LAS bf16*)(F.lds + F.wave * 16384);
    bf16* win_t = (bf16*)(F.ws + WS_WIN_T);
    const int n_vd = (l == 1) ? CV_VD : 0;
    for (int it = lo + rank * NWAVES + F.wave; it < hi; it += nwg * NWAVES) {
        int r = it; const float* src; bf16* dst; const float* ksc = nullptr; float f8 = 0.f; int K, N, roff = 0, mode = 0, ldk = 0;
        if (r < CV_IN) { src = I.w_in + (size_t)l * DM * INW; K = DM; N = INW; dst = win_t; mode = 3; f8 = (F8_IN == 2) ? -IN_WS : F8_IN ? 64.f : 0.f; }
        else if ((r -= CV_IN) < n_vd) { src = I.vres_down; K = DM; N = 32; dst = win_t; roff = C_ZV; f8 = (F8_IN == 2) ? -IN_WS : F8_IN ? 64.f : 0.f; }
        else if ((r -= n_vd) < CV_BR) { src = I.w_a + (size_t)l * 1024 * DM; K = 1024; N = DM; dst = (bf16*)(F.ws + WS_WA_T); ldk = 2048; f8 = F8_MRG ? 64.f : 0.f; }
        else if ((r -= CV_BR) < CV_BR) { src = I.w_b + (size_t)l * 1024 * DM; K = 1024; N = DM; dst = (bf16*)(F.ws + WS_WA_T + 1024 * (F8_MRG ? 1 : 2)); ldk = 2048; f8 = F8_MRG ? 64.f : 0.f; }
        else if ((r -= CV_BR) < CV_OUT) { src = I.w_out + (size_t)l * DM * DM; K = DM; N = DM; dst = (bf16*)(F.ws + WS_WOUT_T); f8 = F8_OUT ? 64.f : 0.f; }
        else { r -= CV_OUT; const int kind = r / (NEXP * CV_EX); r -= kind * (NEXP * CV_EX); const int e = r / CV_EX; r -= e * CV_EX;
            constexpr size_t EB = F8_MOE ? 1 : 2;
            if (kind == 0)      { src = I.e_gate + ((size_t)l * NEXP + e) * DM * EH; K = DM; N = EH; dst = (bf16*)(F.ws + WS_WGU_T + (size_t)e * 1024 * DM * EB); mode = 1; ksc = I.ffn_norm_w + l * DM; f8 = F8_MOE ? 64.f : 0.f; }
            else if (kind == 1) { src = I.e_up   + ((size_t)l * NEXP + e) * DM * EH; K = DM; N = EH; dst = (bf16*)(F.ws + WS_WGU_T + (size_t)e * 1024 * DM * EB); mode = 2; ksc = I.ffn_norm_w + l * DM; f8 = F8_MOE ? 64.f : 0.f; }
            else                { src = I.e_down + ((size_t)l * NEXP + e) * EH * DM; K = EH; N = DM; dst = (bf16*)(F.ws + WS_WD_T + (size_t)e * DM * EH * EB); f8 = F8_MOE ? 32.f : 0.f; } }
        transpose_item(src, K, N, dst, ldk ? ldk : K, roff, mode, scr, r, F.lane, ksc, f8);
    }
}
__device__ __forceinline__ void conv_small(const Frame& F, const In& I, int l) {
    const int gw = F.vcu * NWAVES + F.wave, NGW = F.G * NWAVES;
    bf16* win_t = (bf16*)(F.ws + WS_WIN_T);
    { const int r0 = C_ZV + ((l == 1) ? 32 : 0); const size_t n16 = (size_t)(C_GATE - r0) * DM * (F8_IN ? 1 : 2) / 16; GAS v4u* z = (GAS v4u*)((GAS unsigned char*)win_t + (size_t)r0 * DM * (F8_IN ? 1 : 2));
      for (size_t i = (size_t)gw * 64 + F.lane; i < n16; i += (size_t)NGW * 64) z[i] = (v4u){0u, 0u, 0u, 0u}; }
    bf16* lo = (bf16*)(F.ws + WS_LORA);
    const int gt = gw * 64 + F.lane, NGT = NGW * 64;
    for (int i = gt; i < 1024 * 64; i += NGT) { const int n = i >> 6, k = i & 63;
        lo[LO_WUP + i] = (bf16)f2bf(I.w_up[(size_t)l * 65536 + k * 1024 + n]); lo[LO_AUP + i] = (bf16)f2bf(I.a_up[(size_t)l * 65536 + k * 1024 + n]); }
    for (int i = gt; i < 1024 * 160; i += NGT) { const int n = i / 160, k = i % 160; lo[LO_GUP + i] = (bf16)f2bf(I.g_up[(size_t)l * 163840 + k * 1024 + n]); }
    if (l == 1) for (int i = gt; i < 1024 * 32; i += NGT) { const int n = i >> 5, k = i & 31; lo[LO_VUP + i] = (bf16)f2bf(I.vres_up[k * 1024 + n]); }
    for (int i = gt; i < 48 * 2048; i += NGT) { const int n = i >> 11, k = i & 2047;
        const float v = ((n < 32) ? I.re_w[(size_t)l * 65536 + k * 32 + n] : ((n < 36) ? I.rg_w[(size_t)l * 8192 + k * 4 + (n - 32)] : 0.f)) * I.ffn_norm_w[l * DM + k];
        const unsigned h = f2bf(v); lo[LO_RH + i] = (bf16)h; lo[LO_RL + i] = (bf16)f2bf(v - bflo(h)); }
}
#ifndef CV_B1
#define CV_B1 9216
#endif
#ifndef CV_B2
#define CV_B2 16384
#endif
__device__ __forceinline__ int conv_first_items(int l, int G) { return (G == 256) ? CV_IN + ((l == 1) ? CV_VD : 0) : conv_dense_items(l); }
__device__ __forceinline__ void conv_phase(const Frame& F, const In& I, int l, int lo = 0) {
    conv_items(F, I, l, lo, conv_first_items(l, F.G), F.vcu, F.G); conv_small(F, I, l);
}
__device__ __forceinline__ int moe_r2(int np, int G) { const int n_up = np * 4; return (n_up > G) ? ((n_up - G < G / 2) ? n_up - G : G / 2) : 0; }
__device__ __forceinline__ int moe_n_early(int np, int G) {
    const int R2 = moe_r2(np, G), avail = ((np < G / 4) ? np : G / 4) * 8, nd = np * 8, W = G - R2;
    int best = 0, bestc = 1 << 30;
#pragma unroll
    for (int r = 2; r <= 3; ++r) { int ne = r * W; if (ne > avail) ne = avail; const int zr = (nd - ne + G - 1) / G; const int yc = (R2 > 0 && r * 10 < 22) ? 22 : r * 10; const int c = yc + zr * 10; if (c < bestc) { bestc = c; best = ne; } }
    return best; }
__device__ __forceinline__ int cv_z_idle(int np, int G) { const int n_late = np * 8 - moe_n_early(np, G); const int rem = n_late % G; return (n_late > 0 && rem != 0) ? G - rem : 0; }
__device__ __forceinline__ int cv_z_items(int np, int G) { const int idle = cv_z_idle(np, G); const int n = idle * 16; const int d = conv_first_items(1, G); return n < d ? n : d; }

__device__ __forceinline__ void rms_row_bf16(const float* xrow, const float* w, bf16* orow, int lane, unsigned char* orow8 = nullptr, float* asc = nullptr) {
    const GAS f32x4* xr = (const GAS f32x4*)xrow + lane; const GAS f32x4* wr = (const GAS f32x4*)w + lane;
    f32x4 v[8]; float s = 0.f;
#pragma unroll
    for (int j = 0; j < 8; ++j) { v[j] = __builtin_nontemporal_load(xr + 64 * j); s += (v[j].x * v[j].x + v[j].y * v[j].y) + (v[j].z * v[j].z + v[j].w * v[j].w); }
    const float rstd = __builtin_amdgcn_rsqf(wave_sum(s) * (1.f / DM) + NORM_EPS);
    if (F8_GATE) { GAS unsigned* o4 = (GAS unsigned*)orow8 + lane;
#pragma unroll
        for (int j = 0; j < 8; ++j) { const f32x4 ww = wr[64 * j]; int p = 0; p = __builtin_amdgcn_cvt_pk_fp8_f32(v[j].x * rstd * ww.x, v[j].y * rstd * ww.y, p, false); p = __builtin_amdgcn_cvt_pk_fp8_f32(v[j].z * rstd * ww.z, v[j].w * rstd * ww.w, p, true); o4[64 * j] = (unsigned)p; } }
    if (F8_IN == 2) { GAS unsigned* o4 = (GAS unsigned*)orow + lane; float mx = 0.f; f32x4 hv[8];
#pragma unroll
        for (int j = 0; j < 8; ++j) { hv[j] = v[j] * rstd * wr[64 * j]; mx = fmaxf(mx, fmaxf(fmaxf(fabsf(hv[j].x), fabsf(hv[j].y)), fmaxf(fabsf(hv[j].z), fabsf(hv[j].w)))); }
        mx = fmaxf(wave_max(mx), 1e-20f); const float qs = 127.f / mx;
#pragma unroll
        for (int j = 0; j < 8; ++j) o4[64 * j] = pack_i8x4(hv[j].x * qs, hv[j].y * qs, hv[j].z * qs, hv[j].w * qs);
        if (lane == 0) *asc = mx * (1.f / (127.f * IN_WS));
        return; }
    if (F8_IN) { GAS unsigned* o4 = (GAS unsigned*)orow + lane;
#pragma unroll
        for (int j = 0; j < 8; ++j) { const f32x4 ww = wr[64 * j]; int p = 0; p = __builtin_amdgcn_cvt_pk_fp8_f32(v[j].x * rstd * ww.x, v[j].y * rstd * ww.y, p, false); p = __builtin_amdgcn_cvt_pk_fp8_f32(v[j].z * rstd * ww.z, v[j].w * rstd * ww.w, p, true); o4[64 * j] = (unsigned)p; }
        return; }
    GAS v2u* o8 = (GAS v2u*)orow + lane;
#pragma unroll
    for (int j = 0; j < 8; ++j) { const f32x4 ww = wr[64 * j]; v2u o; o.x = pk2(v[j].x * rstd * ww.x, v[j].y * rstd * ww.y); o.y = pk2(v[j].z * rstd * ww.z, v[j].w * rstd * ww.w); o8[64 * j] = o; }
}
#ifndef ROW_LOCAL
#define ROW_LOCAL 0
#endif
__device__ __forceinline__ int row_of(int gw, int r, int NGW) { return (ROW_LOCAL && NGW == 2048) ? 4 * gw + r : gw + r * NGW; }
__device__ __forceinline__ void norm_phase(const Frame& F, const float* x, const float* w, bf16* out) {
    const int gw = F.vcu * NWAVES + F.wave, NGW = F.G * NWAVES;
    for (int r = 0; r * NGW < NTOK; ++r) { const int m = row_of(gw, r, NGW); if (m < NTOK) rms_row_bf16(x + (size_t)m * DM, w, (bf16*)((unsigned char*)out + (size_t)m * DM * (F8_IN ? 1 : 2)), F.lane, F.ws + WS_H8 + (size_t)m * DM, (float*)(F.ws + WS_ASC) + m); }
}

namespace pg8 {
struct EpiStoreBf16 {
    static constexpr bool PERM = true, AFTER_DRAIN = false, HAS_MID = false;
    bf16_t* O; int ldc; unsigned char* G8; int pn0; const float* asc;
    static __device__ __forceinline__ f32x4 cvt_acc(const f32x4 a, float s, bool isint) { if (!isint) return a; const i32x4_ q = __builtin_bit_cast(i32x4_, a); f32x4 r; r[0] = (float)q[0] * s; r[1] = (float)q[1] * s; r[2] = (float)q[2] * s; r[3] = (float)q[3] * s; return r; }
    __device__ __forceinline__ void operator()(const f32x4 (&acc)[2][2][4][2], const Unit& u, int wr, int wc, int fr, int fq) const {
        const int row0 = u.pm * BM + wr * 64 + fr;
        const int tp = u.pn + pn0;
        float rsc[2][4];
#pragma unroll
        for (int ai = 0; ai < 2; ++ai)
#pragma unroll
            for (int m = 0; m < 4; ++m) rsc[ai][m] = asc ? asc[row0 + ai * HALF + m * 16] : 1.f;
        if (tp < C_GATE / BM) {
            const int col0 = tp * BM + wc * 32 + 8 * fq;
#pragma unroll
            for (int ai = 0; ai < 2; ++ai)
#pragma unroll
                for (int m = 0; m < 4; ++m) { bf16_t* rowp = O + (size_t)(row0 + ai * HALF + m * 16) * ldc + col0;
#pragma unroll
                    for (int bj = 0; bj < 2; ++bj) { const f32x4 v0 = cvt_acc(acc[ai][bj][m][0], rsc[ai][m], asc != nullptr), v1 = cvt_acc(acc[ai][bj][m][1], rsc[ai][m], asc != nullptr);
                        u32x4 w; w.x = cvt_pk_bf16(v0[0], v0[1]); w.y = cvt_pk_bf16(v0[2], v0[3]); w.z = cvt_pk_bf16(v1[0], v1[1]); w.w = cvt_pk_bf16(v1[2], v1[3]);
                        *(u32x4*)(rowp + bj * HALF) = w; } }
        } else {
            const int col0 = (tp - C_GATE / BM) * BM + wc * 32 + 8 * fq;
#pragma unroll
            for (int ai = 0; ai < 2; ++ai)
#pragma unroll
                for (int m = 0; m < 4; ++m) { unsigned char* rowp = G8 + (size_t)(row0 + ai * HALF + m * 16) * 4096 + col0;
#pragma unroll
                    for (int bj = 0; bj < 2; ++bj) { const f32x4 v0 = cvt_acc(acc[ai][bj][m][0], rsc[ai][m], asc != nullptr), v1 = cvt_acc(acc[ai][bj][m][1], rsc[ai][m], asc != nullptr);
                        int lo = 0, hi = 0;
                        lo = __builtin_amdgcn_cvt_pk_fp8_f32(v0[0], v0[1], lo, false); lo = __builtin_amdgcn_cvt_pk_fp8_f32(v0[2], v0[3], lo, true);
                        hi = __builtin_amdgcn_cvt_pk_fp8_f32(v1[0], v1[1], hi, false); hi = __builtin_amdgcn_cvt_pk_fp8_f32(v1[2], v1[3], hi, true);
                        u32x2 w; w.x = (unsigned)lo; w.y = (unsigned)hi; *(u32x2*)(rowp + bj * HALF) = w; } }
        }
    }
};
struct EpiGateA {
    static constexpr bool PERM = false, AFTER_DRAIN = false, HAS_MID = false;
    float* T; const bf16_t* Gt; int ldg;
    __device__ __forceinline__ void operator()(const f32x4 (&acc)[2][2][4][2], const Unit& u, int wr, int wc, int fr, int fq) const {
        const int row0 = u.pm * BM + wr * 64 + fr, col0 = u.pn * BM + wc * 32 + 4 * fq;
#pragma unroll
        for (int ai = 0; ai < 2; ++ai)
#pragma unroll
            for (int m = 0; m < 4; ++m) { const int row = row0 + ai * HALF + m * 16;
#pragma unroll
                for (int bj = 0; bj < 2; ++bj)
#pragma unroll
                    for (int n = 0; n < 2; ++n) { const int col = col0 + bj * HALF + n * 16;
                        const u32x2 g = *(const u32x2*)(Gt + (size_t)row * ldg + col); const f32x4 a = acc[ai][bj][m][n];
                        f32x4 o; o[0] = a[0] * sigmoidf_(bflo(g.x)); o[1] = a[1] * sigmoidf_(bfhi(g.x)); o[2] = a[2] * sigmoidf_(bflo(g.y)); o[3] = a[3] * sigmoidf_(bfhi(g.y));
                        *(f32x4*)(T + (size_t)row * DM + col) = o; } }
    }
};
struct EpiGateB {
    static constexpr bool PERM = true, AFTER_DRAIN = false, HAS_MID = false;
    const float* T; const bf16_t* Gt; int ldg; bf16_t* O;
    __device__ __forceinline__ void operator()(const f32x4 (&acc)[2][2][4][2], const Unit& u, int wr, int wc, int fr, int fq) const {
        const int row0 = u.pm * BM + wr * 64 + fr, col0 = u.pn * BM + wc * 32 + 8 * fq;
#pragma unroll
        for (int ai = 0; ai < 2; ++ai)
#pragma unroll
            for (int m = 0; m < 4; ++m) { const int row = row0 + ai * HALF + m * 16;
#pragma unroll
                for (int bj = 0; bj < 2; ++bj) { const int col = col0 + bj * HALF;
                    const u32x4 g = *(const u32x4*)(Gt + (size_t)row * ldg + col);
                    const f32x4 t0 = *(const f32x4*)(T + (size_t)row * DM + col), t1 = *(const f32x4*)(T + (size_t)row * DM + col + 4);
                    const f32x4 a0 = acc[ai][bj][m][0], a1 = acc[ai][bj][m][1];
                    u32x4 w;
                    w.x = cvt_pk_bf16(t0[0] + a0[0] * sigmoidf_(bflo(g.x)), t0[1] + a0[1] * sigmoidf_(bfhi(g.x)));
                    w.y = cvt_pk_bf16(t0[2] + a0[2] * sigmoidf_(bflo(g.y)), t0[3] + a0[3] * sigmoidf_(bfhi(g.y)));
                    w.z = cvt_pk_bf16(t1[0] + a1[0] * sigmoidf_(bflo(g.z)), t1[1] + a1[1] * sigmoidf_(bfhi(g.z)));
                    w.w = cvt_pk_bf16(t1[2] + a1[2] * sigmoidf_(bflo(g.w)), t1[3] + a1[3] * sigmoidf_(bfhi(g.w)));
                    *(u32x4*)(O + (size_t)row * DM + col) = w; } }
    }
};
struct MergeOrder {
    StaticOrder base;
    __device__ __forceinline__ bool next(int i, Unit& u) const { if (!base.next(i >> 1, u)) return false; u.kq = (i & 1) * (F8_MRG ? 512 : 1024); return true; }
    __device__ __forceinline__ void a_ready(const Unit&) const {}
    __device__ __forceinline__ void done(const Unit&) const {}
};
struct EpiMerge {
    static constexpr bool PERM = true, AFTER_DRAIN = false, HAS_MID = true;
    const unsigned char* Ga; const unsigned char* Gb; int ldg; bf16_t* O;
    static __device__ __forceinline__ float f8(unsigned w, int i) { return (i == 0) ? __builtin_amdgcn_cvt_f32_fp8((int)w, 0) : (i == 1) ? __builtin_amdgcn_cvt_f32_fp8((int)w, 1) : (i == 2) ? __builtin_amdgcn_cvt_f32_fp8((int)w, 2) : __builtin_amdgcn_cvt_f32_fp8((int)w, 3); }
    __device__ __forceinline__ void mid(f32x4 (&acc)[2][2][4][2], const Unit& u, int wr, int wc, int fr, int fq) const {
        const int row0 = u.pm * BM + wr * 64 + fr, col0 = u.pn * BM + wc * 32 + 8 * fq;
#pragma unroll
        for (int ai = 0; ai < 2; ++ai)
#pragma unroll
            for (int m = 0; m < 4; ++m) { const size_t ro = (size_t)(row0 + ai * HALF + m * 16) * ldg + col0;
#pragma unroll
                for (int bj = 0; bj < 2; ++bj) { const u32x2 a = *(const u32x2*)(Ga + ro + bj * HALF), b = *(const u32x2*)(Gb + ro + bj * HALF);
#pragma unroll
                    for (int e = 0; e < 8; ++e) { const float ga = f8((e < 4) ? a.x : a.y, e & 3), gb = f8((e < 4) ? b.x : b.y, e & 3);
                        acc[ai][bj][m][e >> 2][e & 3] *= (1.f + __expf(-gb)) * __builtin_amdgcn_rcpf(1.f + __expf(-ga)); } } }
    }
    __device__ __forceinline__ void operator()(const f32x4 (&acc)[2][2][4][2], const Unit& u, int wr, int wc, int fr, int fq) const {
        const int row0 = u.pm * BM + wr * 64 + fr, col0 = u.pn * BM + wc * 32 + 8 * fq;
#pragma unroll
        for (int ai = 0; ai < 2; ++ai)
#pragma unroll
            for (int m = 0; m < 4; ++m) { const int row = row0 + ai * HALF + m * 16;
#pragma unroll
                for (int bj = 0; bj < 2; ++bj) { const int col = col0 + bj * HALF;
                    const u32x2 g = *(const u32x2*)(Gb + (size_t)row * ldg + col);
                    const f32x4 a0 = acc[ai][bj][m][0], a1 = acc[ai][bj][m][1];
                    u32x4 w;
                    w.x = cvt_pk_bf16(a0[0] * sigmoidf_(f8(g.x, 0)), a0[1] * sigmoidf_(f8(g.x, 1)));
                    w.y = cvt_pk_bf16(a0[2] * sigmoidf_(f8(g.x, 2)), a0[3] * sigmoidf_(f8(g.x, 3)));
                    w.z = cvt_pk_bf16(a1[0] * sigmoidf_(f8(g.y, 0)), a1[1] * sigmoidf_(f8(g.y, 1)));
                    w.w = cvt_pk_bf16(a1[2] * sigmoidf_(f8(g.y, 2)), a1[3] * sigmoidf_(f8(g.y, 3)));
                    if (F8_OUT) { int lo8 = 0, hi8 = 0;
                        lo8 = __builtin_amdgcn_cvt_pk_fp8_f32(16.f * bflo(w.x), 16.f * bfhi(w.x), lo8, false); lo8 = __builtin_amdgcn_cvt_pk_fp8_f32(16.f * bflo(w.y), 16.f * bfhi(w.y), lo8, true);
                        hi8 = __builtin_amdgcn_cvt_pk_fp8_f32(16.f * bflo(w.z), 16.f * bfhi(w.z), hi8, false); hi8 = __builtin_amdgcn_cvt_pk_fp8_f32(16.f * bflo(w.w), 16.f * bfhi(w.w), hi8, true);
                        u32x2 w8; w8.x = (unsigned)lo8; w8.y = (unsigned)hi8; *(u32x2*)((unsigned char*)O + (size_t)row * DM + col) = w8; }
                    else *(u32x4*)(O + (size_t)row * DM + col) = w; } }
    }
};
template <bool IN_F32> struct EpiResid {
    static constexpr bool PERM = true, AFTER_DRAIN = false, HAS_MID = false;
    const float* XiF; const bf16_t* XiB; bf16_t* Xo; unsigned char* X8;
    __device__ __forceinline__ void operator()(const f32x4 (&acc)[2][2][4][2], const Unit& u, int wr, int wc, int fr, int fq) const {
        const int row0 = u.pm * BM + wr * 64 + fr, col0 = u.pn * BM + wc * 32 + 8 * fq;
#pragma unroll
        for (int ai = 0; ai < 2; ++ai)
#pragma unroll
            for (int m = 0; m < 4; ++m) { const size_t ro = (size_t)(row0 + ai * HALF + m * 16) * DM + col0;
#pragma unroll
                for (int bj = 0; bj < 2; ++bj) { const size_t o = ro + bj * HALF; f32x4 x0, x1;
                    if constexpr (IN_F32) { x0 = *(const f32x4*)(XiF + o); x1 = *(const f32x4*)(XiF + o + 4); }
                    else { const u32x4 xb = *(const u32x4*)(XiB + o); x0[0] = bflo(xb.x); x0[1] = bfhi(xb.x); x0[2] = bflo(xb.y); x0[3] = bfhi(xb.y); x1[0] = bflo(xb.z); x1[1] = bfhi(xb.z); x1[2] = bflo(xb.w); x1[3] = bfhi(xb.w); }
                    x0 += acc[ai][bj][m][0]; x1 += acc[ai][bj][m][1];
                    u32x4 w; w.x = cvt_pk_bf16(x0[0], x0[1]); w.y = cvt_pk_bf16(x0[2], x0[3]); w.z = cvt_pk_bf16(x1[0], x1[1]); w.w = cvt_pk_bf16(x1[2], x1[3]);
                    *(u32x4*)(Xo + o) = w;
                    if (F8_MOE) { int lo8 = 0, hi8 = 0; lo8 = __builtin_amdgcn_cvt_pk_fp8_f32(x0[0], x0[1], lo8, false); lo8 = __builtin_amdgcn_cvt_pk_fp8_f32(x0[2], x0[3], lo8, true);
                        hi8 = __builtin_amdgcn_cvt_pk_fp8_f32(x1[0], x1[1], hi8, false); hi8 = __builtin_amdgcn_cvt_pk_fp8_f32(x1[2], x1[3], hi8, true);
                        u32x2 w8; w8.x = (unsigned)lo8; w8.y = (unsigned)hi8; *(u32x2*)(X8 + o) = w8; } } }
    }
};
struct MoeOrder {
    int first, stride, limit, nN; const PG8_LAS int* panel_e; const PG8_LAS int* panel_sb;
    __device__ __forceinline__ bool next(int i, Unit& u) const {
        const int L = first + i * stride; if (L >= limit) return false;
        const int p = L / nN, t = L - p * nN; u.pm = p; u.pn = __builtin_amdgcn_readfirstlane(panel_e[p]) * nN + t; u.kq = 0; u.sb = __builtin_amdgcn_readfirstlane(panel_sb[p]); return true; }
    __device__ __forceinline__ void a_ready(const Unit&) const {}
    __device__ __forceinline__ void done(const Unit&) const {}
};
struct EpiSwiGlu {
    static constexpr bool PERM = true, AFTER_DRAIN = false, HAS_MID = false;
    bf16_t* Hd; const int* slot_tok; const float* rstd;
    __device__ __forceinline__ void operator()(const f32x4 (&acc)[2][2][4][2], const Unit& u, int wr, int wc, int fr, int fq) const {
        const int row0 = u.pm * BM + wr * 64 + fr, t = u.pn & 3, j0 = t * 128 + wc * 16 + 4 * fq, s0 = u.sb + wr * 64 + fr;
        int tk[2][4]; float rs[2][4];
#pragma unroll
        for (int ai = 0; ai < 2; ++ai)
#pragma unroll
            for (int m = 0; m < 4; ++m) tk[ai][m] = slot_tok[s0 + ai * HALF + m * 16];
#pragma unroll
        for (int ai = 0; ai < 2; ++ai)
#pragma unroll
            for (int m = 0; m < 4; ++m) rs[ai][m] = (tk[ai][m] >= 0) ? rstd[tk[ai][m] >> 1] : 0.f;
#pragma unroll
        for (int ai = 0; ai < 2; ++ai)
#pragma unroll
            for (int m = 0; m < 4; ++m) { bf16_t* rowp = Hd + (size_t)(row0 + ai * HALF + m * 16) * EH + j0;
#pragma unroll
                for (int bj = 0; bj < 2; ++bj) { const f32x4 g = acc[ai][bj][m][0] * rs[ai][m], up = acc[ai][bj][m][1] * rs[ai][m];
                    if (F8_MOE) { int p8 = 0; p8 = __builtin_amdgcn_cvt_pk_fp8_f32(8.f * g[0] * sigmoidf_(g[0]) * up[0], 8.f * g[1] * sigmoidf_(g[1]) * up[1], p8, false);
                        p8 = __builtin_amdgcn_cvt_pk_fp8_f32(8.f * g[2] * sigmoidf_(g[2]) * up[2], 8.f * g[3] * sigmoidf_(g[3]) * up[3], p8, true);
                        *(unsigned*)((unsigned char*)Hd + (size_t)(row0 + ai * HALF + m * 16) * EH + j0 + bj * 64) = (unsigned)p8; }
                    else { u32x2 w; w.x = cvt_pk_bf16(g[0] * sigmoidf_(g[0]) * up[0], g[1] * sigmoidf_(g[1]) * up[1]); w.y = cvt_pk_bf16(g[2] * sigmoidf_(g[2]) * up[2], g[3] * sigmoidf_(g[3]) * up[3]);
                    *(u32x2*)(rowp + bj * 64) = w; } } }
    }
};
struct EpiMoeDown {
    static constexpr bool PERM = true, AFTER_DRAIN = false, HAS_MID = false;
    bf16_t* Out; const int* slot_tok; const float* slot_w;
    __device__ __forceinline__ void operator()(const f32x4 (&acc)[2][2][4][2], const Unit& u, int wr, int wc, int fr, int fq) const {
        const int row0 = u.sb + wr * 64 + fr, col0 = (u.pn & 7) * BM + wc * 32 + 8 * fq;
        int tk[2][4]; float wv[2][4];
#pragma unroll
        for (int ai = 0; ai < 2; ++ai)
#pragma unroll
            for (int m = 0; m < 4; ++m) { const int slot = row0 + ai * HALF + m * 16; tk[ai][m] = slot_tok[slot]; wv[ai][m] = slot_w[slot]; }
#pragma unroll
        for (int ai = 0; ai < 2; ++ai)
#pragma unroll
            for (int m = 0; m < 4; ++m) { const int t = tk[ai][m]; const float w = wv[ai][m];
                if (t >= 0) { bf16_t* rowp = Out + ((size_t)(t & 1) * NTOK + (size_t)(t >> 1)) * DM + col0;
#pragma unroll
                    for (int bj = 0; bj < 2; ++bj) { const f32x4 v0 = acc[ai][bj][m][0] * w, v1 = acc[ai][bj][m][1] * w;
                        u32x4 o; o.x = cvt_pk_bf16(v0[0], v0[1]); o.y = cvt_pk_bf16(v0[2], v0[3]); o.z = cvt_pk_bf16(v1[0], v1[1]); o.w = cvt_pk_bf16(v1[2], v1[3]);
                        __builtin_nontemporal_store(o, (u32x4*)(rowp + bj * HALF)); } } }
    }
};
}

constexpr int KS_STRIDE = 72;
constexpr int VT_STRIDE = 260;
constexpr int ATT_KS_OFF = 0, ATT_VT_OFF = 256 * KS_STRIDE * 2;
__device__ __forceinline__ void attn_phase(const Frame& F, const In& I, int l) {
    const bf16* proj = (const bf16*)(F.ws + WS_PROJ); bf16* attn = (bf16*)(F.ws + WS_AY);
    LAS bf16* Ks = (LAS bf16*)(F.lds + ATT_KS_OFF); LAS bf16* Vt = (LAS bf16*)(F.lds + ATT_VT_OFF);
    const int lane = F.lane, r32 = lane & 31, h = lane >> 5;
    for (int u = F.vcu; u < 256; u += F.G) {
        const int kvh = u & 3, n = (u >> 2) & 31, b = u >> 7;
#pragma unroll
        for (int i = 0; i < 4; ++i) { const int c = F.tid + 512 * i, key = c >> 3, ch = c & 7;
            int s = 128 * (n - 1) + key; if (s < 0) s = 0;
            const bf16* rowp = proj + (size_t)(b * SEQ + s) * INP;
            const v4u kv = *(const GAS v4u*)(rowp + C_K + kvh * 64 + ch * 8);
            const v4u vv = *(const GAS v4u*)(rowp + C_V + kvh * 64 + ch * 8);
            *(LAS v4u*)(Ks + key * KS_STRIDE + ch * 8) = kv;
            LAS bf16* vp = Vt + (ch * 8) * VT_STRIDE + key;
            vp[0 * VT_STRIDE] = (bf16)(vv.x & 0xffff); vp[1 * VT_STRIDE] = (bf16)(vv.x >> 16); vp[2 * VT_STRIDE] = (bf16)(vv.y & 0xffff); vp[3 * VT_STRIDE] = (bf16)(vv.y >> 16);
            vp[4 * VT_STRIDE] = (bf16)(vv.z & 0xffff); vp[5 * VT_STRIDE] = (bf16)(vv.z >> 16); vp[6 * VT_STRIDE] = (bf16)(vv.w & 0xffff); vp[7 * VT_STRIDE] = (bf16)(vv.w >> 16); }
        __syncthreads();
        const int g = F.wave & 3, half = F.wave >> 2, hq = kvh * 4 + g;
        const float slope2 = exp2f(-0.5f * (float)(hq + 1)) * LOG2E;
        const float sink2 = I.sinks[l * 16 + hq] * LOG2E;
#pragma unroll 1
        for (int qt = 0; qt < 2; ++qt) {
            const int qrel = 64 * half + 32 * qt;
            const int tpos = 128 * n + qrel + r32;
            const bf16* qp = proj + (size_t)(b * SEQ + tpos) * INP + C_Q + hq * 64 + h * 8;
            bf16x8 qf[4];
#pragma unroll
            for (int ks = 0; ks < 4; ++ks) qf[ks] = *(const GAS bf16x8*)(qp + ks * 16);
            float mx = sink2, lsum = 0.f;
            f32x16 o0, o1;
#pragma unroll
            for (int i = 0; i < 16; ++i) { o0[i] = 0.f; o1[i] = 0.f; }
#pragma unroll 1
            for (int j = 0; j < 5; ++j) {
                f32x16 a;
#pragma unroll
                for (int i = 0; i < 16; ++i) a[i] = 0.f;
#pragma unroll
                for (int ks = 0; ks < 4; ++ks) { const bf16x8 kf = *(const LAS bf16x8*)(Ks + (qrel + 32 * j + r32) * KS_STRIDE + ks * 16 + h * 8);
                    a = __builtin_amdgcn_mfma_f32_32x32x16_bf16(kf, qf[ks], a, 0, 0, 0); }
                float tm = -1e30f;
#pragma unroll
                for (int i = 0; i < 16; ++i) { const int row = (i & 3) + 8 * (i >> 2) + 4 * h;
                    const int dist = r32 + 128 - 32 * j - row;
                    const int spos = tpos - dist;
                    const bool ok = (dist >= 0) && (dist < 128) && (spos >= 0);
                    const float v = ok ? (a[i] * (0.125f * LOG2E) - slope2 * (float)dist) : -1e30f;
                    a[i] = v; tm = fmaxf(tm, v); }
                tm = fmaxf(tm, __shfl_xor(tm, 32));
                const float mn = fmaxf(mx, tm), alpha = exp2f(mx - mn); mx = mn;
                lsum *= alpha;
#pragma unroll
                for (int i = 0; i < 16; ++i) { o0[i] *= alpha; o1[i] *= alpha; }
#pragma unroll
                for (int i = 0; i < 16; ++i) { const float p = exp2f(a[i] - mx); a[i] = p; lsum += p; }
#pragma unroll
                for (int s = 0; s < 2; ++s) {
                    bf16x8 pf; { v4u w; w.x = pk2(a[8 * s + 0], a[8 * s + 1]); w.y = pk2(a[8 * s + 2], a[8 * s + 3]); w.z = pk2(a[8 * s + 4], a[8 * s + 5]); w.w = pk2(a[8 * s + 6], a[8 * s + 7]); pf = __builtin_bit_cast(bf16x8, w); }
                    const int kb = qrel + 32 * j + 16 * s + 4 * h;
                    { const LAS bf16* vp = Vt + r32 * VT_STRIDE + kb; const v2u lo = *(const LAS v2u*)vp, hi = *(const LAS v2u*)(vp + 8);
                      v4u w; w.x = lo.x; w.y = lo.y; w.z = hi.x; w.w = hi.y; o0 = __builtin_amdgcn_mfma_f32_32x32x16_bf16(__builtin_bit_cast(bf16x8, w), pf, o0, 0, 0, 0); }
                    { const LAS bf16* vp = Vt + (32 + r32) * VT_STRIDE + kb; const v2u lo = *(const LAS v2u*)vp, hi = *(const LAS v2u*)(vp + 8);
                      v4u w; w.x = lo.x; w.y = lo.y; w.z = hi.x; w.w = hi.y; o1 = __builtin_amdgcn_mfma_f32_32x32x16_bf16(__builtin_bit_cast(bf16x8, w), pf, o1, 0, 0, 0); }
                }
            }
            lsum += __shfl_xor(lsum, 32);
            const float inv = rcpf_(lsum + exp2f(sink2 - mx));
            bf16* op = attn + (size_t)(b * SEQ + tpos) * 2048 + hq * 64 + 4 * h;
#pragma unroll
            for (int gi = 0; gi < 4; ++gi) {
                if (F8_MRG) { GAS unsigned char* op8 = (GAS unsigned char*)attn + (size_t)(b * SEQ + tpos) * 2048 + hq * 64 + 4 * h; const float i16 = 16.f * inv;
                    int p0 = 0, p1 = 0; p0 = __builtin_amdgcn_cvt_pk_fp8_f32(o0[4 * gi + 0] * i16, o0[4 * gi + 1] * i16, p0, false); p0 = __builtin_amdgcn_cvt_pk_fp8_f32(o0[4 * gi + 2] * i16, o0[4 * gi + 3] * i16, p0, true);
                    p1 = __builtin_amdgcn_cvt_pk_fp8_f32(o1[4 * gi + 0] * i16, o1[4 * gi + 1] * i16, p1, false); p1 = __builtin_amdgcn_cvt_pk_fp8_f32(o1[4 * gi + 2] * i16, o1[4 * gi + 3] * i16, p1, true);
                    *(GAS unsigned*)(op8 + 8 * gi) = (unsigned)p0; *(GAS unsigned*)(op8 + 32 + 8 * gi) = (unsigned)p1; }
                else {
                v2u w0; w0.x = pk2(o0[4 * gi + 0] * inv, o0[4 * gi + 1] * inv); w0.y = pk2(o0[4 * gi + 2] * inv, o0[4 * gi + 3] * inv); *(GAS v2u*)(op + 8 * gi) = w0;
                v2u w1; w1.x = pk2(o1[4 * gi + 0] * inv, o1[4 * gi + 1] * inv); w1.y = pk2(o1[4 * gi + 2] * inv, o1[4 * gi + 3] * inv); *(GAS v2u*)(op + 32 + 8 * gi) = w1; } }
        }
        __syncthreads();
    }
}

constexpr int ACT_STRIDE = 328;
__device__ __forceinline__ float lerp_bf(unsigned cur, unsigned prv, float mix, bool hi) {
    const float c = hi ? bfhi(cur) : bflo(cur), p = hi ? bfhi(prv) : bflo(prv); return c + (p - c) * mix; }
__device__ __forceinline__ f32x4 lerp4(const bf16* cur, const bf16* prv, bool has_prev, const float* mix) {
    const v2u c = *(const GAS v2u*)cur; v2u p = (v2u){0u, 0u}; if (has_prev) p = *(const GAS v2u*)prv; const f32x4 m = *(const GAS f32x4*)mix;
    f32x4 o; o[0] = lerp_bf(c.x, p.x, m[0], false); o[1] = lerp_bf(c.x, p.x, m[1], true); o[2] = lerp_bf(c.y, p.y, m[2], false); o[3] = lerp_bf(c.y, p.y, m[3], true); return o; }
__device__ __forceinline__ void prep_phase(const Frame& F, const In& I, int l) {
    const bf16* proj = (const bf16*)(F.ws + WS_PROJ);
    const bf16* lw = (const bf16*)(F.ws + WS_LORA);
    float* SC = (float*)(F.ws + WS_SCAN); float* Gout = (float*)(F.ws + WS_G); float* VF = (float*)(F.ws + WS_VFIRST);
    LAS bf16* act = (LAS bf16*)F.lds;
    const float* mixz = I.shift_mix + (size_t)l * ZW;
    const int lane = F.lane, tl = lane & 15, q4 = lane >> 4;
    for (int u = F.vcu; u < NTOK / 32; u += F.G) {
        const int tok0 = u * 32;
        for (int idx = F.tid; idx < 32 * 160; idx += NTHR) { const int t = idx / 160, c = (idx - t * 160) * 2; const int tok = tok0 + t; const bool hp = (tok & (SEQ - 1)) != 0;
            float v0 = 0.f, v1 = 0.f;
            if (c < 288 || l == 1) {
                const int col = (c < 288) ? (C_Z + 3072 + c) : (C_ZV + (c - 288));
                const float* mp = (c < 288) ? (mixz + 3072 + c) : (I.vres_mix + (c - 288));
                const unsigned cu = *(const GAS unsigned*)(proj + (size_t)tok * INP + col); unsigned pu = 0u; if (hp) pu = *(const GAS unsigned*)(proj + (size_t)(tok - 1) * INP + col);
                v0 = lerp_bf(cu, pu, mp[0], false); v1 = lerp_bf(cu, pu, mp[1], true);
                if (c < 64) { v0 = tanhf(v0); v1 = tanhf(v1); } else if (c >= 128 && c < 288) { v0 = sigmoidf_(v0); v1 = sigmoidf_(v1); }
            }
            *(LAS unsigned*)(act + t * ACT_STRIDE + c) = pk2(v0, v1); }
        __syncthreads();
#pragma unroll 1
        for (int hh = 0; hh < 2; ++hh) {
            const int H = 2 * F.wave + hh, cb = 64 * H + 4 * q4;
            float inv[2];
#pragma unroll
            for (int mt = 0; mt < 2; ++mt) { const int tok = tok0 + 16 * mt + tl; const bool hp = (tok & (SEQ - 1)) != 0; float ss = 0.f;
#pragma unroll
                for (int rt = 0; rt < 4; ++rt) { const int c = cb + 16 * rt;
                    const f32x4 kr = lerp4(proj + (size_t)tok * INP + C_Z + 1024 + c, proj + (size_t)(tok - 1) * INP + C_Z + 1024 + c, hp, mixz + 1024 + c);
                    const f32x4 kk = kr * *(const GAS f32x4*)(I.k_k + l * 1024 + c); ss += (kk[0] * kk[0] + kk[1] * kk[1]) + (kk[2] * kk[2] + kk[3] * kk[3]); }
                ss += __shfl_xor(ss, 16); ss += __shfl_xor(ss, 32);
                inv[mt] = 1.f / fmaxf(sqrtf(ss), 1e-12f); }
#pragma unroll 1
            for (int rt = 0; rt < 4; ++rt) {
                const int c = cb + 16 * rt;
                const int arow = 64 * H + 16 * rt + tl;
                bf16x8 fw[2], fa[2], fg[5], fv;
#pragma unroll
                for (int ks = 0; ks < 2; ++ks) { fw[ks] = *(const GAS bf16x8*)(lw + LO_WUP + (size_t)arow * 64 + ks * 32 + 8 * q4); fa[ks] = *(const GAS bf16x8*)(lw + LO_AUP + (size_t)arow * 64 + ks * 32 + 8 * q4); }
#pragma unroll
                for (int ks = 0; ks < 5; ++ks) fg[ks] = *(const GAS bf16x8*)(lw + LO_GUP + (size_t)arow * 160 + ks * 32 + 8 * q4);
                if (l == 1) fv = *(const GAS bf16x8*)(lw + LO_VUP + (size_t)arow * 32 + 8 * q4); else fv = (bf16x8){0, 0, 0, 0, 0, 0, 0, 0};
                const f32x4 w0 = *(const GAS f32x4*)(I.w0 + l * 1024 + c), a0 = *(const GAS f32x4*)(I.a0 + l * 1024 + c), kkc = *(const GAS f32x4*)(I.k_k + l * 1024 + c), kac = *(const GAS f32x4*)(I.k_a + l * 1024 + c);
                f32x4 v0c = (f32x4){0.f, 0.f, 0.f, 0.f}; if (l == 1) v0c = *(const GAS f32x4*)(I.vres_v0 + c);
#pragma unroll
                for (int mt = 0; mt < 2; ++mt) {
                    const int tok = tok0 + 16 * mt + tl; const bool hp = (tok & (SEQ - 1)) != 0;
                    const LAS bf16* ap = act + (16 * mt + tl) * ACT_STRIDE + 8 * q4;
                    f32x4 aw = (f32x4){0.f, 0.f, 0.f, 0.f}, aa = aw, ag = aw, av = aw;
#pragma unroll
                    for (int ks = 0; ks < 2; ++ks) { aw = __builtin_amdgcn_mfma_f32_16x16x32_bf16(fw[ks], *(const LAS bf16x8*)(ap + ks * 32), aw, 0, 0, 0);
                                                     aa = __builtin_amdgcn_mfma_f32_16x16x32_bf16(fa[ks], *(const LAS bf16x8*)(ap + 64 + ks * 32), aa, 0, 0, 0); }
#pragma unroll
                    for (int ks = 0; ks < 5; ++ks) ag = __builtin_amdgcn_mfma_f32_16x16x32_bf16(fg[ks], *(const LAS bf16x8*)(ap + 128 + ks * 32), ag, 0, 0, 0);
                    if (l == 1) av = __builtin_amdgcn_mfma_f32_16x16x32_bf16(fv, *(const LAS bf16x8*)(ap + 288), av, 0, 0, 0);
                    const bf16* pc = proj + (size_t)tok * INP + C_Z + c; const bf16* pp = proj + (size_t)(tok - 1) * INP + C_Z + c;
                    const f32x4 r = lerp4(pc, pp, hp, mixz + c), kr = lerp4(pc + 1024, pp + 1024, hp, mixz + 1024 + c), vr = lerp4(pc + 2048, pp + 2048, hp, mixz + 2048 + c);
                    f32x4 dec, a, vv, kkn, k2, bb;
                    const size_t o = (size_t)tok * 1024 + c;
                    f32x4 vf = (f32x4){0.f, 0.f, 0.f, 0.f}; if (l == 1) vf = *(const GAS f32x4*)(VF + o);
#pragma unroll
                    for (int e = 0; e < 4; ++e) {
                        const float xw = -(w0[e] + aw[e]);
                        const float sp = fmaxf(xw, 0.f) + __logf(1.f + __expf(-fabsf(xw)));
                        dec[e] = __expf(-__expf(-sp - 0.5f));
                        a[e] = sigmoidf_(a0[e] + aa[e]);
                        vv[e] = (l == 1) ? (vr[e] + (vf[e] - vr[e]) * sigmoidf_(v0c[e] + av[e])) : vr[e];
                        kkn[e] = kr[e] * kkc[e] * inv[mt];
                        k2[e] = kr[e] * (1.f + (a[e] - 1.f) * kac[e]);
                        bb[e] = kkn[e] * a[e];
                    }
                    *(GAS f32x4*)(SC + 0 * SCAN_STRIDE + o) = r; *(GAS f32x4*)(SC + 1 * SCAN_STRIDE + o) = dec; *(GAS f32x4*)(SC + 2 * SCAN_STRIDE + o) = k2;
                    *(GAS f32x4*)(SC + 3 * SCAN_STRIDE + o) = vv; *(GAS f32x4*)(SC + 4 * SCAN_STRIDE + o) = kkn; *(GAS f32x4*)(SC + 5 * SCAN_STRIDE + o) = bb;
                    *(GAS f32x4*)(Gout + o) = ag;
                    if (l == 0) *(GAS f32x4*)(VF + o) = vr;
                }
            }
        }
        __syncthreads();
    }
}

__device__ __forceinline__ float red16(float v) {
    v += __builtin_bit_cast(float, __builtin_amdgcn_update_dpp(0, __builtin_bit_cast(int, v), 0xB1, 0xF, 0xF, false));
    v += __builtin_bit_cast(float, __builtin_amdgcn_update_dpp(0, __builtin_bit_cast(int, v), 0x4E, 0xF, 0xF, false));
    v += __builtin_bit_cast(float, __builtin_amdgcn_update_dpp(0, __builtin_bit_cast(int, v), 0x141, 0xF, 0xF, false));
    v += __builtin_bit_cast(float, __builtin_amdgcn_update_dpp(0, __builtin_bit_cast(int, v), 0x140, 0xF, 0xF, false));
    return v;
}
struct ScanIn { f32x4 w, kk, b, k, r; float v; };
__device__ __forceinline__ ScanIn scan_load(const float* SC, size_t base, int kq, int row) {
    ScanIn s; const size_t o = base + 4 * kq;
    s.r = *(const GAS f32x4*)(SC + 0 * SCAN_STRIDE + o); s.w = *(const GAS f32x4*)(SC + 1 * SCAN_STRIDE + o); s.k = *(const GAS f32x4*)(SC + 2 * SCAN_STRIDE + o);
    s.kk = *(const GAS f32x4*)(SC + 4 * SCAN_STRIDE + o); s.b = *(const GAS f32x4*)(SC + 5 * SCAN_STRIDE + o); s.v = *(const GAS float*)(SC + 3 * SCAN_STRIDE + base + row); return s; }
__device__ __forceinline__ void scan_phase(const Frame& F) {
    const float* SC = (const float*)(F.ws + WS_SCAN); float* Y = (float*)(F.ws + WS_Y);
    const int lane = F.lane, kq = lane & 15;
    for (int u = F.vcu; u < 64; u += F.G) {
        const int half = u & 1, H = (u >> 1) & 15, b = u >> 5;
        const int row = 32 * half + 4 * F.wave + (lane >> 4);
        const size_t base0 = (size_t)b * SEQ * 1024 + H * 64;
        f32x4 S = (f32x4){0.f, 0.f, 0.f, 0.f};
        ScanIn in0 = scan_load(SC, base0, kq, row), in1 = scan_load(SC, base0 + 1024, kq, row), in2 = scan_load(SC, base0 + 2048, kq, row), in3 = scan_load(SC, base0 + 3072, kq, row);
#define SCAN_STEP(IN, T) do { \
            float p = (S[0] * IN.kk[0] + S[1] * IN.kk[1]) + (S[2] * IN.kk[2] + S[3] * IN.kk[3]); p = red16(p); const float sa = -p; \
            S[0] = S[0] * IN.w[0] + (sa * IN.b[0] + IN.v * IN.k[0]); S[1] = S[1] * IN.w[1] + (sa * IN.b[1] + IN.v * IN.k[1]); \
            S[2] = S[2] * IN.w[2] + (sa * IN.b[2] + IN.v * IN.k[2]); S[3] = S[3] * IN.w[3] + (sa * IN.b[3] + IN.v * IN.k[3]); \
            float y = (S[0] * IN.r[0] + S[1] * IN.r[1]) + (S[2] * IN.r[2] + S[3] * IN.r[3]); y = red16(y); \
            if (kq == 0) Y[base0 + (size_t)(T) * 1024 + row] = y; \
            const int tn = (T) + 4; if (tn < SEQ) IN = scan_load(SC, base0 + (size_t)tn * 1024, kq, row); } while (0)
#pragma unroll 1
        for (int t = 0; t < SEQ; t += 4) { SCAN_STEP(in0, t); SCAN_STEP(in1, t + 1); SCAN_STEP(in2, t + 2); SCAN_STEP(in3, t + 3); }
#undef SCAN_STEP
    }
}

__device__ __forceinline__ void post_phase(const Frame& F, const In& I, int l) {
    const float* SC = (const float*)(F.ws + WS_SCAN); const float* Y = (const float*)(F.ws + WS_Y); const float* Gv = (const float*)(F.ws + WS_G); bf16* YB = (bf16*)(F.ws + WS_YB);
    const int gw = F.vcu * NWAVES + F.wave, NGW = F.G * NWAVES, lane = F.lane;
    for (int p = gw; p < NTOK * 16; p += NGW) {
        const size_t o = (size_t)p * 64 + lane; const int c = (p & 15) * 64 + lane;
        const float y = Y[o], r = SC[o], k = SC[2 * SCAN_STRIDE + o], v = SC[3 * SCAN_STRIDE + o], g = Gv[o];
        const float mu = wave_sum(y) * (1.f / 64.f); const float d = y - mu; const float var = wave_sum(d * d) * (1.f / 64.f);
        const float rk = wave_sum(r * k * I.r_k[l * 1024 + c]);
        const float yn = d * (__builtin_amdgcn_rsqf(var + GN_EPS)) * I.ln_w[l * 1024 + c] + I.ln_b[l * 1024 + c];
        YB[o] = (bf16)f2bf((yn + rk * v) * g);
    }
}

typedef short s16x4_t __attribute__((ext_vector_type(4)));
constexpr int CS = 72;
constexpr int L_At = 0, L_Rt = 9216, L_Bt = 18432, L_Kt = 27648, L_BT = 36864, L_KT = 46080, L_VT = 55296, L_NLab = 64512, L_Lak = 73728, L_Mrb = 82944, L_Mrk = 92160,
              L_G = 101376, L_Ld = 117760, L_Tbb = 121856, L_SEG = 123904;
static_assert(L_SEG + 2048 <= RING_BYTES, "scanA LDS");
constexpr size_t WS_PF = WS_TMP, WS_RWF = WS_TMP + 16 * MiB, WS_QF = WS_TMP + 32 * MiB, WS_Y0F = WS_TMP + 64 * MiB;
constexpr size_t WS_S0F = WS_H, WS_RK = WS_H + 16 * MiB;
static_assert(WS_Y0F + 32 * MiB <= WS_ROUTE, "scan scratch");
__device__ __forceinline__ s16x4_t pk4(float a, float b, float c, float d) { v2u w; w.x = pk2(a, b); w.y = pk2(c, d); return __builtin_bit_cast(s16x4_t, w); }
__device__ __forceinline__ f32x4 mfma16(s16x4_t a, s16x4_t b, f32x4 c) { return __builtin_amdgcn_mfma_f32_16x16x16bf16_1k(a, b, c, 0, 0, 0); }
__device__ __forceinline__ s16x4_t lds4(const LAS bf16* p) { return *(const LAS s16x4_t*)p; }

__device__ __forceinline__ void scanA_phase(const Frame& F, const In& I, int l) {
    const float* SC = (const float*)(F.ws + WS_SCAN);
    LAS unsigned char* L = F.lds;
    LAS bf16* At = (LAS bf16*)(L + L_At); LAS bf16* Rt = (LAS bf16*)(L + L_Rt); LAS bf16* Bt = (LAS bf16*)(L + L_Bt); LAS bf16* Kt = (LAS bf16*)(L + L_Kt);
    LAS bf16* BT = (LAS bf16*)(L + L_BT); LAS bf16* KT = (LAS bf16*)(L + L_KT); LAS bf16* VT = (LAS bf16*)(L + L_VT);
    LAS bf16* NLab = (LAS bf16*)(L + L_NLab); LAS bf16* Lak = (LAS bf16*)(L + L_Lak); LAS bf16* Mrb = (LAS bf16*)(L + L_Mrb); LAS bf16* Mrk = (LAS bf16*)(L + L_Mrk);
    LAS float* Gs = (LAS float*)(L + L_G); LAS float* Ld = (LAS float*)(L + L_Ld); LAS bf16* Tbb = (LAS bf16*)(L + L_Tbb); LAS float* SEG = (LAS float*)(L + L_SEG);
    const int lane = F.lane, w = F.wave, c16 = lane & 15, q = lane >> 4;
    for (int u = F.vcu; u < 2048; u += F.G) {
        const int c = u & 63, H = (u >> 6) & 15, b = u >> 10;
        const size_t base = ((size_t)(b * SEQ + c * 64)) * 1024 + H * 64;
        { float loc[8]; float p = 1.f;
#pragma unroll
          for (int i = 0; i < 8; ++i) { p *= SC[1 * SCAN_STRIDE + base + (size_t)(8 * w + i) * 1024 + lane]; loc[i] = p; }
          SEG[w * 64 + lane] = p;
          __syncthreads();
          float pre = 1.f;
          for (int s = 0; s < w; ++s) pre *= SEG[s * 64 + lane];
#pragma unroll
          for (int i = 0; i < 8; ++i) Gs[(8 * w + i) * 64 + lane] = loc[i] * pre; }
        __syncthreads();
#pragma unroll
        for (int it = 0; it < 2; ++it) { const int item = F.tid + 512 * it, t = item >> 4, kq = item & 15; const size_t o = base + (size_t)t * 1024 + 4 * kq;
            const f32x4 r4 = *(const GAS f32x4*)(SC + o), k4 = *(const GAS f32x4*)(SC + 2 * SCAN_STRIDE + o), v4 = *(const GAS f32x4*)(SC + 3 * SCAN_STRIDE + o),
                        a4 = *(const GAS f32x4*)(SC + 4 * SCAN_STRIDE + o), b4 = *(const GAS f32x4*)(SC + 5 * SCAN_STRIDE + o);
            const f32x4 g4 = *(const LAS f32x4*)(Gs + t * 64 + 4 * kq); f32x4 gp4 = (f32x4){1.f, 1.f, 1.f, 1.f}; if (t > 0) gp4 = *(const LAS f32x4*)(Gs + (t - 1) * 64 + 4 * kq);
            const f32x4 rk4 = *(const GAS f32x4*)(I.r_k + l * 1024 + H * 64 + 4 * kq);
            f32x4 ig; ig[0] = rcpf_(g4[0]); ig[1] = rcpf_(g4[1]); ig[2] = rcpf_(g4[2]); ig[3] = rcpf_(g4[3]);
            const f32x4 at = a4 * gp4, bt = b4 * ig, kt = k4 * ig, rt = r4 * g4;
            *(LAS s16x4_t*)(At + t * CS + 4 * kq) = pk4(at[0], at[1], at[2], at[3]); *(LAS s16x4_t*)(Rt + t * CS + 4 * kq) = pk4(rt[0], rt[1], rt[2], rt[3]);
            *(LAS s16x4_t*)(Bt + t * CS + 4 * kq) = pk4(bt[0], bt[1], bt[2], bt[3]); *(LAS s16x4_t*)(Kt + t * CS + 4 * kq) = pk4(kt[0], kt[1], kt[2], kt[3]);
#pragma unroll
            for (int e = 0; e < 4; ++e) { BT[(4 * kq + e) * CS + t] = (bf16)f2bf(bt[e]); KT[(4 * kq + e) * CS + t] = (bf16)f2bf(kt[e]); VT[(4 * kq + e) * CS + t] = (bf16)f2bf(v4[e]); }
            float rk = (r4[0] * k4[0] * rk4[0] + r4[1] * k4[1] * rk4[1]) + (r4[2] * k4[2] * rk4[2] + r4[3] * k4[3] * rk4[3]);
            rk = red16(rk);
            if (kq == 0) ((float*)(F.ws + WS_RK))[(size_t)u * 64 + t] = rk; }
        __syncthreads();
        { const int tt = w & 3; const LAS bf16* Arow = ((w < 4) ? At : Rt) + (16 * tt + c16) * CS + 4 * q;
          s16x4_t af[4];
#pragma unroll
          for (int ks = 0; ks < 4; ++ks) af[ks] = lds4(Arow + 16 * ks);
          for (int jt = 0; jt <= tt; ++jt) {
#pragma unroll
              for (int which = 0; which < 2; ++which) {
                  const LAS bf16* Brow = (which ? Kt : Bt) + (16 * jt + c16) * CS + 4 * q;
                  f32x4 acc = (f32x4){0.f, 0.f, 0.f, 0.f};
#pragma unroll
                  for (int ks = 0; ks < 4; ++ks) acc = mfma16(af[ks], lds4(Brow + 16 * ks), acc);
                  LAS bf16* dst = (w < 4) ? (which ? Lak : NLab) : (which ? Mrk : Mrb);
#pragma unroll
                  for (int e = 0; e < 4; ++e) { const int t = 16 * tt + 4 * q + e, j = 16 * jt + c16;
                      const bool keep = (w < 4) ? (j < t) : (j <= t); float v = keep ? acc[e] : 0.f;
                      if (w < 4 && which == 0) { if (jt == tt) Ld[(tt * 16 + c16) * 16 + 4 * q + e] = v; v = -v; }
                      dst[t * CS + j] = (bf16)f2bf(v); } } } }
        __syncthreads();
        if (w == 0) { float s[16]; const LAS float* Lb = Ld + q * 256;
#pragma unroll
            for (int i = 0; i < 16; ++i) s[i] = (i == c16) ? 1.f : 0.f;
#pragma unroll
            for (int j = 0; j < 16; ++j) { const float Tj = s[j]; Tbb[(q * 16 + j) * 16 + c16] = (bf16)f2bf(Tj);
#pragma unroll
                for (int ci = (j + 1) / 4; ci < 4; ++ci) { const f32x4 lc = *(const LAS f32x4*)(Lb + j * 16 + 4 * ci);
#pragma unroll
                    for (int e = 0; e < 4; ++e) if (4 * ci + e > j) s[4 * ci + e] -= lc[e] * Tj; } } }
        f32x4 X[4]; s16x4_t vB[4];
        if (w < 4) {
#pragma unroll
            for (int bb = 0; bb < 4; ++bb)
#pragma unroll
                for (int e = 0; e < 4; ++e) X[bb][e] = bflo((unsigned)At[(16 * bb + 4 * q + e) * CS + 16 * w + c16]);
#pragma unroll
            for (int bb = 0; bb < 4; ++bb) vB[bb] = (s16x4_t){0, 0, 0, 0};
        } else {
#pragma unroll
            for (int bb = 0; bb < 4; ++bb) vB[bb] = lds4(VT + (16 * (w - 4) + c16) * CS + 16 * bb + 4 * q);
#pragma unroll
            for (int bb = 0; bb < 4; ++bb) { f32x4 acc = (f32x4){0.f, 0.f, 0.f, 0.f};
#pragma unroll
                for (int jb = 0; jb <= bb; ++jb) acc = mfma16(lds4(Lak + (16 * bb + c16) * CS + 16 * jb + 4 * q), vB[jb], acc);
                X[bb] = acc; }
        }
        __syncthreads();
        s16x4_t XB[4];
#pragma unroll
        for (int bb = 0; bb < 4; ++bb) {
            f32x4 r = X[bb];
#pragma unroll
            for (int jb = 0; jb < bb; ++jb) r = mfma16(lds4(NLab + (16 * bb + c16) * CS + 16 * jb + 4 * q), pk4(X[jb][0], X[jb][1], X[jb][2], X[jb][3]), r);
            const f32x4 z = (f32x4){0.f, 0.f, 0.f, 0.f};
            X[bb] = mfma16(lds4(Tbb + (bb * 16 + c16) * 16 + 4 * q), pk4(r[0], r[1], r[2], r[3]), z);
        }
#pragma unroll
        for (int bb = 0; bb < 4; ++bb) XB[bb] = pk4(-X[bb][0], -X[bb][1], -X[bb][2], -X[bb][3]);
        if (w < 4) {
            s16x4_t* PF = (s16x4_t*)(F.ws + WS_PF) + ((size_t)u * 16 + w * 4) * 64 + lane;
#pragma unroll
            for (int ct = 0; ct < 4; ++ct) { f32x4 acc = (f32x4){0.f, 0.f, 0.f, 0.f};
#pragma unroll
                for (int bb = 0; bb < 4; ++bb) acc = mfma16(XB[bb], lds4(BT + (16 * ct + c16) * CS + 16 * bb + 4 * q), acc);
                const float g63 = Gs[63 * 64 + 16 * ct + c16];
#pragma unroll
                for (int e = 0; e < 4; ++e) acc[e] = (acc[e] + ((ct == w && 4 * q + e == c16) ? 1.f : 0.f)) * g63;
                PF[ct * 64] = pk4(acc[0], acc[1], acc[2], acc[3]); }
            s16x4_t* RWF = (s16x4_t*)(F.ws + WS_RWF) + ((size_t)u * 16 + w) * 64 + lane;
#pragma unroll
            for (int tt = 0; tt < 4; ++tt) { const v2u rr = *(const LAS v2u*)(Rt + (16 * tt + c16) * CS + 16 * w + 4 * q);
                f32x4 acc; acc[0] = bflo(rr.x); acc[1] = bfhi(rr.x); acc[2] = bflo(rr.y); acc[3] = bfhi(rr.y);
#pragma unroll
                for (int bb = 0; bb <= tt; ++bb) acc = mfma16(XB[bb], lds4(Mrb + (16 * tt + c16) * CS + 16 * bb + 4 * q), acc);
                RWF[tt * 4 * 64] = pk4(acc[0], acc[1], acc[2], acc[3]); }
        } else {
            const int vt = w - 4;
            f32x4* QF = (f32x4*)(F.ws + WS_QF) + ((size_t)u * 16 + vt * 4) * 64 + lane;
#pragma unroll
            for (int ct = 0; ct < 4; ++ct) { f32x4 acc = (f32x4){0.f, 0.f, 0.f, 0.f};
#pragma unroll
                for (int bb = 0; bb < 4; ++bb) { acc = mfma16(lds4(BT + (16 * ct + c16) * CS + 16 * bb + 4 * q), XB[bb], acc); acc = mfma16(lds4(KT + (16 * ct + c16) * CS + 16 * bb + 4 * q), vB[bb], acc); }
                const f32x4 g63 = *(const LAS f32x4*)(Gs + 63 * 64 + 16 * ct + 4 * q);
                QF[ct * 64] = acc * g63; }
            f32x4* Y0F = (f32x4*)(F.ws + WS_Y0F) + ((size_t)u * 16 + vt * 4) * 64 + lane;
#pragma unroll
            for (int tt = 0; tt < 4; ++tt) { f32x4 acc = (f32x4){0.f, 0.f, 0.f, 0.f};
#pragma unroll
                for (int bb = 0; bb <= tt; ++bb) { acc = mfma16(lds4(Mrb + (16 * tt + c16) * CS + 16 * bb + 4 * q), XB[bb], acc); acc = mfma16(lds4(Mrk + (16 * tt + c16) * CS + 16 * bb + 4 * q), vB[bb], acc); }
                Y0F[tt * 64] = acc; }
        }
        __syncthreads();
    }
}


constexpr size_t WS_ACT = WS_YB, WS_INVN = WS_YB + 8 * MiB;
__device__ __forceinline__ void acts_phase(const Frame& F, const In& I, int l) {
    const bf16* proj = (const bf16*)(F.ws + WS_PROJ); bf16* ACT = (bf16*)(F.ws + WS_ACT); float* INV = (float*)(F.ws + WS_INVN);
    const float* mixz = I.shift_mix + (size_t)l * ZW;
    for (int u = F.vcu; u < NTOK / 32; u += F.G) {
        const int tok0 = 32 * u;
        { unsigned cu[10], pu[10];
#pragma unroll
          for (int i = 0; i < 10; ++i) { const int idx = F.tid + NTHR * i, t = idx / 160, cc = (idx - t * 160) * 2; const int tok = tok0 + t; const bool hp = (tok & (SEQ - 1)) != 0;
              cu[i] = 0u; pu[i] = 0u;
              if (cc < 288 || l == 1) {
                  const int col = (cc < 288) ? (C_Z + 3072 + cc) : (C_ZV + (cc - 288));
                  cu[i] = *(const GAS unsigned*)(proj + (size_t)tok * INP + col); if (hp) pu[i] = *(const GAS unsigned*)(proj + (size_t)(tok - 1) * INP + col); } }
#pragma unroll
          for (int i = 0; i < 10; ++i) { const int idx = F.tid + NTHR * i, t = idx / 160, cc = (idx - t * 160) * 2;
              float v0 = 0.f, v1 = 0.f;
              if (cc < 288 || l == 1) { const float* mp = (cc < 288) ? (mixz + 3072 + cc) : (I.vres_mix + (cc - 288));
                  v0 = lerp_bf(cu[i], pu[i], mp[0], false); v1 = lerp_bf(cu[i], pu[i], mp[1], true);
                  if (cc < 64) { v0 = tanhf(v0); v1 = tanhf(v1); } else if (cc >= 128 && cc < 288) { v0 = sigmoidf_(v0); v1 = sigmoidf_(v1); } }
              *(GAS unsigned*)(ACT + (size_t)(tok0 + t) * 320 + cc) = pk2(v0, v1); } }
#pragma unroll 4
        for (int it = 0; it < 16; ++it) { const int item = F.tid + NTHR * it, kq = item & 15, hh = (item >> 4) & 15, t = item >> 8; const int tok = tok0 + t; const bool hp = (tok & (SEQ - 1)) != 0; const int ch = 64 * hh + 4 * kq;
            const f32x4 kr = lerp4(proj + (size_t)tok * INP + C_Z + 1024 + ch, proj + (size_t)(tok - 1) * INP + C_Z + 1024 + ch, hp, mixz + 1024 + ch);
            const f32x4 kk = kr * *(const GAS f32x4*)(I.k_k + l * 1024 + ch); float ss = (kk[0] * kk[0] + kk[1] * kk[1]) + (kk[2] * kk[2] + kk[3] * kk[3]);
            ss = red16(ss);
            if (kq == 0) INV[(size_t)tok * 16 + hh] = 1.f / fmaxf(sqrtf(ss), 1e-12f); }
    }
}

__device__ __forceinline__ int chunk_unit(int vcu, int i, int G) {
#ifndef CHUNK_LOCAL
#define CHUNK_LOCAL 0
#endif
    if (!CHUNK_LOCAL || G != 256) return vcu + i * G;
    const int x = vcu >> 5, j = vcu & 31; const int b = x >> 2, cc = 16 * (x & 3) + (j & 15), H = (j >> 4) + 2 * i;
    return (b << 10) | (H << 6) | cc; }
constexpr int L_ACT = 64512;
constexpr int L_G2 = 106496, L_Ld2 = 122880, L_Tbb2 = 126976, L_SEG2 = 129024;
constexpr int L_INVN = LDSCTL_OFF + 4096, L_RKS = LDSCTL_OFF + 4096 + 256, L_GT = LDSCTL_OFF + 6144;
constexpr size_t WS_VGF = WS_G;
static_assert(L_ACT + 64 * ACT_STRIDE * 2 <= L_G2 && L_SEG2 + 2048 <= RING_BYTES && L_RKS + 1024 <= L_GT && L_GT + 64 * CS * 2 <= LDS_BYTES, "chunk LDS");
__device__ __forceinline__ float scan16_mul(float v) {
    v *= __builtin_bit_cast(float, __builtin_amdgcn_update_dpp(0x3f800000, __builtin_bit_cast(int, v), 0x111, 0xF, 0xF, false));
    v *= __builtin_bit_cast(float, __builtin_amdgcn_update_dpp(0x3f800000, __builtin_bit_cast(int, v), 0x112, 0xF, 0xF, false));
    v *= __builtin_bit_cast(float, __builtin_amdgcn_update_dpp(0x3f800000, __builtin_bit_cast(int, v), 0x114, 0xF, 0xF, false));
    v *= __builtin_bit_cast(float, __builtin_amdgcn_update_dpp(0x3f800000, __builtin_bit_cast(int, v), 0x118, 0xF, 0xF, false));
    return v; }
__device__ __forceinline__ void chunk_phase(const Frame& F, const In& I, int l) {
    const bf16* proj = (const bf16*)(F.ws + WS_PROJ); const bf16* lw = (const bf16*)(F.ws + WS_LORA);
    bf16* VF = (bf16*)(F.ws + WS_VFIRST);
    LAS unsigned char* L = F.lds;
    LAS bf16* At = (LAS bf16*)(L + L_At); LAS bf16* Rt = (LAS bf16*)(L + L_Rt); LAS bf16* Bt = (LAS bf16*)(L + L_Bt); LAS bf16* Kt = (LAS bf16*)(L + L_Kt);
    LAS bf16* BT = (LAS bf16*)(L + L_BT); LAS bf16* KT = (LAS bf16*)(L + L_KT); LAS bf16* VT = (LAS bf16*)(L + L_VT);
    LAS bf16* NLab = (LAS bf16*)(L + L_NLab); LAS bf16* Lak = (LAS bf16*)(L + L_Lak); LAS bf16* Mrb = (LAS bf16*)(L + L_Mrb); LAS bf16* Mrk = (LAS bf16*)(L + L_Mrk);
    LAS float* Gs = (LAS float*)(L + L_G2); LAS float* Ld = (LAS float*)(L + L_Ld2); LAS bf16* Tbb = (LAS bf16*)(L + L_Tbb2); LAS float* SEG = (LAS float*)(L + L_SEG2);
    LAS float* RKS = (LAS float*)(L + L_RKS); LAS bf16* GT = (LAS bf16*)(L + L_GT); LAS bf16* act = (LAS bf16*)(L + L_ACT); const bf16* ACT = (const bf16*)(F.ws + WS_ACT); const float* INV = (const float*)(F.ws + WS_INVN);
    const float* mixz = I.shift_mix + (size_t)l * ZW;
    const int lane = F.lane, w = F.wave, c16 = lane & 15, q = lane >> 4;
    for (int it = 0; it * F.G < 2048; ++it) { const int u = chunk_unit(F.vcu, it, F.G); if (u >= 2048) break;
        const int c = u & 63, H = (u >> 6) & 15, b = u >> 10;
        const int tok0 = b * SEQ + c * 64;
        const bool hp0 = (c != 0);
        f32x4 rr[2], kn[2], k2r[2], bbr[2], dcv[2];
        { const int rt = w & 3, chl = 16 * rt + 4 * q, ch = 64 * H + chl;
          const int arow = 64 * H + 16 * rt + c16;
          v4u ac[5];
#pragma unroll
          for (int i = 0; i < 5; ++i) ac[i] = *(const GAS v4u*)(ACT + (size_t)(tok0 + (F.tid >> 3)) * 320 + ((F.tid & 7) + 8 * i) * 8);
          bf16x8 fw[2], fa[2], fg[5], fv;
#pragma unroll
          for (int ks = 0; ks < 2; ++ks) { fw[ks] = *(const GAS bf16x8*)(lw + LO_WUP + (size_t)arow * 64 + ks * 32 + 8 * q); fa[ks] = *(const GAS bf16x8*)(lw + LO_AUP + (size_t)arow * 64 + ks * 32 + 8 * q); }
#pragma unroll
          for (int ks = 0; ks < 5; ++ks) fg[ks] = *(const GAS bf16x8*)(lw + LO_GUP + (size_t)arow * 160 + ks * 32 + 8 * q);
          if (l == 1) fv = *(const GAS bf16x8*)(lw + LO_VUP + (size_t)arow * 32 + 8 * q); else fv = (bf16x8){0, 0, 0, 0, 0, 0, 0, 0};
          v2u zc[2][3], zp[2][3]; f32x4 vfv[2]; float invv[2];
#pragma unroll
          for (int mi = 0; mi < 2; ++mi) { const int t = 16 * (2 * (w >> 2) + mi) + c16, tok = tok0 + t; const bool hp = hp0 || (t != 0);
              const bf16* pc = proj + (size_t)tok * INP + C_Z + ch; const bf16* pp = proj + (size_t)(tok - 1) * INP + C_Z + ch;
#pragma unroll
              for (int j = 0; j < 3; ++j) { zc[mi][j] = *(const GAS v2u*)(pc + 1024 * j); zp[mi][j] = (v2u){0u, 0u}; if (hp) zp[mi][j] = *(const GAS v2u*)(pp + 1024 * j); }
              vfv[mi] = (f32x4){0.f, 0.f, 0.f, 0.f}; if (l == 1) { const v2u vb_ = *(const GAS v2u*)(VF + (size_t)tok * 1024 + ch); vfv[mi][0] = bflo(vb_.x); vfv[mi][1] = bfhi(vb_.x); vfv[mi][2] = bflo(vb_.y); vfv[mi][3] = bfhi(vb_.y); }
              invv[mi] = INV[(size_t)tok * 16 + H]; }
#pragma unroll
          for (int i = 0; i < 5; ++i) *(LAS v4u*)(act + (F.tid >> 3) * ACT_STRIDE + ((F.tid & 7) + 8 * i) * 8) = ac[i];
          __syncthreads();
          const f32x4 w0 = *(const GAS f32x4*)(I.w0 + l * 1024 + ch), a0 = *(const GAS f32x4*)(I.a0 + l * 1024 + ch), kkc = *(const GAS f32x4*)(I.k_k + l * 1024 + ch), kac = *(const GAS f32x4*)(I.k_a + l * 1024 + ch);
          const f32x4 rkc = *(const GAS f32x4*)(I.r_k + l * 1024 + ch);
          f32x4 v0c = (f32x4){0.f, 0.f, 0.f, 0.f}; if (l == 1) v0c = *(const GAS f32x4*)(I.vres_v0 + ch);
          const f32x4 mxr = *(const GAS f32x4*)(mixz + ch), mxk = *(const GAS f32x4*)(mixz + 1024 + ch), mxv = *(const GAS f32x4*)(mixz + 2048 + ch);
#pragma unroll
          for (int mi = 0; mi < 2; ++mi) {
              const int mt = 2 * (w >> 2) + mi, t = 16 * mt + c16, tok = tok0 + t;
              const LAS bf16* ap = act + t * ACT_STRIDE + 8 * q;
              f32x4 aw = (f32x4){0.f, 0.f, 0.f, 0.f}, aa = aw, ag = aw, av = aw;
#pragma unroll
              for (int ks = 0; ks < 2; ++ks) { aw = __builtin_amdgcn_mfma_f32_16x16x32_bf16(fw[ks], *(const LAS bf16x8*)(ap + ks * 32), aw, 0, 0, 0);
                                               aa = __builtin_amdgcn_mfma_f32_16x16x32_bf16(fa[ks], *(const LAS bf16x8*)(ap + 64 + ks * 32), aa, 0, 0, 0); }
#pragma unroll
              for (int ks = 0; ks < 5; ++ks) ag = __builtin_amdgcn_mfma_f32_16x16x32_bf16(fg[ks], *(const LAS bf16x8*)(ap + 128 + ks * 32), ag, 0, 0, 0);
              if (l == 1) av = __builtin_amdgcn_mfma_f32_16x16x32_bf16(fv, *(const LAS bf16x8*)(ap + 288), av, 0, 0, 0);
              f32x4 r, kr, vr;
              { const v2u* C = zc[mi]; const v2u* P = zp[mi];
                r[0] = lerp_bf(C[0].x, P[0].x, mxr[0], false); r[1] = lerp_bf(C[0].x, P[0].x, mxr[1], true); r[2] = lerp_bf(C[0].y, P[0].y, mxr[2], false); r[3] = lerp_bf(C[0].y, P[0].y, mxr[3], true);
                kr[0] = lerp_bf(C[1].x, P[1].x, mxk[0], false); kr[1] = lerp_bf(C[1].x, P[1].x, mxk[1], true); kr[2] = lerp_bf(C[1].y, P[1].y, mxk[2], false); kr[3] = lerp_bf(C[1].y, P[1].y, mxk[3], true);
                vr[0] = lerp_bf(C[2].x, P[2].x, mxv[0], false); vr[1] = lerp_bf(C[2].x, P[2].x, mxv[1], true); vr[2] = lerp_bf(C[2].y, P[2].y, mxv[2], false); vr[3] = lerp_bf(C[2].y, P[2].y, mxv[3], true); }
              const size_t o = (size_t)tok * 1024 + ch;
              const f32x4 vf = vfv[mi];
              const float invn = invv[mi];
              f32x4 dec, vv; float rkp = 0.f;
#pragma unroll
              for (int e = 0; e < 4; ++e) {
                  const float xw = -(w0[e] + aw[e]);
                  const float sp = fmaxf(xw, 0.f) + __logf(1.f + __expf(-fabsf(xw)));
                  dec[e] = __expf(-__expf(-sp - 0.5f));
                  const float a = sigmoidf_(a0[e] + aa[e]);
                  vv[e] = (l == 1) ? (vr[e] + (vf[e] - vr[e]) * sigmoidf_(v0c[e] + av[e])) : vr[e];
                  kn[mi][e] = kr[e] * kkc[e] * invn;
                  k2r[mi][e] = kr[e] * (1.f + (a - 1.f) * kac[e]);
                  bbr[mi][e] = kn[mi][e] * a;
                  rkp += r[e] * k2r[mi][e] * rkc[e];
              }
              rr[mi] = r;
              dcv[mi] = dec;
#pragma unroll
              for (int e = 0; e < 4; ++e) { VT[(chl + e) * CS + t] = (bf16)f2bf(vv[e]); GT[(chl + e) * CS + t] = (bf16)f2bf(ag[e]); }
              if (l == 0) { v2u vb_; vb_.x = pk2(vr[0], vr[1]); vb_.y = pk2(vr[2], vr[3]); *(GAS v2u*)(VF + o) = vb_; }
              rkp += __shfl_xor(rkp, 16); rkp += __shfl_xor(rkp, 32);
              if (q == 0) RKS[rt * 64 + t] = rkp;
          } }
        f32x4 G[2];
        { const int rt = w & 3, chl = 16 * rt + 4 * q;
          LAS float* TOT = SEG; LAS float* G63 = SEG + 64;
#pragma unroll
          for (int mi = 0; mi < 2; ++mi)
#pragma unroll
              for (int e = 0; e < 4; ++e) G[mi][e] = scan16_mul(dcv[mi][e]);
#pragma unroll
          for (int e = 0; e < 4; ++e) G[1][e] *= __shfl(G[0][e], (lane & 48) | 15);
          if (w < 4 && c16 == 15) *(LAS f32x4*)(TOT + chl) = G[1];
          __syncthreads();
          if (w >= 4) { const f32x4 tq = *(const LAS f32x4*)(TOT + chl); G[0] *= tq; G[1] *= tq; if (c16 == 15) *(LAS f32x4*)(G63 + chl) = G[1]; }
#pragma unroll
          for (int mi = 0; mi < 2; ++mi) { const int t = 16 * (2 * (w >> 2) + mi) + c16;
              const f32x4 g4 = G[mi];
              f32x4 ig; ig[0] = rcpf_(g4[0]); ig[1] = rcpf_(g4[1]); ig[2] = rcpf_(g4[2]); ig[3] = rcpf_(g4[3]);
              f32x4 gp4; gp4[0] = g4[0] * rcpf_(dcv[mi][0]); gp4[1] = g4[1] * rcpf_(dcv[mi][1]); gp4[2] = g4[2] * rcpf_(dcv[mi][2]); gp4[3] = g4[3] * rcpf_(dcv[mi][3]);
              const f32x4 at = kn[mi] * gp4, bt = bbr[mi] * ig, kt = k2r[mi] * ig, rt_ = rr[mi] * g4;
              *(LAS s16x4_t*)(At + t * CS + chl) = pk4(at[0], at[1], at[2], at[3]); *(LAS s16x4_t*)(Rt + t * CS + chl) = pk4(rt_[0], rt_[1], rt_[2], rt_[3]);
              *(LAS s16x4_t*)(Bt + t * CS + chl) = pk4(bt[0], bt[1], bt[2], bt[3]); *(LAS s16x4_t*)(Kt + t * CS + chl) = pk4(kt[0], kt[1], kt[2], kt[3]);
#pragma unroll
              for (int e = 0; e < 4; ++e) { BT[(chl + e) * CS + t] = (bf16)f2bf(bt[e]); KT[(chl + e) * CS + t] = (bf16)f2bf(kt[e]); } }
          if (F.tid < 64) ((float*)(F.ws + WS_RK))[(size_t)u * 64 + F.tid] = (RKS[F.tid] + RKS[64 + F.tid]) + (RKS[128 + F.tid] + RKS[192 + F.tid]); }
        __syncthreads();
        { const int tt = w & 3; const LAS bf16* Arow = ((w < 4) ? At : Rt) + (16 * tt + c16) * CS + 4 * q;
          s16x4_t af[4];
#pragma unroll
          for (int ks = 0; ks < 4; ++ks) af[ks] = lds4(Arow + 16 * ks);
          for (int jt = 0; jt <= tt; ++jt) {
#pragma unroll
              for (int which = 0; which < 2; ++which) {
                  const LAS bf16* Brow = (which ? Kt : Bt) + (16 * jt + c16) * CS + 4 * q;
                  f32x4 acc = (f32x4){0.f, 0.f, 0.f, 0.f};
#pragma unroll
                  for (int ks = 0; ks < 4; ++ks) acc = mfma16(af[ks], lds4(Brow + 16 * ks), acc);
                  LAS bf16* dst = (w < 4) ? (which ? Lak : NLab) : (which ? Mrk : Mrb);
#pragma unroll
                  for (int e = 0; e < 4; ++e) { const int t = 16 * tt + 4 * q + e, j = 16 * jt + c16;
                      const bool keep = (w < 4) ? (j < t) : (j <= t); float v = keep ? acc[e] : 0.f;
                      if (w < 4 && which == 0) { if (jt == tt) Ld[(tt * 16 + c16) * 16 + 4 * q + e] = v; v = -v; }
                      dst[t * CS + j] = (bf16)f2bf(v); } } } }
        __syncthreads();
        if (w == 0) { float s[16]; const LAS float* Lb = Ld + q * 256;
#pragma unroll
            for (int i = 0; i < 16; ++i) s[i] = (i == c16) ? 1.f : 0.f;
#pragma unroll
            for (int j = 0; j < 16; ++j) { const float Tj = s[j]; Tbb[(q * 16 + j) * 16 + c16] = (bf16)f2bf(Tj);
#pragma unroll
                for (int ci = (j + 1) / 4; ci < 4; ++ci) { const f32x4 lc = *(const LAS f32x4*)(Lb + j * 16 + 4 * ci);
#pragma unroll
                    for (int e = 0; e < 4; ++e) if (4 * ci + e > j) s[4 * ci + e] -= lc[e] * Tj; } } }
        f32x4 X[4]; s16x4_t vB[4]; f32x4 qv[4], yv[4];
        if (w < 4) {
#pragma unroll
            for (int bb = 0; bb < 4; ++bb)
#pragma unroll
                for (int e = 0; e < 4; ++e) X[bb][e] = bflo((unsigned)At[(16 * bb + 4 * q + e) * CS + 16 * w + c16]);
#pragma unroll
            for (int bb = 0; bb < 4; ++bb) { vB[bb] = (s16x4_t){0, 0, 0, 0}; qv[bb] = (f32x4){0.f, 0.f, 0.f, 0.f}; yv[bb] = qv[bb]; }
        } else {
#pragma unroll
            for (int bb = 0; bb < 4; ++bb) vB[bb] = lds4(VT + (16 * (w - 4) + c16) * CS + 16 * bb + 4 * q);
#pragma unroll
            for (int bb = 0; bb < 4; ++bb) { f32x4 acc = (f32x4){0.f, 0.f, 0.f, 0.f};
#pragma unroll
                for (int jb = 0; jb <= bb; ++jb) acc = mfma16(lds4(Lak + (16 * bb + c16) * CS + 16 * jb + 4 * q), vB[jb], acc);
                X[bb] = acc; }
#pragma unroll
            for (int ct = 0; ct < 4; ++ct) { f32x4 acc = (f32x4){0.f, 0.f, 0.f, 0.f};
#pragma unroll
                for (int bb = 0; bb < 4; ++bb) acc = mfma16(lds4(KT + (16 * ct + c16) * CS + 16 * bb + 4 * q), vB[bb], acc);
                qv[ct] = acc; }
#pragma unroll
            for (int tt = 0; tt < 4; ++tt) { f32x4 acc = (f32x4){0.f, 0.f, 0.f, 0.f};
#pragma unroll
                for (int bb = 0; bb <= tt; ++bb) acc = mfma16(lds4(Mrk + (16 * tt + c16) * CS + 16 * bb + 4 * q), vB[bb], acc);
                yv[tt] = acc; }
            { const int vt = w - 4; v4u* VGF = (v4u*)(F.ws + WS_VGF) + ((size_t)u * 16 + vt * 4) * 64 + lane;
#pragma unroll
              for (int tt = 0; tt < 4; ++tt) { const v2u vv2 = __builtin_bit_cast(v2u, vB[tt]); const v2u gg2 = *(const LAS v2u*)(GT + (16 * vt + c16) * CS + 16 * tt + 4 * q);
                  v4u o; o.x = vv2.x; o.y = vv2.y; o.z = gg2.x; o.w = gg2.y; __builtin_nontemporal_store(o, VGF + tt * 64); } }
        }
        __syncthreads();
        s16x4_t XB[4];
#pragma unroll
        for (int bb = 0; bb < 4; ++bb) {
            f32x4 r = X[bb];
#pragma unroll
            for (int jb = 0; jb < bb; ++jb) r = mfma16(lds4(NLab + (16 * bb + c16) * CS + 16 * jb + 4 * q), pk4(X[jb][0], X[jb][1], X[jb][2], X[jb][3]), r);
            const f32x4 z = (f32x4){0.f, 0.f, 0.f, 0.f};
            X[bb] = mfma16(lds4(Tbb + (bb * 16 + c16) * 16 + 4 * q), pk4(r[0], r[1], r[2], r[3]), z);
        }
#pragma unroll
        for (int bb = 0; bb < 4; ++bb) XB[bb] = pk4(-X[bb][0], -X[bb][1], -X[bb][2], -X[bb][3]);
        if (w < 4) {
            s16x4_t* PF = (s16x4_t*)(F.ws + WS_PF) + ((size_t)u * 16 + w * 4) * 64 + lane;
#pragma unroll
            for (int ct = 0; ct < 4; ++ct) { f32x4 acc = (f32x4){0.f, 0.f, 0.f, 0.f};
#pragma unroll
                for (int bb = 0; bb < 4; ++bb) acc = mfma16(XB[bb], lds4(BT + (16 * ct + c16) * CS + 16 * bb + 4 * q), acc);
                const float g63 = SEG[64 + 16 * ct + c16];
#pragma unroll
                for (int e = 0; e < 4; ++e) acc[e] = (acc[e] + ((ct == w && 4 * q + e == c16) ? 1.f : 0.f)) * g63;
                __builtin_nontemporal_store(pk4(acc[0], acc[1], acc[2], acc[3]), PF + ct * 64); }
            s16x4_t* RWF = (s16x4_t*)(F.ws + WS_RWF) + ((size_t)u * 16 + w) * 64 + lane;
#pragma unroll
            for (int tt = 0; tt < 4; ++tt) { const v2u rr = *(const LAS v2u*)(Rt + (16 * tt + c16) * CS + 16 * w + 4 * q);
                f32x4 acc; acc[0] = bflo(rr.x); acc[1] = bfhi(rr.x); acc[2] = bflo(rr.y); acc[3] = bfhi(rr.y);
#pragma unroll
                for (int bb = 0; bb <= tt; ++bb) acc = mfma16(XB[bb], lds4(Mrb + (16 * tt + c16) * CS + 16 * bb + 4 * q), acc);
                __builtin_nontemporal_store(pk4(acc[0], acc[1], acc[2], acc[3]), RWF + tt * 4 * 64); }
        } else {
            const int vt = w - 4;
            s16x4_t* QF = (s16x4_t*)(F.ws + WS_QF) + ((size_t)u * 16 + vt * 4) * 64 + lane;
#pragma unroll
            for (int ct = 0; ct < 4; ++ct) { f32x4 acc = qv[ct];
#pragma unroll
                for (int bb = 0; bb < 4; ++bb) acc = mfma16(lds4(BT + (16 * ct + c16) * CS + 16 * bb + 4 * q), XB[bb], acc);
                const f32x4 g63 = *(const LAS f32x4*)(SEG + 64 + 16 * ct + 4 * q);
                { const f32x4 qq = acc * g63; __builtin_nontemporal_store(pk4(qq[0], qq[1], qq[2], qq[3]), QF + ct * 64); } }
            s16x4_t* Y0F = (s16x4_t*)(F.ws + WS_Y0F) + ((size_t)u * 16 + vt * 4) * 64 + lane;
#pragma unroll
            for (int tt = 0; tt < 4; ++tt) { f32x4 acc = yv[tt];
#pragma unroll
                for (int bb = 0; bb <= tt; ++bb) acc = mfma16(lds4(Mrb + (16 * tt + c16) * CS + 16 * bb + 4 * q), XB[bb], acc);
                __builtin_nontemporal_store(pk4(acc[0], acc[1], acc[2], acc[3]), Y0F + tt * 64); }
        }
        __syncthreads();
    }
}

__device__ __forceinline__ void scanB_phase(const Frame& F) {
    const int task = F.vcu >> 1;
    if (F.wave != 0 || (F.vcu & 1) || task >= 128) return;
    const int lane = F.lane, bh = task >> 2, vt = task & 3;
    const s16x4_t* PF = (const s16x4_t*)(F.ws + WS_PF) + (size_t)bh * 64 * 16 * 64 + lane;
    const s16x4_t* QF = (const s16x4_t*)(F.ws + WS_QF) + ((size_t)bh * 64 * 16 + vt * 4) * 64 + lane;
    s16x4_t* S0F = (s16x4_t*)(F.ws + WS_S0F) + ((size_t)bh * 64 * 16 + vt * 4) * 64 + lane;
    f32x4 S[4];
#pragma unroll
    for (int i = 0; i < 4; ++i) S[i] = (f32x4){0.f, 0.f, 0.f, 0.f};
    s16x4_t P0[16], P1[16], P2[16]; s16x4_t Q0[4], Q1[4], Q2[4];
#define SB_LOAD(P, Q, C) do { _Pragma("unroll") for (int i = 0; i < 16; ++i) P[i] = __builtin_nontemporal_load(PF + ((size_t)(C) * 16 + i) * 64); _Pragma("unroll") for (int i = 0; i < 4; ++i) Q[i] = __builtin_nontemporal_load(QF + ((size_t)(C) * 16 + i) * 64); } while (0)
#define SB_STEP(P, Q, C) do { s16x4_t Sb[4]; \
        _Pragma("unroll") for (int i = 0; i < 4; ++i) { Sb[i] = pk4(S[i][0], S[i][1], S[i][2], S[i][3]); __builtin_nontemporal_store(Sb[i], S0F + ((size_t)(C) * 16 + i) * 64); } \
        _Pragma("unroll") for (int ct = 0; ct < 4; ++ct) { const v2u qb_ = __builtin_bit_cast(v2u, Q[ct]); f32x4 acc; acc[0] = bflo(qb_.x); acc[1] = bfhi(qb_.x); acc[2] = bflo(qb_.y); acc[3] = bfhi(qb_.y); \
            _Pragma("unroll") for (int kb = 0; kb < 4; ++kb) acc = mfma16(P[kb * 4 + ct], Sb[kb], acc); \
            S[ct] = acc; } } while (0)
    SB_LOAD(P0, Q0, 0); SB_LOAD(P1, Q1, 1); SB_LOAD(P2, Q2, 2);
#pragma unroll 1
    for (int c = 0; c < 63; c += 3) {
        SB_STEP(P0, Q0, c);     SB_LOAD(P0, Q0, c + 3);
        SB_STEP(P1, Q1, c + 1); if (c + 4 < 64) SB_LOAD(P1, Q1, c + 4);
        SB_STEP(P2, Q2, c + 2); if (c + 5 < 64) SB_LOAD(P2, Q2, c + 5);
    }
    SB_STEP(P0, Q0, 63);
#undef SB_LOAD
#undef SB_STEP
}

__device__ __forceinline__ void scanC_phase(const Frame& F, const In& I, int l) {
    bf16* YB = (bf16*)(F.ws + WS_AY) + 1024;
    const int gw = F.vcu * NWAVES + F.wave, NGW = F.G * NWAVES, lane = F.lane, c16 = lane & 15, q = lane >> 4;
    for (int it = 0; it * NGW < 2048; ++it) { const int u = (CHUNK_LOCAL && F.G == 256) ? chunk_unit(F.vcu, F.wave, F.G) : gw + it * NGW; if (u >= 2048) break;
        const int c = u & 63, H = (u >> 6) & 15, b = u >> 10;
        const s16x4_t* RWF = (const s16x4_t*)(F.ws + WS_RWF) + (size_t)u * 16 * 64 + lane;
        const s16x4_t* S0F = (const s16x4_t*)(F.ws + WS_S0F) + (size_t)u * 16 * 64 + lane;
        const s16x4_t* Y0F = (const s16x4_t*)(F.ws + WS_Y0F) + (size_t)u * 16 * 64 + lane;
        const v4u* VGF = (const v4u*)(F.ws + WS_VGF) + (size_t)u * 16 * 64 + lane;
        const float* RK = (const float*)(F.ws + WS_RK) + (size_t)u * 64;
        s16x4_t rw[16], s0[16];
#pragma unroll
        for (int i = 0; i < 16; ++i) { rw[i] = __builtin_nontemporal_load(RWF + i * 64); s0[i] = __builtin_nontemporal_load(S0F + i * 64); }
        float lnw[4], lnb[4];
#pragma unroll
        for (int vt = 0; vt < 4; ++vt) { lnw[vt] = I.ln_w[l * 1024 + H * 64 + 16 * vt + c16]; lnb[vt] = I.ln_b[l * 1024 + H * 64 + 16 * vt + c16]; }
        bf16* yb = YB + ((size_t)(b * SEQ + c * 64)) * 2048 + H * 64;
        s16x4_t yn[4]; v4u vgn[4]; f32x4 rkn;
#pragma unroll
        for (int vt = 0; vt < 4; ++vt) { yn[vt] = __builtin_nontemporal_load(Y0F + (vt * 4) * 64); vgn[vt] = __builtin_nontemporal_load(VGF + (vt * 4) * 64); }
        rkn = *(const GAS f32x4*)(RK + 4 * q);
#pragma unroll
        for (int tt = 0; tt < 4; ++tt) {
            f32x4 y[4]; v4u vg[4]; const f32x4 rk4 = rkn;
#pragma unroll
            for (int vt = 0; vt < 4; ++vt) { const v2u yb_ = __builtin_bit_cast(v2u, yn[vt]); y[vt][0] = bflo(yb_.x); y[vt][1] = bfhi(yb_.x); y[vt][2] = bflo(yb_.y); y[vt][3] = bfhi(yb_.y); vg[vt] = vgn[vt]; }
            if (tt < 3) {
#pragma unroll
                for (int vt = 0; vt < 4; ++vt) { yn[vt] = __builtin_nontemporal_load(Y0F + (vt * 4 + tt + 1) * 64); vgn[vt] = __builtin_nontemporal_load(VGF + (vt * 4 + tt + 1) * 64); }
                rkn = *(const GAS f32x4*)(RK + 16 * (tt + 1) + 4 * q); }
            __builtin_amdgcn_sched_barrier(0);
#pragma unroll
            for (int vt = 0; vt < 4; ++vt) { f32x4 acc = y[vt];
#pragma unroll
                for (int kb = 0; kb < 4; ++kb) acc = mfma16(rw[tt * 4 + kb], s0[vt * 4 + kb], acc);
                y[vt] = acc; }
#pragma unroll
            for (int e = 0; e < 4; ++e) {
                float s = (y[0][e] + y[1][e]) + (y[2][e] + y[3][e]); s = red16(s); const float mu = s * (1.f / 64.f);
                const float d0 = y[0][e] - mu, d1 = y[1][e] - mu, d2 = y[2][e] - mu, d3 = y[3][e] - mu;
                float s2 = (d0 * d0 + d1 * d1) + (d2 * d2 + d3 * d3); s2 = red16(s2);
                const float rs = __builtin_amdgcn_rsqf(s2 * (1.f / 64.f) + GN_EPS);
                y[0][e] = d0 * rs; y[1][e] = d1 * rs; y[2][e] = d2 * rs; y[3][e] = d3 * rs; }
#pragma unroll
            for (int vt = 0; vt < 4; ++vt) { const unsigned vw[2] = {vg[vt].x, vg[vt].y}, gw_[2] = {vg[vt].z, vg[vt].w};
#pragma unroll
                for (int e = 0; e < 4; ++e) { const float vv = (e & 1) ? bfhi(vw[e >> 1]) : bflo(vw[e >> 1]), gg = (e & 1) ? bfhi(gw_[e >> 1]) : bflo(gw_[e >> 1]);
                    const float o = (y[vt][e] * lnw[vt] + lnb[vt] + rk4[e] * vv) * gg;
                    if (F8_MRG) ((GAS unsigned char*)(F.ws + WS_AY))[1024 + ((size_t)(b * SEQ + c * 64) + 16 * tt + 4 * q + e) * 2048 + H * 64 + 16 * vt + c16] = (unsigned char)__builtin_amdgcn_cvt_pk_fp8_f32(16.f * o, 0.f, 0, false);
                    else yb[(size_t)(16 * tt + 4 * q + e) * 2048 + 16 * vt + c16] = (bf16)f2bf(o); } }
        }
    }
}

__device__ __forceinline__ void router_phase(const Frame& F, const In& I, int l, const bf16* X, int cslot = -1, size_t rt_off = 0) {
    const bf16* lw = (const bf16*)(F.ws + WS_LORA); float* RS = (float*)(F.ws + WS_RSTD);
    if (cslot < 0) cslot = l;
    int* ST = (int*)(F.ws + WS_SLOT_TOK + rt_off) + (size_t)l * NEXP * ECAP; float* SW = (float*)(F.ws + WS_SLOT_W + rt_off) + (size_t)l * NEXP * ECAP;
    LAS float* ssq = (LAS float*)(F.lds); LAS float* part = (LAS float*)(F.lds + 1024); LAS float* logit = (LAS float*)(F.lds + 1024 + 49152);
    LAS int* lcnt = (LAS int*)(F.lds + 1024 + 49152 + 6144); LAS int* lbase = lcnt + 32; LAS int* tsel = lbase + 32; LAS float* twt = (LAS float*)(tsel + 128);
    const int lane = F.lane, tl = lane & 15, q4 = lane >> 4;
    for (int u = F.vcu; u < NTOK / 32; u += F.G) {
        const int tok0 = 32 * u;
        if (F.tid < 32) lcnt[F.tid] = 0;
        { f32x4 acc[2][3]; float ss[2] = {0.f, 0.f};
#pragma unroll
          for (int mt = 0; mt < 2; ++mt)
#pragma unroll
              for (int nt = 0; nt < 3; ++nt) acc[mt][nt] = (f32x4){0.f, 0.f, 0.f, 0.f};
#pragma unroll 4
          for (int ks = 0; ks < 8; ++ks) { const int k = 256 * F.wave + 32 * ks + 8 * q4;
              bf16x8 ah[2];
#pragma unroll
              for (int mt = 0; mt < 2; ++mt) { const v4u xb = *(const GAS v4u*)(X + (size_t)(tok0 + 16 * mt + tl) * DM + k); ah[mt] = __builtin_bit_cast(bf16x8, xb);
                  const float a0 = bflo(xb.x), a1 = bfhi(xb.x), a2 = bflo(xb.y), a3 = bfhi(xb.y), a4 = bflo(xb.z), a5 = bfhi(xb.z), a6 = bflo(xb.w), a7 = bfhi(xb.w);
                  ss[mt] += ((a0 * a0 + a1 * a1) + (a2 * a2 + a3 * a3)) + ((a4 * a4 + a5 * a5) + (a6 * a6 + a7 * a7)); }
#pragma unroll
              for (int nt = 0; nt < 3; ++nt) { const size_t wo = (size_t)(16 * nt + tl) * 2048 + k;
                  const bf16x8 bh = *(const GAS bf16x8*)(lw + LO_RH + wo), bl = *(const GAS bf16x8*)(lw + LO_RL + wo);
#pragma unroll
                  for (int mt = 0; mt < 2; ++mt) { acc[mt][nt] = __builtin_amdgcn_mfma_f32_16x16x32_bf16(ah[mt], bh, acc[mt][nt], 0, 0, 0);
                      acc[mt][nt] = __builtin_amdgcn_mfma_f32_16x16x32_bf16(ah[mt], bl, acc[mt][nt], 0, 0, 0); } } }
#pragma unroll
          for (int mt = 0; mt < 2; ++mt) { ss[mt] += __shfl_xor(ss[mt], 16); ss[mt] += __shfl_xor(ss[mt], 32); if (q4 == 0) ssq[F.wave * 32 + 16 * mt + tl] = ss[mt]; }
#pragma unroll
          for (int mt = 0; mt < 2; ++mt)
#pragma unroll
              for (int nt = 0; nt < 3; ++nt)
#pragma unroll
                  for (int e = 0; e < 4; ++e) part[(F.wave * 32 + 16 * mt + 4 * q4 + e) * 48 + 16 * nt + tl] = acc[mt][nt][e]; }
        __syncthreads();
        for (int idx = F.tid; idx < 32 * 36; idx += NTHR) { const int t = idx / 36, c = idx - t * 36; float s = 0.f, q = 0.f;
#pragma unroll
            for (int w = 0; w < 8; ++w) { s += part[(w * 32 + t) * 48 + c]; q += ssq[w * 32 + t]; }
            const float rstd = __builtin_amdgcn_rsqf(q * (1.f / DM) + NORM_EPS);
            if (c == 0) RS[tok0 + t] = rstd;
            s = s * rstd + ((c < 32) ? I.re_b[l * 32 + c] : I.rg_b[l * 4 + (c - 32)]); logit[t * 48 + c] = s; }
        __syncthreads();
        if (F.tid < 32) { const int t = F.tid; const LAS float* lg = logit + t * 48;
            int gs = 0; float gm = lg[32];
#pragma unroll
            for (int j = 1; j < 4; ++j) if (lg[32 + j] > gm) { gm = lg[32 + j]; gs = j; }
            float den = 0.f;
#pragma unroll
            for (int j = 0; j < 4; ++j) den += __expf(lg[32 + j] - gm);
            const float gp = 1.f / den;
            int i1 = 0; float v1 = lg[gs * 8];
#pragma unroll
            for (int j = 1; j < 8; ++j) if (lg[gs * 8 + j] > v1) { v1 = lg[gs * 8 + j]; i1 = j; }
            int i2 = -1; float v2 = -3.0e38f;
#pragma unroll
            for (int j = 0; j < 8; ++j) if (j != i1 && lg[gs * 8 + j] > v2) { v2 = lg[gs * 8 + j]; i2 = j; }
            const float e2 = __expf(v2 - v1); const float wa = gp / (1.f + e2), wb = gp * e2 / (1.f + e2);
            const int ea = gs * 8 + i1, eb = gs * 8 + i2;
            tsel[t * 4 + 0] = ea; tsel[t * 4 + 1] = eb; tsel[t * 4 + 2] = atomicAdd((int*)(lcnt + ea), 1); tsel[t * 4 + 3] = atomicAdd((int*)(lcnt + eb), 1);
            twt[t * 2] = wa; twt[t * 2 + 1] = wb; }
        __syncthreads();
        if (F.tid < 32) lbase[F.tid] = (int)atomicAdd(F.ctl + CW_CNT + 64 * cslot + F.tid, (unsigned)lcnt[F.tid]);
        __syncthreads();
        if (F.tid < 64) { const int t = F.tid >> 1, k = F.tid & 1; const int e = tsel[t * 4 + k]; const int i = (tok0 + t) * 2 + k;
            const int slot = e * ECAP + lbase[e] + tsel[t * 4 + 2 + k]; ST[slot] = i; SW[slot] = twt[t * 2 + k]; }
        __syncthreads();
    }
}

__device__ __forceinline__ void moe_tables(const Frame& F, int l) {
    LAS int* panel_e = (LAS int*)(F.lds + LDS_PANEL); LAS int* panel_sb = (LAS int*)(F.lds + LDS_PSB); LAS int* tab = (LAS int*)(F.lds + LDS_TAB);
    if (F.tid < 32) tab[F.tid] = (int)__hip_atomic_load(F.ctl + CW_CNT + 64 * l + F.tid, __ATOMIC_RELAXED, __HIP_MEMORY_SCOPE_AGENT);
    __syncthreads();
    if (F.tid == 0) { int pp = 0;
        for (int e = 0; e < 32; ++e) { const int np = (tab[e] + 255) >> 8; for (int j = 0; j < np; ++j) { panel_e[pp + j] = e; panel_sb[pp + j] = e * ECAP + 256 * j; } pp += np; }
        tab[65] = pp; }
    __syncthreads();
}
__device__ __forceinline__ void combine_phase(const Frame& F, const In& I, int l, const bf16* X, float* out, bool dummy = false) {
    const bf16* MO = (const bf16*)(F.ws + WS_MOEOUT); bf16* XC = (bf16*)(F.ws + (dummy ? WS_TMP : WS_X)); bf16* Hn = (bf16*)(F.ws + (dummy ? WS_ATTN : WS_H));
    const int gw = F.vcu * NWAVES + F.wave, NGW = F.G * NWAVES, lane = F.lane;
    const float* w = (l == 0) ? (I.attn_norm_w + DM) : I.final_w;
    for (int rp_ = 0; rp_ * 2 * NGW < NTOK; ++rp_) {
        f32x4 v[2][8]; float s[2] = {0.f, 0.f};
#pragma unroll
        for (int r = 0; r < 2; ++r) { const int m = row_of(gw, 2 * rp_ + r, NGW); if (m < NTOK) {
            const GAS v2u* xr = (const GAS v2u*)(X + (size_t)m * DM) + lane; const GAS v2u* m0 = (const GAS v2u*)(MO + (size_t)m * DM) + lane; const GAS v2u* m1 = (const GAS v2u*)(MO + ((size_t)NTOK + m) * DM) + lane;
#pragma unroll
            for (int j = 0; j < 8; ++j) { const v2u a = __builtin_nontemporal_load(m0 + 64 * j), b = __builtin_nontemporal_load(m1 + 64 * j); { const v2u xb = xr[64 * j]; v[r][j].x = bflo(xb.x); v[r][j].y = bfhi(xb.x); v[r][j].z = bflo(xb.y); v[r][j].w = bfhi(xb.y); }
                v[r][j].x += bflo(a.x) + bflo(b.x); v[r][j].y += bfhi(a.x) + bfhi(b.x); v[r][j].z += bflo(a.y) + bflo(b.y); v[r][j].w += bfhi(a.y) + bfhi(b.y);
                s[r] += (v[r][j].x * v[r][j].x + v[r][j].y * v[r][j].y) + (v[r][j].z * v[r][j].z + v[r][j].w * v[r][j].w); } } }
#pragma unroll
        for (int r = 0; r < 2; ++r) { const int m = row_of(gw, 2 * rp_ + r, NGW); if (m < NTOK) {
            const GAS f32x4* wr = (const GAS f32x4*)w + lane;
            const float rstd = __builtin_amdgcn_rsqf(wave_sum(s[r]) * (1.f / DM) + NORM_EPS);
            if (l == 0) { GAS v2u* xo = (GAS v2u*)(XC + (size_t)m * DM) + lane; GAS v2u* o8 = (GAS v2u*)(Hn + (size_t)m * DM) + lane; GAS unsigned* o4 = (GAS unsigned*)((GAS unsigned char*)Hn + (size_t)m * DM) + lane;
                float qs = 0.f;
                if (F8_IN == 2) { float mx = 0.f;
#pragma unroll
                    for (int j = 0; j < 8; ++j) { const f32x4 hh = v[r][j] * rstd * wr[64 * j]; mx = fmaxf(mx, fmaxf(fmaxf(fabsf(hh.x), fabsf(hh.y)), fmaxf(fabsf(hh.z), fabsf(hh.w)))); }
                    mx = fmaxf(wave_max(mx), 1e-20f); qs = 127.f / mx; if (lane == 0) ((float*)(F.ws + WS_ASC))[m] = mx * (1.f / (127.f * IN_WS)); }
#pragma unroll
                for (int j = 0; j < 8; ++j) { { v2u xq; xq.x = pk2(v[r][j].x, v[r][j].y); xq.y = pk2(v[r][j].z, v[r][j].w); xo[64 * j] = xq; } const f32x4 ww = wr[64 * j];
                    if (F8_IN == 2) { o4[64 * j] = pack_i8x4(v[r][j].x * rstd * ww.x * qs, v[r][j].y * rstd * ww.y * qs, v[r][j].z * rstd * ww.z * qs, v[r][j].w * rstd * ww.w * qs); continue; }
                    if (F8_GATE) { int p = 0; p = __builtin_amdgcn_cvt_pk_fp8_f32(v[r][j].x * rstd * ww.x, v[r][j].y * rstd * ww.y, p, false); p = __builtin_amdgcn_cvt_pk_fp8_f32(v[r][j].z * rstd * ww.z, v[r][j].w * rstd * ww.w, p, true); ((GAS unsigned*)(F.ws + WS_H8 + (size_t)m * DM) + lane)[64 * j] = (unsigned)p; }
                    if (F8_IN) { int p = 0; p = __builtin_amdgcn_cvt_pk_fp8_f32(v[r][j].x * rstd * ww.x, v[r][j].y * rstd * ww.y, p, false); p = __builtin_amdgcn_cvt_pk_fp8_f32(v[r][j].z * rstd * ww.z, v[r][j].w * rstd * ww.w, p, true); o4[64 * j] = (unsigned)p; }
                    else { v2u o; o.x = pk2(v[r][j].x * rstd * ww.x, v[r][j].y * rstd * ww.y); o.y = pk2(v[r][j].z * rstd * ww.z, v[r][j].w * rstd * ww.w); o8[64 * j] = o; } } }
            else { GAS f32x4* oo = (GAS f32x4*)(out + (size_t)m * DM) + lane;
#pragma unroll
                for (int j = 0; j < 8; ++j) __builtin_nontemporal_store(v[r][j] * rstd * wr[64 * j], oo + 64 * j); } } }
    }
}

#ifndef MERGE_WGM
#define MERGE_WGM 8
#endif
#ifndef GEMMIN_WGM
#define GEMMIN_WGM 8
#endif
#ifndef DOWN_ALIGN
#define DOWN_ALIGN true
#endif
#ifndef CV_T1
#define CV_T1 4608
#endif
#ifndef GEMMIN_SP2
#define GEMMIN_SP2 true
#endif
#ifndef GEMMIN_ALIGN
#define GEMMIN_ALIGN true
#endif
#ifndef PROBE_MASK
#define PROBE_MASK 0
#endif
#ifndef CUT
#define CUT 0
#endif
__device__ __forceinline__ void finalize_phase(const Frame& F, const In& I, const bf16* X, float* out) {
    const int gw = F.vcu * NWAVES + F.wave, NGW = F.G * NWAVES, lane = F.lane;
    for (int m = gw; m < NTOK; m += NGW) {
        const GAS v2u* xr = (const GAS v2u*)(X + (size_t)m * DM) + lane; const GAS f32x4* wr = (const GAS f32x4*)I.final_w + lane;
        f32x4 v[8]; float s = 0.f;
#pragma unroll
        for (int j = 0; j < 8; ++j) { const v2u xb = xr[64 * j]; v[j].x = bflo(xb.x); v[j].y = bfhi(xb.x); v[j].z = bflo(xb.y); v[j].w = bfhi(xb.y); s += (v[j].x * v[j].x + v[j].y * v[j].y) + (v[j].z * v[j].z + v[j].w * v[j].w); }
        const float rstd = __builtin_amdgcn_rsqf(wave_sum(s) * (1.f / DM) + NORM_EPS);
        GAS f32x4* oo = (GAS f32x4*)(out + (size_t)m * DM) + lane;
#pragma unroll
        for (int j = 0; j < 8; ++j) oo[64 * j] = v[j] * rstd * wr[64 * j];
    }
}
struct Args { const float* in[31]; float* out; unsigned char* ws; int ph_lo, ph_hi; };
#define PHASE_BEGIN if (ph >= lo && ph < hi) { { int t_ = threadIdx.x; asm volatile("" : "+v"(t_)); F.tid = t_; F.lane = t_ & 63; F.wave = __builtin_amdgcn_readfirstlane(t_ >> 6); unsigned char* w_ = args.ws; asm volatile("" : "+s"(w_)); F.ws = w_; F.ctl = (unsigned*)(w_ + WS_CTL); } const In I = load_in(F); \
    bf16* Hb = (bf16*)(F.ws + WS_H); bf16* PROJ = (bf16*)(F.ws + WS_PROJ); bf16* XC = (bf16*)(F.ws + WS_X); (void)Hb; (void)PROJ; (void)XC;
#define PHASE_END(last) if (ph + 1 < hi && !(last)) xcd_barrier(bar); } ++ph;
template <int l> __device__ __forceinline__ bool layer_body(Frame& F, const Args& args, const XcdBarrier& bar, int& ph, const int lo, const int hi) {

#if (PROBE_MASK & 1)
        if (l == 1) { PHASE_BEGIN conv_phase(F, I, 1); PHASE_END(false) }
#endif
#if F8_GATE
        PHASE_BEGIN { { pg8::Gemm g{Hb, (const bf16*)(F.ws + WS_WIN_T), NTOK, C_GATE, DM}; pg8::StaticOrder S; S.init(NTOK, C_GATE, F.G, (int)blockIdx.x, GEMMIN_WGM);
              pg8::EpiStoreBf16 E{PROJ, INP, (unsigned char*)(F.ws + WS_GATE8), 0, nullptr}; pg8::gemm_phase<pg8::EpiStoreBf16, pg8::StaticOrder, GEMMIN_ALIGN, GEMMIN_SP2>(F.lds, g, S, E); }
            { pg8::Gemm g{(const bf16*)(F.ws + WS_H8), (const bf16*)(F.ws + WS_WIN_T + WIN8_OFF), NTOK, INP - C_GATE, DM / 2}; pg8::ListOrder S; S.base.init(NTOK, INP - C_GATE, F.G, 0, GEMMIN_WGM);
              const int bx = (int)blockIdx.x; if (F.G == 256) { S.first = (bx < 128) ? bx : bx; S.stride = 128; S.cnt = (bx < 128) ? 1 : 3; if (bx >= 128) S.first = bx; } else { S.first = bx; S.stride = F.G; S.cnt = 1 << 20; }
              pg8::EpiStoreBf16 E{PROJ, INP, (unsigned char*)(F.ws + WS_GATE8), C_GATE / 256, nullptr}; pg8::gemm_phase<pg8::EpiStoreBf16, pg8::ListOrder, GEMMIN_ALIGN, GEMMIN_SP2, false, 124>(F.lds, g, S, E); }
            { __syncthreads(); const int d = conv_dense_items(l); conv_items(F, I, l, conv_first_items(l, F.G), d + ((F.G == 256) ? CV_B1 : 0), F.vcu, F.G); } } PHASE_END(false)
#else
        PHASE_BEGIN { pg8::Gemm g{Hb, (const bf16*)(F.ws + WS_WIN_T), NTOK, INP, F8_IN ? DM / 2 : DM}; pg8::StaticOrder S; S.init(NTOK, INP, F.G, (int)blockIdx.x, GEMMIN_WGM);
            pg8::EpiStoreBf16 E{PROJ, INP, (unsigned char*)(F.ws + WS_GATE8), 0, (F8_IN == 2) ? (const float*)(F.ws + WS_ASC) : nullptr}; pg8::gemm_phase<pg8::EpiStoreBf16, pg8::StaticOrder, GEMMIN_ALIGN, GEMMIN_SP2, false, (F8_IN == 1 ? 124 : 0), (F8_IN == 2)>(F.lds, g, S, E);
            if (F.G == 256) { const int d = conv_dense_items(l), c0 = conv_first_items(l, F.G), c1 = (F8_IN ? c0 + CV_T1 : d + CV_B1);
                if ((int)blockIdx.x >= 128) conv_items(F, I, l, c0, c1, (int)blockIdx.x - 128, 128);
                if (c1 < d + CV_B1) { __syncthreads(); conv_items(F, I, l, c1, d + CV_B1, F.vcu, F.G); } } } PHASE_END(false)
#endif
#if (PROBE_MASK & 2)
        PHASE_BEGIN { pg8::Gemm g{Hb, (const bf16*)(F.ws + WS_WIN_T), NTOK, INP, DM}; pg8::StaticOrder S; S.init(NTOK, INP, F.G, (int)blockIdx.x, GEMMIN_WGM);
            pg8::EpiStoreBf16 E{PROJ, INP, (unsigned char*)(F.ws + WS_GATE8), 0, nullptr}; pg8::gemm_phase<pg8::EpiStoreBf16, pg8::StaticOrder, true, true>(F.lds, g, S, E); } PHASE_END(false)
#endif
#ifdef UNFUSED_PREP
        PHASE_BEGIN attn_phase(F, I, l); prep_phase(F, I, l); PHASE_END(false)
#else
        PHASE_BEGIN acts_phase(F, I, l); attn_phase(F, I, l); PHASE_END(false)
        PHASE_BEGIN chunk_phase(F, I, l); PHASE_END(false)
#endif
#if (PROBE_MASK & 4)
        PHASE_BEGIN acts_phase(F, I, l); attn_phase(F, I, l); PHASE_END(false)
#endif
#if (PROBE_MASK & 64)
        PHASE_BEGIN attn_phase(F, I, l); PHASE_END(false)
#endif
#ifdef SEQ_SCAN
        PHASE_BEGIN scan_phase(F); PHASE_END(false)
#else
#ifdef UNFUSED_PREP
        PHASE_BEGIN scanA_phase(F, I, l); PHASE_END(false)
#endif
        PHASE_BEGIN scanB_phase(F); if (F.G == 256 && (F.vcu & 1)) { const int d = conv_dense_items(l); conv_items(F, I, l, d + CV_B1, d + CV_B2, F.vcu >> 1, 128); } PHASE_END(false)
        PHASE_BEGIN scanC_phase(F, I, l); PHASE_END(false)
#endif
#if (PROBE_MASK & 512)
        PHASE_BEGIN scanC_phase(F, I, l); PHASE_END(false)
#endif
#if (PROBE_MASK & 128)
        PHASE_BEGIN chunk_phase(F, I, l); PHASE_END(false)
#endif
#if (PROBE_MASK & 256)
        PHASE_BEGIN scanB_phase(F); PHASE_END(false)
#endif
#if defined(SEQ_SCAN)
        PHASE_BEGIN post_phase(F, I, l); PHASE_END(false)
#endif
        PHASE_BEGIN { pg8::Gemm g{(const bf16*)(F.ws + WS_AY), (const bf16*)(F.ws + WS_WA_T), NTOK, DM, F8_MRG ? 512 : 1024, F8_MRG ? DM / 2 : DM}; pg8::MergeOrder S; S.base.init(NTOK, DM, F.G, (int)blockIdx.x, MERGE_WGM);
            pg8::EpiMerge E{(const unsigned char*)(F.ws + WS_GATE8), (const unsigned char*)(F.ws + WS_GATE8) + 2048, 4096, (bf16*)(F.ws + WS_MERGED)}; pg8::gemm_phase<pg8::EpiMerge, pg8::MergeOrder, true, true, false, (F8_MRG ? 122 : 0)>(F.lds, g, S, E); } PHASE_END(false)
#if (PROBE_MASK & 32)
        PHASE_BEGIN { pg8::Gemm g{(const bf16*)(F.ws + WS_AY), (const bf16*)(F.ws + WS_WA_T), NTOK, DM, 1024, DM}; pg8::MergeOrder S; S.base.init(NTOK, DM, F.G, (int)blockIdx.x, MERGE_WGM);
            pg8::EpiMerge E{(const unsigned char*)(F.ws + WS_GATE8), (const unsigned char*)(F.ws + WS_GATE8) + 2048, 4096, (bf16*)(F.ws + WS_MERGED)}; pg8::gemm_phase<pg8::EpiMerge, pg8::MergeOrder, true, true>(F.lds, g, S, E); } PHASE_END(false)
#endif
        PHASE_BEGIN { pg8::Gemm g{(const bf16*)(F.ws + WS_MERGED), (const bf16*)(F.ws + WS_WOUT_T), NTOK, DM, F8_OUT ? DM / 2 : DM}; pg8::StaticOrder S; S.init(NTOK, DM, F.G, (int)blockIdx.x, MERGE_WGM);
            pg8::EpiResid<l == 0> E{I.x, XC, XC, (unsigned char*)(F.ws + WS_H)}; pg8::gemm_phase<pg8::EpiResid<l == 0>, pg8::StaticOrder, true, true, false, (F8_OUT ? 122 : 0)>(F.lds, g, S, E); } PHASE_END(false)
#if (PROBE_MASK & 1024)
        if (l == 0) { PHASE_BEGIN { pg8::Gemm g{(const bf16*)(F.ws + WS_MERGED), (const bf16*)(F.ws + WS_WOUT_T), NTOK, DM, DM}; pg8::StaticOrder S; S.init(NTOK, DM, F.G, (int)blockIdx.x, MERGE_WGM);
            pg8::EpiResid<true> E{I.x, XC, XC, (unsigned char*)(F.ws + WS_H)}; pg8::gemm_phase<pg8::EpiResid<true>, pg8::StaticOrder, true, true>(F.lds, g, S, E); } PHASE_END(false) }
#endif
        if (CUT == 1 + 2 * l) { PHASE_BEGIN finalize_phase(F, I, XC, args.out); PHASE_END(true) return true; }
#if (PROBE_MASK & 4096)
        PHASE_BEGIN router_phase(F, I, l, XC, 2 + l, 8 * MiB); PHASE_END(false)
#endif
        PHASE_BEGIN router_phase(F, I, l, XC); { const int d = conv_dense_items(l); conv_items(F, I, l, (F.G == 256) ? d + CV_B2 : d, d + CV_MOE, F.vcu, F.G); } PHASE_END(false)
#define MOE_UP(FIRST, STRIDE, LIMIT) do { pg8::Gemm g{(const bf16*)(F.ws + (F8_MOE ? WS_H : WS_X)), (const bf16*)(F.ws + WS_WGU_T), MAXSLOT, NEXP * 1024, F8_MOE ? DM / 2 : DM}; \
            pg8::MoeOrder S{(FIRST), (STRIDE), (LIMIT), 4, (const LAS int*)(F.lds + LDS_PANEL), (const LAS int*)(F.lds + LDS_PSB)}; \
            pg8::EpiSwiGlu E{(bf16*)(F.ws + WS_HID), (const int*)(F.ws + WS_SLOT_TOK) + (size_t)l * NEXP * ECAP, (const float*)(F.ws + WS_RSTD)}; pg8::gemm_phase<pg8::EpiSwiGlu, pg8::MoeOrder, true, true, true, (F8_MOE ? 124 : 0)>(F.lds, g, S, E, (const int*)(F.ws + WS_SLOT_TOK) + (size_t)l * NEXP * ECAP); } while (0)
#define MOE_DOWN(FIRST, STRIDE, LIMIT) do { pg8::Gemm g{(const bf16*)(F.ws + WS_HID), (const bf16*)(F.ws + WS_WD_T), MAXSLOT, NEXP * DM, F8_MOE ? EH / 2 : EH}; \
            pg8::MoeOrder S{(FIRST), (STRIDE), (LIMIT), 8, (const LAS int*)(F.lds + LDS_PANEL), (const LAS int*)(F.lds + LDS_PSB)}; \
            pg8::EpiMoeDown E{(bf16*)(F.ws + WS_MOEOUT), (const int*)(F.ws + WS_SLOT_TOK) + (size_t)l * NEXP * ECAP, (const float*)(F.ws + WS_SLOT_W) + (size_t)l * NEXP * ECAP}; \
            pg8::gemm_phase<pg8::EpiMoeDown, pg8::MoeOrder, DOWN_ALIGN, true, false, (F8_MOE ? 123 : 0)>(F.lds, g, S, E); } while (0)
        PHASE_BEGIN { moe_tables(F, l); const int np = ((const LAS int*)(F.lds + LDS_TAB))[65], n_up = np * 4, G = F.G, c = F.vcu;
            MOE_UP(c, G, (n_up < G ? n_up : G)); } PHASE_END(false)
        PHASE_BEGIN { const int np = ((const LAS int*)(F.lds + LDS_TAB))[65], n_up = np * 4, G = F.G, c = F.vcu;
            const int R2 = moe_r2(np, G), n_early = moe_n_early(np, G);
            if (c < R2) MOE_UP(G + c, R2, n_up); else MOE_DOWN(c - R2, G - R2, n_early); } PHASE_END(false)
        PHASE_BEGIN { const int np = ((const LAS int*)(F.lds + LDS_TAB))[65], G = F.G, c = F.vcu;
            const int n_early = moe_n_early(np, G);
            MOE_DOWN(n_early + c, G, np * 8);
            if (l == 0) { const int idle = cv_z_idle(np, G); if (idle > 0 && c >= G - idle) conv_items(F, I, 1, 0, cv_z_items(np, G), c - (G - idle), idle); } } PHASE_END(false)
#if (PROBE_MASK & 16)
        PHASE_BEGIN { moe_tables(F, l); const int np = ((const LAS int*)(F.lds + LDS_TAB))[65], n_up = np * 4, G = F.G, c = F.vcu;
            MOE_UP(c, G, (n_up < G ? n_up : G)); } PHASE_END(false)
        PHASE_BEGIN { const int np = ((const LAS int*)(F.lds + LDS_TAB))[65], n_up = np * 4, G = F.G, c = F.vcu;
            const int R2 = moe_r2(np, G), n_early = moe_n_early(np, G);
            if (c < R2) MOE_UP(G + c, R2, n_up); else MOE_DOWN(c - R2, G - R2, n_early); } PHASE_END(false)
        PHASE_BEGIN { const int np = ((const LAS int*)(F.lds + LDS_TAB))[65], G = F.G, c = F.vcu;
            const int n_early = moe_n_early(np, G);
            MOE_DOWN(n_early + c, G, np * 8);
            if (false) { const int idle = cv_z_idle(np, G); if (idle > 0 && c >= G - idle) conv_items(F, I, 1, 0, cv_z_items(np, G), c - (G - idle), idle); } } PHASE_END(false)
#endif
#undef MOE_UP
#undef MOE_DOWN
#if (PROBE_MASK & 8192)
        PHASE_BEGIN combine_phase(F, I, 0, XC, args.out, true); PHASE_END(false)
#endif
        PHASE_BEGIN combine_phase(F, I, l, XC, args.out); if (l == 0) { __syncthreads(); conv_phase(F, I, 1, cv_z_items(((const LAS int*)(F.lds + LDS_TAB))[65], F.G)); } PHASE_END(l == 1)
        if (CUT == 2 && l == 0) { PHASE_BEGIN finalize_phase(F, I, XC, args.out); PHASE_END(true) return true; }
        return false;
}
__global__ void __launch_bounds__(NTHR, 2) hybrid_fwd(Args args) {
    extern __shared__ __attribute__((aligned(16))) unsigned char lds_raw[];
    Frame F;
    F.lds = (LAS unsigned char*)lds_raw; F.ws = args.ws; F.ctl = (unsigned*)(args.ws + WS_CTL);
    F.tid = threadIdx.x; F.lane = F.tid & 63; F.wave = __builtin_amdgcn_readfirstlane(F.tid >> 6);
    F.G = gridDim.x; { const int bx = blockIdx.x; F.vcu = (F.G % 8 == 0) ? (bx % 8) * (F.G / 8) + bx / 8 : bx; }
    for (int u = F.tid; u < (LDS_BYTES - LDSCTL_OFF) / 4; u += NTHR) ((LAS unsigned*)(F.lds + LDSCTL_OFF))[u] = 0u;
    __syncthreads();
    if (F.tid == 0) {
#pragma unroll
        for (int k = 0; k < 31; ++k) *(LAS unsigned long long*)(F.lds + LDS_PTRS + 8 * k) = (unsigned long long)args.in[k]; }
    __syncthreads();
    XcdBarrier bar = xcd_barrier_post(F.ctl + CW_BAR, (volatile LAS unsigned*)(F.lds + LDSCTL_OFF));
    const int lo = args.ph_lo, hi = args.ph_hi;
    int ph = 0;

    PHASE_BEGIN conv_phase(F, I, 0); norm_phase(F, I.x, I.attn_norm_w, Hb); PHASE_END(false)
#if (PROBE_MASK & 1)
    PHASE_BEGIN conv_phase(F, I, 0); PHASE_END(false)
#endif
    if (layer_body<0>(F, args, bar, ph, lo, hi)) return;
    (void)layer_body<1>(F, args, bar, ph, lo, hi);
}

extern "C" void kernel_launch(void* const* d_in, const int* in_sizes, int n_in, void* d_out, int out_size, void* d_ws, size_t ws_size, hipStream_t stream) {
    static int grid = 0;
    if (grid == 0) {
        if (n_in != 31 || out_size != NTOK * DM || ws_size < WS_END) { fprintf(stderr, "kernel_launch: unexpected shapes: n_in %d out %d ws %zu (need %zu)\n", n_in, out_size, ws_size, (size_t)WS_END); grid = -1; return; }
        int dev = 0, cus = 0, per_cu = 0;
        if (hipGetDevice(&dev) != hipSuccess || hipDeviceGetAttribute(&cus, hipDeviceAttributeMultiprocessorCount, dev) != hipSuccess) { grid = -1; return; }
        if (hipFuncSetAttribute((const void*)hybrid_fwd, hipFuncAttributeMaxDynamicSharedMemorySize, LDS_BYTES) != hipSuccess) { fprintf(stderr, "kernel_launch: hipFuncSetAttribute failed\n"); grid = -1; return; }
        if (hipOccupancyMaxActiveBlocksPerMultiprocessor(&per_cu, (const void*)hybrid_fwd, NTHR, LDS_BYTES) != hipSuccess || per_cu < 1) fprintf(stderr, "kernel_launch: occupancy query says %d\n", per_cu);
        (void)hipGetLastError();
        grid = cus;
    }
    if (grid < 0) return;
    (void)hipMemsetAsync((char*)d_ws + WS_CTL, 0, CTL_ZERO_BYTES, stream);
    (void)hipMemsetAsync((char*)d_ws + WS_SLOT_TOK, 0xFF, 2 * MiB, stream);
    Args a{};
    for (int i = 0; i < 31; ++i) a.in[i] = (const float*)d_in[i];
    a.out = (float*)d_out; a.ws = (unsigned char*)d_ws; a.ph_lo = 0; a.ph_hi = 1000;
    hipLaunchKernelGGL(hybrid_fwd, dim3(grid), dim3(NTHR), LDS_BYTES, stream, a);
}
```

```cpp
#include <hip/hip_runtime.h>
#include <cstdio>
#include <cstdint>

namespace pg8 {
#define PG8_LAS __attribute__((address_space(3)))
typedef unsigned short bf16_t;
typedef short bf16x8 __attribute__((ext_vector_type(8)));
typedef float f32x4 __attribute__((ext_vector_type(4)));
typedef unsigned u32x4 __attribute__((ext_vector_type(4)));
typedef unsigned u32x2 __attribute__((ext_vector_type(2)));
constexpr int BM = 256, BK = 64, HALF = 128, HTB = HALF * BK * 2  , STAGE_BYTES = 8 * HTB, NXCD = 8, WGM = 8;

__host__ __device__ __forceinline__ int lds_byte(int r, int c) { const int st = (r >> 4) * 2 + (c >> 5), rr = r & 15, cc = c & 31, ob = rr * 64 + cc * 2; return st * 1024 + (ob ^ (((ob >> 9) & 1) << 5)); }
__host__ __device__ __forceinline__ void stage_rc(int b, int& R, int& C) { const int st = b / 1024, sb = b % 1024, swz = sb ^ (((sb >> 9) & 1) << 5); R = (st >> 1) * 16 + swz / 64; C = (st & 1) * 32 + (swz % 64) / 2; }
__host__ __device__ __forceinline__ int perm32(int rho) { const int n = rho >> 4, i = rho & 15; return 8 * (i >> 2) + 4 * n + (i & 3); }

struct Unit { int pm, pn, kq, sb; };
struct Gemm { const bf16_t* A; const bf16_t* Bt; int M, N, K, ld; };

struct StaticOrder {
    int nM, nN, nwg, G, c, wgm;
    __host__ __device__ void init(int M, int N, int G_, int c_, int wgm_ = WGM) { nM = M / BM; nN = N / BM; nwg = nM * nN; G = G_; c = c_; wgm = wgm_; }
    __host__ __device__ bool next(int i, Unit& u) const { return at((long)i * G + c, u); }
    __host__ __device__ bool at(const long L, Unit& u) const {
        if (L >= nwg) return false;
        int wgid = (int)L; { const int q = nwg / NXCD, r = nwg % NXCD, xcd = wgid % NXCD, off = wgid / NXCD; wgid = (xcd < r ? xcd * (q + 1) : r * (q + 1) + (xcd - r) * q) + off; }
        const int nig = wgm * nN, gid = wgid / nig, fm = gid * wgm, gsz = (nM - fm) < wgm ? (nM - fm) : wgm;
        u.pm = fm + ((wgid % nig) % gsz); u.pn = (wgid % nig) / gsz; u.kq = 0; u.sb = 0; return true;
    }
    __device__ __forceinline__ void a_ready(const Unit&) const {}
    __device__ __forceinline__ void done(const Unit&) const {}
};
struct ListOrder {
    StaticOrder base; int first, stride, cnt;
    __device__ __forceinline__ bool next(int i, Unit& u) const { return (i < cnt) && base.at((long)first + (long)i * stride, u); }
    __device__ __forceinline__ void a_ready(const Unit&) const {}
    __device__ __forceinline__ void done(const Unit&) const {}
};
__device__ __forceinline__ unsigned cvt_pk_bf16(float lo, float hi) { unsigned r; asm volatile("v_cvt_pk_bf16_f32 %0, %1, %2" : "=v"(r) : "v"(lo), "v"(hi)); return r; }
typedef int i32x4_ __attribute__((ext_vector_type(4))); typedef int i32x8_ __attribute__((ext_vector_type(8)));
template <class Epi, class Sched, bool ALIGN_EPI = false, bool SP2 = false, bool GATHER = false, int F8 = 0, bool I8 = false>
__device__ __forceinline__ void gemm_phase(PG8_LAS unsigned char* lds, const Gemm g, const Sched& S, const Epi& E, const int* slot_tok = nullptr) {
    static_assert(!GATHER || SP2, "row-gathered A panels: SP2 loop only");
    int tid_ = threadIdx.x; asm volatile("" : "+v"(tid_));
    const int tid = tid_, wid = __builtin_amdgcn_readfirstlane(tid >> 6), lane = tid & 63, wr = wid >> 2, wc = wid & 3, fr = lane & 15, fq = lane >> 4;
    const int K = g.K, nt = K / BK, LD = g.ld ? g.ld : g.K;
    unsigned voffA[2], voffB[2];
#pragma unroll
    for (int i = 0; i < 2; ++i) { int R, C; stage_rc(tid * 16 + i * 8192, R, C); const int Rb = Epi::PERM ? ((R & ~31) + perm32(R & 31)) : R;
        voffA[i] = (unsigned)(R * LD + C) * 2u; voffB[i] = (unsigned)(Rb * LD + C) * 2u; }
    const size_t kstep = (size_t)(BK * 2);
    const size_t hstep = (size_t)HALF * LD * 2;
    const size_t tstep = 2 * hstep;
    const unsigned ldsw = (unsigned)wid * 1024u;
    const int aoff = lds_byte(wr * 64 + fr, fq * 8), boff = lds_byte(wc * 32 + fr, fq * 8);
#define PG8_SA(b, h) (((b) * 2 + (h)) * HTB)
#define PG8_SB(b, h) ((4 + (b) * 2 + (h)) * HTB)
#define PG8_STAGE(bufoff, gbase, voff) do { _Pragma("unroll") for (int _i = 0; _i < 2; ++_i) \
        __builtin_amdgcn_global_load_lds((const unsigned*)((const char*)(gbase) + (voff)[_i]), (PG8_LAS unsigned*)(lds + (bufoff) + ldsw + _i * 8192), 16, 0, 0); } while (0)
#define PG8_LDA(dst, b, h) do { _Pragma("unroll") for (int m = 0; m < 4; ++m) _Pragma("unroll") for (int k = 0; k < 2; ++k) dst[m][k] = *(const PG8_LAS bf16x8*)(lds + PG8_SA(b, h) + aoff + m * 2048 + k * 1024); } while (0)
#define PG8_LDB(dst, b, h) do { _Pragma("unroll") for (int n = 0; n < 2; ++n) _Pragma("unroll") for (int k = 0; k < 2; ++k) dst[n][k] = *(const PG8_LAS bf16x8*)(lds + PG8_SB(b, h) + boff + n * 2048 + k * 1024); } while (0)
#define PG8_CAT(x0, x1) __builtin_shufflevector(__builtin_bit_cast(i32x4_, x0), __builtin_bit_cast(i32x4_, x1), 0, 1, 2, 3, 4, 5, 6, 7)
#define PG8_MMA(ai, bj, At, Bt) do { __builtin_amdgcn_s_setprio(1); if constexpr (F8 != 0) { _Pragma("unroll") for (int m = 0; m < 4; ++m) _Pragma("unroll") for (int n = 0; n < 2; ++n) \
        { const i32x8_ _b8 = PG8_CAT(Bt[n][0], Bt[n][1]), _a8 = PG8_CAT(At[m][0], At[m][1]); asm volatile("v_mfma_scale_f32_16x16x128_f8f6f4 %0, %1, %2, %0, %3, %3 op_sel_hi:[0,0,0]" : "+v"(acc[ai][bj][m][n]) : "v"(_b8), "v"(_a8), "v"(f8scale)); } } else { \
        _Pragma("unroll") for (int m = 0; m < 4; ++m) _Pragma("unroll") for (int n = 0; n < 2; ++n) _Pragma("unroll") for (int k = 0; k < 2; ++k) { \
        if constexpr (I8) acc[ai][bj][m][n] = __builtin_bit_cast(f32x4, __builtin_amdgcn_mfma_i32_16x16x64_i8(__builtin_bit_cast(i32x4_, Bt[n][k]), __builtin_bit_cast(i32x4_, At[m][k]), __builtin_bit_cast(i32x4_, acc[ai][bj][m][n]), 0, 0, 0)); \
        else acc[ai][bj][m][n] = __builtin_amdgcn_mfma_f32_16x16x32_bf16(Bt[n][k], At[m][k], acc[ai][bj][m][n], 0, 0, 0); } } __builtin_amdgcn_s_setprio(0); } while (0)
#define PG8_WAIT_V(n) asm volatile("s_waitcnt vmcnt(" #n ")" ::: "memory")
#define PG8_WAIT_L(n) asm volatile("s_waitcnt lgkmcnt(" #n ")" ::: "memory")
#define PG8_BAR __builtin_amdgcn_s_barrier()
#define PG8_SCHED __builtin_amdgcn_sched_barrier(0)
    int gR[2]; unsigned gC[2]; unsigned gv[2][2], gn[2][2];
#pragma unroll
    for (int i = 0; i < 2; ++i) { int R, C; stage_rc(tid * 16 + i * 8192, R, C); gR[i] = R; gC[i] = (unsigned)C * 2u; gv[0][i] = gv[1][i] = gn[0][i] = gn[1][i] = 0u; }
#define PG8_GOFF(dst, u) do { _Pragma("unroll") for (int _h = 0; _h < 2; ++_h) _Pragma("unroll") for (int _i = 0; _i < 2; ++_i) { \
        const int _tk = slot_tok[(u).sb + _h * HALF + gR[_i]]; dst[_h][_i] = (unsigned)((_tk < 0 ? 0 : (_tk >> 1)) * LD) * 2u + gC[_i]; } } while (0)
#define PG8_STAGE_A(bufoff, gbase, H, NX) do { _Pragma("unroll") for (int _i = 0; _i < 2; ++_i) { unsigned _o; const char* _b; \
        if constexpr (GATHER) { _o = (NX) ? gn[H][_i] : gv[H][_i]; _b = (const char*)(gbase); } else { _o = voffA[_i]; _b = (const char*)(gbase) + (H) * hstep; } \
        __builtin_amdgcn_global_load_lds((const unsigned*)(_b + _o), (PG8_LAS unsigned*)(lds + (bufoff) + ldsw + _i * 8192), 16, 0, 0); } } while (0)
    int f8scale = F8; asm volatile("" : "+v"(f8scale));
    Unit cur, nxt; int ui = 0;
    if (!S.next(0, cur)) return;
    if constexpr (GATHER) PG8_GOFF(gv, cur);
    f32x4 acc[2][2][4][2];
#pragma unroll
    for (int a = 0; a < 2; ++a)
#pragma unroll
        for (int b = 0; b < 2; ++b)
#pragma unroll
            for (int m = 0; m < 4; ++m)
#pragma unroll
                for (int n = 0; n < 2; ++n) acc[a][b][m][n] = (f32x4){0.f, 0.f, 0.f, 0.f};
    bf16x8 At[4][2], B0[2][2], B1[2][2];
    const char* cA = (const char*)g.A + (GATHER ? (size_t)0 : (size_t)cur.pm * tstep) + (size_t)cur.kq * 2; const char* cB = (const char*)g.Bt + (size_t)cur.pn * tstep + (size_t)cur.kq * 2;
    S.a_ready(cur);
    if constexpr (SP2) {
        PG8_STAGE(PG8_SB(0, 0), cB, voffB); PG8_STAGE(PG8_SB(0, 1), cB + hstep, voffB); PG8_STAGE_A(PG8_SA(0, 0), cA, 0, false); PG8_STAGE_A(PG8_SA(0, 1), cA, 1, false);
        if (wr == 1) PG8_BAR;
        PG8_WAIT_V(2); PG8_BAR;
        PG8_STAGE(PG8_SB(1, 0), cB + kstep, voffB); PG8_STAGE_A(PG8_SA(1, 0), cA + kstep, 0, false); PG8_STAGE(PG8_SB(1, 1), cB + hstep + kstep, voffB);
        PG8_WAIT_V(6); PG8_BAR;
    } else {
        PG8_STAGE(PG8_SB(0, 0), cB, voffB); PG8_STAGE(PG8_SA(0, 0), cA, voffA); PG8_STAGE(PG8_SB(0, 1), cB + hstep, voffB); PG8_STAGE(PG8_SA(0, 1), cA + hstep, voffA);
        if (wr == 1) PG8_BAR;
        PG8_WAIT_V(4); PG8_BAR;
        PG8_STAGE(PG8_SB(1, 0), cB + kstep, voffB); PG8_STAGE(PG8_SA(1, 0), cA + kstep, voffA); PG8_STAGE(PG8_SB(1, 1), cB + hstep + kstep, voffB);
        PG8_WAIT_V(6); PG8_BAR;
    }
    for (;;) {
        const bool has_next = S.next(ui + 1, nxt);
        const char* nA = has_next ? (const char*)g.A + (GATHER ? (size_t)0 : (size_t)nxt.pm * tstep) + (size_t)nxt.kq * 2 : cA; const char* nB = has_next ? (const char*)g.Bt + (size_t)nxt.pn * tstep + (size_t)nxt.kq * 2 : cB;
        for (int t = 0; t < nt; t += 2) {
            const bool last = (t == nt - 2);
            const char* a1 = cA + (size_t)(t + 1) * kstep;
            const char* a2 = last ? nA : cA + (size_t)(t + 2) * kstep; const char* b2 = last ? nB : cB + (size_t)(t + 2) * kstep;
            const char* a3 = a2 + kstep; const char* b3 = b2 + kstep;
            if (last && has_next) { S.a_ready(nxt); if constexpr (GATHER) PG8_GOFF(gn, nxt); }
            const bool nx = last && has_next;
            if constexpr (SP2) {
            PG8_LDB(B0, 0, 0); PG8_LDB(B1, 0, 1); PG8_SCHED; PG8_LDA(At, 0, 0); PG8_STAGE_A(PG8_SA(1, 1), a1, 1, false);
            PG8_WAIT_V(8); PG8_WAIT_L(0); PG8_BAR; PG8_MMA(0, 0, At, B0); PG8_MMA(0, 1, At, B1); PG8_BAR; PG8_SCHED;
            PG8_LDA(At, 0, 1); PG8_STAGE(PG8_SB(0, 0), b2, voffB); PG8_STAGE(PG8_SB(0, 1), b2 + hstep, voffB); PG8_STAGE_A(PG8_SA(0, 0), a2, 0, nx);
            PG8_WAIT_V(8); PG8_WAIT_L(0); PG8_BAR; PG8_MMA(1, 0, At, B0); PG8_MMA(1, 1, At, B1); PG8_BAR; PG8_SCHED;
            PG8_LDB(B0, 1, 0); PG8_LDB(B1, 1, 1); PG8_SCHED; PG8_LDA(At, 1, 0); PG8_STAGE_A(PG8_SA(0, 1), a2, 1, nx);
            PG8_WAIT_V(8); PG8_WAIT_L(0); PG8_BAR; PG8_MMA(0, 0, At, B0); PG8_MMA(0, 1, At, B1); PG8_BAR; PG8_SCHED;
            PG8_LDA(At, 1, 1); PG8_STAGE(PG8_SB(1, 0), b3, voffB); PG8_STAGE(PG8_SB(1, 1), b3 + hstep, voffB); PG8_STAGE_A(PG8_SA(1, 0), a3, 0, nx);
            PG8_WAIT_V(8); PG8_WAIT_L(0); PG8_BAR; PG8_MMA(1, 0, At, B0); PG8_MMA(1, 1, At, B1); PG8_BAR; PG8_SCHED;
            } else {
            PG8_LDB(B0, 0, 0); PG8_SCHED; PG8_LDA(At, 0, 0); PG8_STAGE(PG8_SA(1, 1), a1 + hstep, voffA);
            PG8_WAIT_L(8); PG8_BAR; PG8_WAIT_L(0); PG8_MMA(0, 0, At, B0); PG8_BAR; PG8_SCHED;
            PG8_LDB(B1, 0, 1); PG8_STAGE(PG8_SB(0, 0), b2, voffB);
            PG8_BAR; PG8_WAIT_L(0); PG8_MMA(0, 1, At, B1); PG8_BAR;
            PG8_LDA(At, 0, 1); PG8_STAGE(PG8_SA(0, 0), a2, voffA);
            PG8_BAR; PG8_WAIT_L(0); PG8_MMA(1, 0, At, B0); PG8_BAR; PG8_SCHED;
            PG8_STAGE(PG8_SB(0, 1), b2 + hstep, voffB);
            PG8_WAIT_V(6); PG8_BAR; PG8_MMA(1, 1, At, B1); PG8_BAR;
            PG8_LDB(B0, 1, 0); PG8_SCHED; PG8_LDA(At, 1, 0); PG8_STAGE(PG8_SA(0, 1), a2 + hstep, voffA);
            PG8_WAIT_L(8); PG8_BAR; PG8_WAIT_L(0); PG8_MMA(0, 0, At, B0); PG8_BAR; PG8_SCHED;
            PG8_LDB(B1, 1, 1); PG8_STAGE(PG8_SB(1, 0), b3, voffB);
            PG8_BAR; PG8_WAIT_L(0); PG8_MMA(0, 1, At, B1); PG8_BAR;
            PG8_LDA(At, 1, 1); PG8_STAGE(PG8_SA(1, 0), a3, voffA);
            PG8_BAR; PG8_WAIT_L(0); PG8_MMA(1, 0, At, B0); PG8_BAR; PG8_SCHED;
            PG8_STAGE(PG8_SB(1, 1), b3 + hstep, voffB);
            PG8_WAIT_V(6); PG8_BAR; PG8_MMA(1, 1, At, B1); PG8_BAR;
            }
        }
        if constexpr (F8 != 0) { asm volatile("s_nop 15\n\ts_nop 15\n\ts_nop 15" ::: "memory"); }
        if constexpr (ALIGN_EPI) { if (wr == 0) PG8_BAR; }
        bool keep_acc = false;
        if constexpr (!Epi::AFTER_DRAIN) { if constexpr (Epi::HAS_MID) { if (cur.kq == 0) { E.mid(acc, cur, wr, wc, fr, fq); keep_acc = true; } else E(acc, cur, wr, wc, fr, fq); } else E(acc, cur, wr, wc, fr, fq); S.done(cur); }
        if (!has_next) break;
        if (!keep_acc)
#pragma unroll
        for (int a = 0; a < 2; ++a)
#pragma unroll
            for (int b = 0; b < 2; ++b)
#pragma unroll
                for (int m = 0; m < 4; ++m)
#pragma unroll
                    for (int n = 0; n < 2; ++n) acc[a][b][m][n] = (f32x4){0.f, 0.f, 0.f, 0.f};
        cur = nxt; cA = nA; cB = nB; ++ui;
        if constexpr (GATHER) { _Pragma("unroll") for (int _h = 0; _h < 2; ++_h) _Pragma("unroll") for (int _i = 0; _i < 2; ++_i) gv[_h][_i] = gn[_h][_i]; }
        if constexpr (ALIGN_EPI) { if (wr == 1) PG8_BAR; }
    }
    PG8_WAIT_V(0);
    if constexpr (!ALIGN_EPI) { if (wr == 0) PG8_BAR; }
    PG8_BAR;
    if constexpr (Epi::AFTER_DRAIN) { E.fused(acc, cur, wr, wc, fr, fq, lds, wid, lane); S.done(cur); }
#undef PG8_SA
#undef PG8_SB
#undef PG8_STAGE
#undef PG8_STAGE_A
#undef PG8_GOFF
#undef PG8_LDA
#undef PG8_LDB
#undef PG8_MMA
#undef PG8_CAT
#undef PG8_WAIT_V
#undef PG8_WAIT_L
#undef PG8_BAR
#undef PG8_SCHED
}
}

constexpr int NWAVES = 8, NTHR = 512;
constexpr int NTOK = 8192, SEQ = 4096, DM = 2048;
constexpr int INW = 8992, INP = 9216;
constexpr int C_Q = 0, C_K = 1024, C_V = 1280, C_Z = 1536, C_ZV = 4896, C_GATE = 5120;
constexpr float IN_WCLIP = 4.f * 0.0220970869f  , IN_WS = 127.f / IN_WCLIP;
constexpr size_t WIN8_OFF = (size_t)C_GATE * 2048 * 2;
constexpr int GATE_SHIFT = C_GATE - 4896;
constexpr int ZW = 3360;
constexpr int NEXP = 32, EH = 512, MAXSLOT = 16384 + 32 * 256, MAXPANEL = MAXSLOT / 256;
constexpr float NORM_EPS = 1e-5f, GN_EPS = 64e-5f;
constexpr float LOG2E = 1.4426950408889634f;

constexpr size_t MiB = 1u << 20;
constexpr size_t WS_CTL = 0, CTL_ZERO_BYTES = 1 * MiB;
constexpr size_t WS_WIN_T = 2 * MiB;
constexpr size_t WS_WA_T = 38 * MiB;
constexpr size_t WS_WB_T = 42 * MiB;
constexpr size_t WS_WOUT_T = 46 * MiB;
constexpr size_t WS_LORA = 54 * MiB;
constexpr size_t WS_WGU_T = 56 * MiB;
constexpr size_t WS_WD_T = 184 * MiB;
constexpr size_t WS_X = 248 * MiB;
constexpr size_t WS_H = 312 * MiB;
constexpr size_t WS_PROJ = 344 * MiB;
constexpr size_t WS_ATTN = 488 * MiB;
constexpr size_t WS_SCAN = 504 * MiB;
constexpr size_t WS_G = 696 * MiB;
constexpr size_t WS_VFIRST = 728 * MiB;
constexpr size_t WS_Y = 760 * MiB;
constexpr size_t WS_YB = 792 * MiB;
constexpr size_t WS_TMP = 808 * MiB;
constexpr size_t WS_MERGED = 872 * MiB;
constexpr size_t WS_ROUTE = 904 * MiB;
constexpr size_t WS_END = 905 * MiB;
constexpr size_t WS_XG = WS_PROJ;
constexpr size_t WS_SLOT_TOK = WS_Y, WS_SLOT_W = WS_Y + 2 * MiB, WS_H8 = WS_ATTN  , WS_ASC = WS_Y + 7 * MiB  , WS_RSTD = WS_Y + 6 * MiB  ;
constexpr int ECAP = 8192;
constexpr size_t WS_HID = WS_PROJ + 96 * MiB;
constexpr size_t WS_MOEOUT = WS_SCAN;
constexpr size_t WS_GATE8 = WS_SCAN + 96 * MiB;
constexpr size_t WS_AY = WS_SCAN + 64 * MiB;
static_assert(WS_HID + (size_t)MAXSLOT * EH * 2 <= WS_ATTN, "hid overlay");
constexpr size_t SCAN_STRIDE = (size_t)NTOK * 1024;
constexpr size_t LO_WUP = 0, LO_AUP = 65536, LO_GUP = 131072, LO_VUP = 131072 + 163840, LO_RH = 327680 + 0, LO_RL = LO_RH + 48 * 2048;
static_assert((LO_RL + 48 * 2048) * 2 <= 2 * MiB, "lora region");
constexpr size_t RT_E = 0, RT_POS = 65536, RT_W = 131072, RT_SLOT_TOK = 196608, RT_SLOT_W = 196608 + 98304;

constexpr int CW_BAR = 4096;
constexpr int CW_CNT = 8192;

constexpr int RING_BYTES = 131072;
constexpr int LDSCTL_OFF = RING_BYTES;
constexpr int LDS_PANEL = LDSCTL_OFF + 64, LDS_TAB = LDSCTL_OFF + 1024, LDS_PSB = LDSCTL_OFF + 1536, LDS_PTRS = LDSCTL_OFF + 2048;
constexpr int LDS_BYTES = 147456;

#define GAS __attribute__((address_space(1)))
#define LAS __attribute__((address_space(3)))
typedef unsigned short bf16;
typedef unsigned v4u __attribute__((ext_vector_type(4)));
typedef unsigned v2u __attribute__((ext_vector_type(2)));
typedef float f32x4 __attribute__((ext_vector_type(4)));
typedef float f32x2 __attribute__((ext_vector_type(2)));
typedef float f32x16 __attribute__((ext_vector_type(16)));
typedef short bf16x8 __attribute__((ext_vector_type(8)));
typedef short s16x4 __attribute__((ext_vector_type(4)));
#define LDS_WAIT() asm volatile("s_waitcnt lgkmcnt(0)" ::: "memory")
#define VM_WAIT() asm volatile("s_waitcnt vmcnt(0)" ::: "memory")
__device__ __forceinline__ unsigned f2bf(float f) { unsigned u = __builtin_bit_cast(unsigned, f); return (u + 0x7fffu + ((u >> 16) & 1u)) >> 16; }
__device__ __forceinline__ unsigned pk2(float lo, float hi) { return f2bf(lo) | (f2bf(hi) << 16); }
__device__ __forceinline__ float bflo(unsigned u) { return __builtin_bit_cast(float, u << 16); }
__device__ __forceinline__ float bfhi(unsigned u) { return __builtin_bit_cast(float, u & 0xffff0000u); }
__device__ __forceinline__ float rcpf_(float x) { return __builtin_amdgcn_rcpf(x); }
__device__ __forceinline__ float sigmoidf_(float x) { return __builtin_amdgcn_rcpf(1.f + __expf(-x)); }

#define XB_TMO      128
#define XB_XCNT(j)  (256  + 64 * (j))
#define XB_XSUB(j)  (1280 + 64 * (j))
#define XB_XGEN(j)  (2304 + 64 * (j))
#define XB_TOP      3328
#define XB_TOPGEN   3392
#define XCD_BAR_WORDS 3456
#define XB_SPIN_CAP (1u << 18)

__device__ __forceinline__ unsigned xb_ld(unsigned* p)              { return __hip_atomic_load(p, __ATOMIC_RELAXED, __HIP_MEMORY_SCOPE_AGENT); }
__device__ __forceinline__ unsigned xb_add(unsigned* p, unsigned v) { return __hip_atomic_fetch_add(p, v, __ATOMIC_RELAXED, __HIP_MEMORY_SCOPE_AGENT); }
__device__ __forceinline__ unsigned xb_xcc_id() { return (unsigned)__builtin_amdgcn_s_getreg((3 << 11) | 20) & 0xFu; }
#define XB_SPIN(cond, bar) do { unsigned _sp = 0; while (cond) { __builtin_amdgcn_s_sleep(1); \
    if ((++_sp & 255u) == 0u) { if (xb_ld(&(bar)[XB_TMO])) break; if (_sp > XB_SPIN_CAP) { atomicAdd(&(bar)[XB_TMO], 1u); break; } } } } while (0)

struct XcdBarrier {
    unsigned* bar; unsigned x;
    volatile LAS unsigned* st;
};
__device__ __forceinline__ XcdBarrier xcd_barrier_post(unsigned* bar, volatile LAS unsigned* st) {
    XcdBarrier b; b.bar = bar; b.x = xb_xcc_id(); b.st = st;
    if (threadIdx.x == 0) (void)xb_add(&bar[XB_XCNT(b.x)], 1u);
    return b;
}
__device__ __forceinline__ void xcd_barrier_complete(unsigned* bar, unsigned x, unsigned& nloc, unsigned& nx) {
    const unsigned G = gridDim.x * gridDim.y * gridDim.z;
    unsigned sum, cnt, mine, sp = 0u;
    for (;;) {
        sum = 0u; cnt = 0u; mine = 0u;
#pragma unroll
        for (unsigned j = 0; j < 16; ++j) { const unsigned c = xb_ld(&bar[XB_XCNT(j)]); sum += c; cnt += (c > 0u) ? 1u : 0u; mine = (j == x) ? c : mine; }
        if (sum == G) break;
        __builtin_amdgcn_s_sleep(1);
        if ((++sp & 255u) == 0u) { if (xb_ld(&bar[XB_TMO])) break; if (sp > XB_SPIN_CAP) { atomicAdd(&bar[XB_TMO], 1u); break; } }
    }
    nloc = mine > 0u ? mine : 1u; nx = cnt > 0u ? cnt : 1u;
}
__device__ __forceinline__ void xcd_barrier(const XcdBarrier& b) {
    asm volatile("s_waitcnt vmcnt(0)" ::: "memory");
    __syncthreads();
    if (threadIdx.x == 0) {
        unsigned* bar = b.bar;
        __builtin_amdgcn_s_waitcnt(0);
        unsigned nloc = b.st[0], nx = b.st[1];
        if (nloc == 0u) { xcd_barrier_complete(bar, b.x, nloc, nx); b.st[0] = nloc; b.st[1] = nx; }
        const unsigned old = xb_add(&bar[XB_XSUB(b.x)], 1u);
        const unsigned gen = old / nloc;
        if (old + 1u == (gen + 1u) * nloc) {
            __builtin_amdgcn_fence(__ATOMIC_RELEASE, "agent");
            asm volatile("s_waitcnt vmcnt(0)" ::: "memory");
            const unsigned og = xb_add(&bar[XB_TOP], 1u);
            const unsigned tg = og / nx;
            if (og + 1u == (tg + 1u) * nx) xb_add(&bar[XB_TOPGEN], 1u);
            else XB_SPIN(xb_ld(&bar[XB_TOPGEN]) == tg, bar);
            __builtin_amdgcn_fence(__ATOMIC_ACQUIRE, "agent");
            xb_add(&bar[XB_XGEN(b.x)], 1u);
            asm volatile("s_waitcnt vmcnt(0)" ::: "memory");
        } else {
            XB_SPIN(xb_ld(&bar[XB_XGEN(b.x)]) == gen, bar);
            __builtin_amdgcn_fence(__ATOMIC_ACQUIRE, "agent");
            asm volatile("s_waitcnt vmcnt(0)" ::: "memory");
        }
    }
    __syncthreads();
}

struct Frame {
    LAS unsigned char* lds;
    unsigned* ctl;
    unsigned char* ws;
    const float* const* in;
    int tid, lane, wave, vcu, G;
};
__device__ __forceinline__ float wave_max(float v) {
#pragma unroll
    for (int o = 1; o < 64; o <<= 1) v = fmaxf(v, __shfl_xor(v, o));
    return v;
}
__device__ __forceinline__ unsigned pack_i8x4(float a, float b, float c, float d) {
    const int ia = (int)fminf(fmaxf(rintf(a), -127.f), 127.f), ib = (int)fminf(fmaxf(rintf(b), -127.f), 127.f), ic = (int)fminf(fmaxf(rintf(c), -127.f), 127.f), id = (int)fminf(fmaxf(rintf(d), -127.f), 127.f);
    return ((unsigned)ia & 255u) | (((unsigned)ib & 255u) << 8) | (((unsigned)ic & 255u) << 16) | ((unsigned)id << 24);
}
__device__ __forceinline__ float wave_sum(float v) {
#pragma unroll
    for (int o = 1; o < 64; o <<= 1) v += __shfl_xor(v, o);
    return v;
}
#ifndef F8_GATE
#define F8_GATE 0
#endif
#ifndef F8_MRG
#define F8_MRG 0
#endif
#ifndef F8_OUT
#define F8_OUT 1
#endif
#ifndef F8_MOE
#define F8_MOE 1
#endif
#ifndef F8_IN
#define F8_IN 2
#endif

constexpr int TS = 68;
__device__ __forceinline__ void transpose_item(const float* W, int K, int N, bf16* WT, int ldk, int row_off, int mode, LAS bf16* scr, int item, int lane, const float* ksc = nullptr, float f8 = 0.f) {
    const int nblk = (N + 63) / 64, kb = item / nblk, nb = item - kb * nblk, k0 = 64 * kb, n0 = 64 * nb;
    const int lr = lane >> 4, lc = 4 * (lane & 15);
    const bool cv = (n0 + lc) < N;
    f32x4 v[16];
#pragma unroll
    for (int i = 0; i < 16; ++i) { v[i] = (f32x4){0.f, 0.f, 0.f, 0.f}; if (cv) v[i] = __builtin_nontemporal_load((const GAS f32x4*)(W + (size_t)(k0 + 4 * i + lr) * N + n0 + lc)); }
    if (ksc) {
#pragma unroll
        for (int i = 0; i < 16; ++i) v[i] = v[i] * ksc[k0 + 4 * i + lr]; }
    if (f8 != 0.f) { const float f8a = fabsf(f8);
#pragma unroll
        for (int i = 0; i < 16; ++i) v[i] = v[i] * f8a; }
    const bool g8 = F8_GATE && (mode == 3);
    if (g8 && (n0 + lc) >= 4896) {
#pragma unroll
        for (int i = 0; i < 16; ++i) v[i] = v[i] * 64.f; }
#pragma unroll
    for (int i = 0; i < 16; ++i) { v2u o; o.x = pk2(v[i].x, v[i].y); o.y = pk2(v[i].z, v[i].w); *(LAS v2u*)(scr + (4 * i + lr) * TS + lc) = o; }
    LDS_WAIT(); asm volatile("" ::: "memory");
    const int c = lane & 7;
#pragma unroll
    for (int j = 0; j < 8; ++j) { const int n = (lane >> 3) + 8 * j; const LAS bf16* s = scr + (8 * c) * TS + n;
        v4u o; o.x = (unsigned)s[0 * TS] | ((unsigned)s[1 * TS] << 16); o.y = (unsigned)s[2 * TS] | ((unsigned)s[3 * TS] << 16); o.z = (unsigned)s[4 * TS] | ((unsigned)s[5 * TS] << 16); o.w = (unsigned)s[6 * TS] | ((unsigned)s[7 * TS] << 16);
        const int nn = n0 + n; const int orow = (mode == 0) ? (row_off + nn) : (mode == 3) ? (nn + ((nn >= 4896) ? GATE_SHIFT : 0)) : (((nn >> 2) << 3) + (nn & 3) + ((mode == 2) ? 4 : 0));
        if (f8 < 0.f) { v2u o8; o8.x = pack_i8x4(bflo(o.x), bfhi(o.x), bflo(o.y), bfhi(o.y)); o8.y = pack_i8x4(bflo(o.z), bfhi(o.z), bflo(o.w), bfhi(o.w));
            if (nn < N) *(GAS v2u*)((GAS unsigned char*)WT + (size_t)orow * ldk + k0 + 8 * c) = o8; }
        else if (f8 != 0.f || (g8 && nn >= 4896)) { int lo8 = 0, hi8 = 0; unsigned char* W8 = (unsigned char*)WT; size_t r8 = (size_t)orow;
            if (g8) { W8 += WIN8_OFF; r8 = (size_t)(nn - 4896); }
            lo8 = __builtin_amdgcn_cvt_pk_fp8_f32(bflo(o.x), bfhi(o.x), lo8, false); lo8 = __builtin_amdgcn_cvt_pk_fp8_f32(bflo(o.y), bfhi(o.y), lo8, true);
            hi8 = __builtin_amdgcn_cvt_pk_fp8_f32(bflo(o.z), bfhi(o.z), hi8, false); hi8 = __builtin_amdgcn_cvt_pk_fp8_f32(bflo(o.w), bfhi(o.w), hi8, true);
            v2u o8; o8.x = (unsigned)lo8; o8.y = (unsigned)hi8;
            if (nn < N) *(GAS v2u*)((GAS unsigned char*)W8 + r8 * ldk + k0 + 8 * c) = o8; }
        else if (nn < N) __builtin_nontemporal_store(o, (GAS v4u*)(WT + (size_t)orow * ldk + k0 + 8 * c)); }
    LDS_WAIT(); asm volatile("" ::: "memory");
}

struct In {
    const float *x, *attn_norm_w, *w_in, *shift_mix, *sinks, *w0, *w_up, *a0, *a_up, *g_up, *k_k, *k_a, *r_k, *ln_w, *ln_b,
                *vres_down, *vres_mix, *vres_up, *vres_v0, *w_a, *w_b, *w_out, *ffn_norm_w, *rg_w, *rg_b, *re_w, *re_b, *e_gate, *e_up, *e_down, *final_w;
};

__device__ __forceinline__ const float* ldptr(const Frame& F, int k) {
    const LAS unsigned* p = (const LAS unsigned*)(F.lds + LDS_PTRS) + 2 * k;
    const unsigned lo = __builtin_amdgcn_readfirstlane(p[0]), hi = __builtin_amdgcn_readfirstlane(p[1]);
    return (const float*)(((unsigned long long)hi << 32) | lo); }
__device__ __forceinline__ In load_in(const Frame& F) {
    In I;
    I.x = ldptr(F, 0); I.attn_norm_w = ldptr(F, 1); I.w_in = ldptr(F, 2); I.shift_mix = ldptr(F, 3); I.sinks = ldptr(F, 4); I.w0 = ldptr(F, 5); I.w_up = ldptr(F, 6); I.a0 = ldptr(F, 7);
    I.a_up = ldptr(F, 8); I.g_up = ldptr(F, 9); I.k_k = ldptr(F, 10); I.k_a = ldptr(F, 11); I.r_k = ldptr(F, 12); I.ln_w = ldptr(F, 13); I.ln_b = ldptr(F, 14); I.vres_down = ldptr(F, 15);
    I.vres_mix = ldptr(F, 16); I.vres_up = ldptr(F, 17); I.vres_v0 = ldptr(F, 18); I.w_a = ldptr(F, 19); I.w_b = ldptr(F, 20); I.w_out = ldptr(F, 21); I.ffn_norm_w = ldptr(F, 22);
    I.rg_w = ldptr(F, 23); I.rg_b = ldptr(F, 24); I.re_w = ldptr(F, 25); I.re_b = ldptr(F, 26); I.e_gate = ldptr(F, 27); I.e_up = ldptr(F, 28); I.e_down = ldptr(F, 29); I.final_w = ldptr(F, 30);
    return I; }
constexpr int CV_IN = 32 * 141, CV_VD = 32, CV_BR = 16 * 32, CV_OUT = 32 * 32, CV_EX = 256, CV_MOE = 3 * NEXP * CV_EX;
__device__ __forceinline__ int conv_dense_items(int l) { return CV_IN + ((l == 1) ? CV_VD : 0) + 2 * CV_BR + CV_OUT; }
__device__ __forceinline__ void conv_items(const Frame& F, const In& I, int l, int lo, int hi, int rank, int nwg) {
    LAS bf16* scr = (LAS bf16*)(F.lds + F.wave * 16384);
    bf16* win_t = (bf16*)(F.ws + WS_WIN_T);
    const int n_vd = (l == 1) ? CV_VD : 0;
    for (int it = lo + rank * NWAVES + F.wave; it < hi; it += nwg * NWAVES) {
        int r = it; const float* src; bf16* dst; const float* ksc = nullptr; float f8 = 0.f; int K, N, roff = 0, mode = 0, ldk = 0;
        if (r < CV_IN) { src = I.w_in + (size_t)l * DM * INW; K = DM; N = INW; dst = win_t; mode = 3; f8 = (F8_IN == 2) ? -IN_WS : F8_IN ? 64.f : 0.f; }
        else if ((r -= CV_IN) < n_vd) { src = I.vres_down; K = DM; N = 32; dst = win_t; roff = C_ZV; f8 = (F8_IN == 2) ? -IN_WS : F8_IN ? 64.f : 0.f; }
        else if ((r -= n_vd) < CV_BR) { src = I.w_a + (size_t)l * 1024 * DM; K = 1024; N = DM; dst = (bf16*)(F.ws + WS_WA_T); ldk = 2048; f8 = F8_MRG ? 64.f : 0.f; }
        else if ((r -= CV_BR) < CV_BR) { src = I.w_b + (size_t)l * 1024 * DM; K = 1024; N = DM; dst = (bf16*)(F.ws + WS_WA_T + 1024 * (F8_MRG ? 1 : 2)); ldk = 2048; f8 = F8_MRG ? 64.f : 0.f; }
        else if ((r -= CV_BR) < CV_OUT) { src = I.w_out + (size_t)l * DM * DM; K = DM; N = DM; dst = (bf16*)(F.ws + WS_WOUT_T); f8 = F8_OUT ? 64.f : 0.f; }
        else { r -= CV_OUT; const int kind = r / (NEXP * CV_EX); r -= kind * (NEXP * CV_EX); const int e = r / CV_EX; r -= e * CV_EX;
            constexpr size_t EB = F8_MOE ? 1 : 2;
            if (kind == 0)      { src = I.e_gate + ((size_t)l * NEXP + e) * DM * EH; K = DM; N = EH; dst = (bf16*)(F.ws + WS_WGU_T + (size_t)e * 1024 * DM * EB); mode = 1; ksc = I.ffn_norm_w + l * DM; f8 = F8_MOE ? 64.f : 0.f; }
            else if (kind == 1) { src = I.e_up   + ((size_t)l * NEXP + e) * DM * EH; K = DM; N = EH; dst = (bf16*)(F.ws + WS_WGU_T + (size_t)e * 1024 * DM * EB); mode = 2; ksc = I.ffn_norm_w + l * DM; f8 = F8_MOE ? 64.f : 0.f; }
            else                { src = I.e_down + ((size_t)l * NEXP + e) * EH * DM; K = EH; N = DM; dst = (bf16*)(F.ws + WS_WD_T + (size_t)e * DM * EH * EB); f8 = F8_MOE ? 32.f : 0.f; } }
        transpose_item(src, K, N, dst, ldk ? ldk : K, roff, mode, scr, r, F.lane, ksc, f8);
    }
}
__device__ __forceinline__ void conv_small(const Frame& F, const In& I, int l) {
    const int gw = F.vcu * NWAVES + F.wave, NGW = F.G * NWAVES;
    bf16* win_t = (bf16*)(F.ws + WS_WIN_T);
    { const int r0 = C_ZV + ((l == 1) ? 32 : 0); const size_t n16 = (size_t)(C_GATE - r0) * DM * (F8_IN ? 1 : 2) / 16; GAS v4u* z = (GAS v4u*)((GAS unsigned char*)win_t + (size_t)r0 * DM * (F8_IN ? 1 : 2));
      for (size_t i = (size_t)gw * 64 + F.lane; i < n16; i += (size_t)NGW * 64) z[i] = (v4u){0u, 0u, 0u, 0u}; }
    bf16* lo = (bf16*)(F.ws + WS_LORA);
    const int gt = gw * 64 + F.lane, NGT = NGW * 64;
    for (int i = gt; i < 1024 * 64; i += NGT) { const int n = i >> 6, k = i & 63;
        lo[LO_WUP + i] = (bf16)f2bf(I.w_up[(size_t)l * 65536 + k * 1024 + n]); lo[LO_AUP + i] = (bf16)f2bf(I.a_up[(size_t)l * 65536 + k * 1024 + n]); }
    for (int i = gt; i < 1024 * 160; i += NGT) { const int n = i / 160, k = i % 160; lo[LO_GUP + i] = (bf16)f2bf(I.g_up[(size_t)l * 163840 + k * 1024 + n]); }
    if (l == 1) for (int i = gt; i < 1024 * 32; i += NGT) { const int n = i >> 5, k = i & 31; lo[LO_VUP + i] = (bf16)f2bf(I.vres_up[k * 1024 + n]); }
    for (int i = gt; i < 48 * 2048; i += NGT) { const int n = i >> 11, k = i & 2047;
        const float v = ((n < 32) ? I.re_w[(size_t)l * 65536 + k * 32 + n] : ((n < 36) ? I.rg_w[(size_t)l * 8192 + k * 4 + (n - 32)] : 0.f)) * I.ffn_norm_w[l * DM + k];
        const unsigned h = f2bf(v); lo[LO_RH + i] = (bf16)h; lo[LO_RL + i] = (bf16)f2bf(v - bflo(h)); }
}
#ifndef CV_B1
#define CV_B1 9216
#endif
#ifndef CV_B2
#define CV_B2 16384
#endif
__device__ __forceinline__ int conv_first_items(int l, int G) { return (G == 256) ? CV_IN + ((l == 1) ? CV_VD : 0) : conv_dense_items(l); }
__device__ __forceinline__ void conv_phase(const Frame& F, const In& I, int l, int lo = 0) {
    conv_items(F, I, l, lo, conv_first_items(l, F.G), F.vcu, F.G); conv_small(F, I, l);
}
__device__ __forceinline__ int moe_r2(int np, int G) { const int n_up = np * 4; return (n_up > G) ? ((n_up - G < G / 2) ? n_up - G : G / 2) : 0; }
__device__ __forceinline__ int moe_n_early(int np, int G) {
    const int R2 = moe_r2(np, G), avail = ((np < G / 4) ? np : G / 4) * 8, nd = np * 8, W = G - R2;
    int best = 0, bestc = 1 << 30;
#pragma unroll
    for (int r = 2; r <= 3; ++r) { int ne = r * W; if (ne > avail) ne = avail; const int zr = (nd - ne + G - 1) / G; const int yc = (R2 > 0 && r * 10 < 22) ? 22 : r * 10; const int c = yc + zr * 10; if (c < bestc) { bestc = c; best = ne; } }
    return best; }
__device__ __forceinline__ int cv_z_idle(int np, int G) { const int n_late = np * 8 - moe_n_early(np, G); const int rem = n_late % G; return (n_late > 0 && rem != 0) ? G - rem : 0; }
__device__ __forceinline__ int cv_z_items(int np, int G) { const int idle = cv_z_idle(np, G); const int n = idle * 16; const int d = conv_first_items(1, G); return n < d ? n : d; }

__device__ __forceinline__ void rms_row_bf16(const float* xrow, const float* w, bf16* orow, int lane, unsigned char* orow8 = nullptr, float* asc = nullptr) {
    const GAS f32x4* xr = (const GAS f32x4*)xrow + lane; const GAS f32x4* wr = (const GAS f32x4*)w + lane;
    f32x4 v[8]; float s = 0.f;
#pragma unroll
    for (int j = 0; j < 8; ++j) { v[j] = __builtin_nontemporal_load(xr + 64 * j); s += (v[j].x * v[j].x + v[j].y * v[j].y) + (v[j].z * v[j].z + v[j].w * v[j].w); }
    const float rstd = __builtin_amdgcn_rsqf(wave_sum(s) * (1.f / DM) + NORM_EPS);
    if (F8_GATE) { GAS unsigned* o4 = (GAS unsigned*)orow8 + lane;
#pragma unroll
        for (int j = 0; j < 8; ++j) { const f32x4 ww = wr[64 * j]; int p = 0; p = __builtin_amdgcn_cvt_pk_fp8_f32(v[j].x * rstd * ww.x, v[j].y * rstd * ww.y, p, false); p = __builtin_amdgcn_cvt_pk_fp8_f32(v[j].z * rstd * ww.z, v[j].w * rstd * ww.w, p, true); o4[64 * j] = (unsigned)p; } }
    if (F8_IN == 2) { GAS unsigned* o4 = (GAS unsigned*)orow + lane; float mx = 0.f; f32x4 hv[8];
#pragma unroll
        for (int j = 0; j < 8; ++j) { hv[j] = v[j] * rstd * wr[64 * j]; mx = fmaxf(mx, fmaxf(fmaxf(fabsf(hv[j].x), fabsf(hv[j].y)), fmaxf(fabsf(hv[j].z), fabsf(hv[j].w)))); }
        mx = fmaxf(wave_max(mx), 1e-20f); const float qs = 127.f / mx;
#pragma unroll
        for (int j = 0; j < 8; ++j) o4[64 * j] = pack_i8x4(hv[j].x * qs, hv[j].y * qs, hv[j].z * qs, hv[j].w * qs);
        if (lane == 0) *asc = mx * (1.f / (127.f * IN_WS));
        return; }
    if (F8_IN) { GAS unsigned* o4 = (GAS unsigned*)orow + lane;
#pragma unroll
        for (int j = 0; j < 8; ++j) { const f32x4 ww = wr[64 * j]; int p = 0; p = __builtin_amdgcn_cvt_pk_fp8_f32(v[j].x * rstd * ww.x, v[j].y * rstd * ww.y, p, false); p = __builtin_amdgcn_cvt_pk_fp8_f32(v[j].z * rstd * ww.z, v[j].w * rstd * ww.w, p, true); o4[64 * j] = (unsigned)p; }
        return; }
    GAS v2u* o8 = (GAS v2u*)orow + lane;
#pragma unroll
    for (int j = 0; j < 8; ++j) { const f32x4 ww = wr[64 * j]; v2u o; o.x = pk2(v[j].x * rstd * ww.x, v[j].y * rstd * ww.y); o.y = pk2(v[j].z * rstd * ww.z, v[j].w * rstd * ww.w); o8[64 * j] = o; }
}
#ifndef ROW_LOCAL
#define ROW_LOCAL 0
#endif
__device__ __forceinline__ int row_of(int gw, int r, int NGW) { return (ROW_LOCAL && NGW == 2048) ? 4 * gw + r : gw + r * NGW; }
__device__ __forceinline__ void norm_phase(const Frame& F, const float* x, const float* w, bf16* out) {
    const int gw = F.vcu * NWAVES + F.wave, NGW = F.G * NWAVES;
    for (int r = 0; r * NGW < NTOK; ++r) { const int m = row_of(gw, r, NGW); if (m < NTOK) rms_row_bf16(x + (size_t)m * DM, w, (bf16*)((unsigned char*)out + (size_t)m * DM * (F8_IN ? 1 : 2)), F.lane, F.ws + WS_H8 + (size_t)m * DM, (float*)(F.ws + WS_ASC) + m); }
}

namespace pg8 {
struct EpiStoreBf16 {
    static constexpr bool PERM = true, AFTER_DRAIN = false, HAS_MID = false;
    bf16_t* O; int ldc; unsigned char* G8; int pn0; const float* asc;
    static __device__ __forceinline__ f32x4 cvt_acc(const f32x4 a, float s, bool isint) { if (!isint) return a; const i32x4_ q = __builtin_bit_cast(i32x4_, a); f32x4 r; r[0] = (float)q[0] * s; r[1] = (float)q[1] * s; r[2] = (float)q[2] * s; r[3] = (float)q[3] * s; return r; }
    __device__ __forceinline__ void operator()(const f32x4 (&acc)[2][2][4][2], const Unit& u, int wr, int wc, int fr, int fq) const {
        const int row0 = u.pm * BM + wr * 64 + fr;
        const int tp = u.pn + pn0;
        float rsc[2][4];
#pragma unroll
        for (int ai = 0; ai < 2; ++ai)
#pragma unroll
            for (int m = 0; m < 4; ++m) rsc[ai][m] = asc ? asc[row0 + ai * HALF + m * 16] : 1.f;
        if (tp < C_GATE / BM) {
            const int col0 = tp * BM + wc * 32 + 8 * fq;
#pragma unroll
            for (int ai = 0; ai < 2; ++ai)
#pragma unroll
                for (int m = 0; m < 4; ++m) { bf16_t* rowp = O + (size_t)(row0 + ai * HALF + m * 16) * ldc + col0;
#pragma unroll
                    for (int bj = 0; bj < 2; ++bj) { const f32x4 v0 = cvt_acc(acc[ai][bj][m][0], rsc[ai][m], asc != nullptr), v1 = cvt_acc(acc[ai][bj][m][1], rsc[ai][m], asc != nullptr);
                        u32x4 w; w.x = cvt_pk_bf16(v0[0], v0[1]); w.y = cvt_pk_bf16(v0[2], v0[3]); w.z = cvt_pk_bf16(v1[0], v1[1]); w.w = cvt_pk_bf16(v1[2], v1[3]);
                        *(u32x4*)(rowp + bj * HALF) = w; } }
        } else {
            const int col0 = (tp - C_GATE / BM) * BM + wc * 32 + 8 * fq;
#pragma unroll
            for (int ai = 0; ai < 2; ++ai)
#pragma unroll
                for (int m = 0; m < 4; ++m) { unsigned char* rowp = G8 + (size_t)(row0 + ai * HALF + m * 16) * 4096 + col0;
#pragma unroll
                    for (int bj = 0; bj < 2; ++bj) { const f32x4 v0 = cvt_acc(acc[ai][bj][m][0], rsc[ai][m], asc != nullptr), v1 = cvt_acc(acc[ai][bj][m][1], rsc[ai][m], asc != nullptr);
                        int lo = 0, hi = 0;
                        lo = __builtin_amdgcn_cvt_pk_fp8_f32(v0[0], v0[1], lo, false); lo = __builtin_amdgcn_cvt_pk_fp8_f32(v0[2], v0[3], lo, true);
                        hi = __builtin_amdgcn_cvt_pk_fp8_f32(v1[0], v1[1], hi, false); hi = __builtin_amdgcn_cvt_pk_fp8_f32(v1[2], v1[3], hi, true);
                        u32x2 w; w.x = (unsigned)lo; w.y = (unsigned)hi; *(u32x2*)(rowp + bj * HALF) = w; } }
        }
    }
};
struct EpiGateA {
    static constexpr bool PERM = false, AFTER_DRAIN = false, HAS_MID = false;
    float* T; const bf16_t* Gt; int ldg;
    __device__ __forceinline__ void operator()(const f32x4 (&acc)[2][2][4][2], const Unit& u, int wr, int wc, int fr, int fq) const {
        const int row0 = u.pm * BM + wr * 64 + fr, col0 = u.pn * BM + wc * 32 + 4 * fq;
#pragma unroll
        for (int ai = 0; ai < 2; ++ai)
#pragma unroll
            for (int m = 0; m < 4; ++m) { const int row = row0 + ai * HALF + m * 16;
#pragma unroll
                for (int bj = 0; bj < 2; ++bj)
#pragma unroll
                    for (int n = 0; n < 2; ++n) { const int col = col0 + bj * HALF + n * 16;
                        const u32x2 g = *(const u32x2*)(Gt + (size_t)row * ldg + col); const f32x4 a = acc[ai][bj][m][n];
                        f32x4 o; o[0] = a[0] * sigmoidf_(bflo(g.x)); o[1] = a[1] * sigmoidf_(bfhi(g.x)); o[2] = a[2] * sigmoidf_(bflo(g.y)); o[3] = a[3] * sigmoidf_(bfhi(g.y));
                        *(f32x4*)(T + (size_t)row * DM + col) = o; } }
    }
};
struct EpiGateB {
    static constexpr bool PERM = true, AFTER_DRAIN = false, HAS_MID = false;
    const float* T; const bf16_t* Gt; int ldg; bf16_t* O;
    __device__ __forceinline__ void operator()(const f32x4 (&acc)[2][2][4][2], const Unit& u, int wr, int wc, int fr, int fq) const {
        const int row0 = u.pm * BM + wr * 64 + fr, col0 = u.pn * BM + wc * 32 + 8 * fq;
#pragma unroll
        for (int ai = 0; ai < 2; ++ai)
#pragma unroll
            for (int m = 0; m < 4; ++m) { const int row = row0 + ai * HALF + m * 16;
#pragma unroll
                for (int bj = 0; bj < 2; ++bj) { const int col = col0 + bj * HALF;
                    const u32x4 g = *(const u32x4*)(Gt + (size_t)row * ldg + col);
                    const f32x4 t0 = *(const f32x4*)(T + (size_t)row * DM + col), t1 = *(const f32x4*)(T + (size_t)row * DM + col + 4);
                    const f32x4 a0 = acc[ai][bj][m][0], a1 = acc[ai][bj][m][1];
                    u32x4 w;
                    w.x = cvt_pk_bf16(t0[0] + a0[0] * sigmoidf_(bflo(g.x)), t0[1] + a0[1] * sigmoidf_(bfhi(g.x)));
                    w.y = cvt_pk_bf16(t0[2] + a0[2] * sigmoidf_(bflo(g.y)), t0[3] + a0[3] * sigmoidf_(bfhi(g.y)));
                    w.z = cvt_pk_bf16(t1[0] + a1[0] * sigmoidf_(bflo(g.z)), t1[1] + a1[1] * sigmoidf_(bfhi(g.z)));
                    w.w = cvt_pk_bf16(t1[2] + a1[2] * sigmoidf_(bflo(g.w)), t1[3] + a1[3] * sigmoidf_(bfhi(g.w)));
                    *(u32x4*)(O + (size_t)row * DM + col) = w; } }
    }
};
struct MergeOrder {
    StaticOrder base;
    __device__ __forceinline__ bool next(int i, Unit& u) const { if (!base.next(i >> 1, u)) return false; u.kq = (i & 1) * (F8_MRG ? 512 : 1024); return true; }
    __device__ __forceinline__ void a_ready(const Unit&) const {}
    __device__ __forceinline__ void done(const Unit&) const {}
};
struct EpiMerge {
    static constexpr bool PERM = true, AFTER_DRAIN = false, HAS_MID = true;
    const unsigned char* Ga; const unsigned char* Gb; int ldg; bf16_t* O;
    static __device__ __forceinline__ float f8(unsigned w, int i) { return (i == 0) ? __builtin_amdgcn_cvt_f32_fp8((int)w, 0) : (i == 1) ? __builtin_amdgcn_cvt_f32_fp8((int)w, 1) : (i == 2) ? __builtin_amdgcn_cvt_f32_fp8((int)w, 2) : __builtin_amdgcn_cvt_f32_fp8((int)w, 3); }
    __device__ __forceinline__ void mid(f32x4 (&acc)[2][2][4][2], const Unit& u, int wr, int wc, int fr, int fq) const {
        const int row0 = u.pm * BM + wr * 64 + fr, col0 = u.pn * BM + wc * 32 + 8 * fq;
#pragma unroll
        for (int ai = 0; ai < 2; ++ai)
#pragma unroll
            for (int m = 0; m < 4; ++m) { const size_t ro = (size_t)(row0 + ai * HALF + m * 16) * ldg + col0;
#pragma unroll
                for (int bj = 0; bj < 2; ++bj) { const u32x2 a = *(const u32x2*)(Ga + ro + bj * HALF), b = *(const u32x2*)(Gb + ro + bj * HALF);
#pragma unroll
                    for (int e = 0; e < 8; ++e) { const float ga = f8((e < 4) ? a.x : a.y, e & 3), gb = f8((e < 4) ? b.x : b.y, e & 3);
                        acc[ai][bj][m][e >> 2][e & 3] *= (1.f + __expf(-gb)) * __builtin_amdgcn_rcpf(1.f + __expf(-ga)); } } }
    }
    __device__ __forceinline__ void operator()(const f32x4 (&acc)[2][2][4][2], const Unit& u, int wr, int wc, int fr, int fq) const {
        const int row0 = u.pm * BM + wr * 64 + fr, col0 = u.pn * BM + wc * 32 + 8 * fq;
#pragma unroll
        for (int ai = 0; ai < 2; ++ai)
#pragma unroll
            for (int m = 0; m < 4; ++m) { const int row = row0 + ai * HALF + m * 16;
#pragma unroll
                for (int bj = 0; bj < 2; ++bj) { const int col = col0 + bj * HALF;
                    const u32x2 g = *(const u32x2*)(Gb + (size_t)row * ldg + col);
                    const f32x4 a0 = acc[ai][bj][m][0], a1 = acc[ai][bj][m][1];
                    u32x4 w;
                    w.x = cvt_pk_bf16(a0[0] * sigmoidf_(f8(g.x, 0)), a0[1] * sigmoidf_(f8(g.x, 1)));
                    w.y = cvt_pk_bf16(a0[2] * sigmoidf_(f8(g.x, 2)), a0[3] * sigmoidf_(f8(g.x, 3)));
                    w.z = cvt_pk_bf16(a1[0] * sigmoidf_(f8(g.y, 0)), a1[1] * sigmoidf_(f8(g.y, 1)));
                    w.w = cvt_pk_bf16(a1[2] * sigmoidf_(f8(g.y, 2)), a1[3] * sigmoidf_(f8(g.y, 3)));
                    if (F8_OUT) { int lo8 = 0, hi8 = 0;
                        lo8 = __builtin_amdgcn_cvt_pk_fp8_f32(16.f * bflo(w.x), 16.f * bfhi(w.x), lo8, false); lo8 = __builtin_amdgcn_cvt_pk_fp8_f32(16.f * bflo(w.y), 16.f * bfhi(w.y), lo8, true);
                        hi8 = __builtin_amdgcn_cvt_pk_fp8_f32(16.f * bflo(w.z), 16.f * bfhi(w.z), hi8, false); hi8 = __builtin_amdgcn_cvt_pk_fp8_f32(16.f * bflo(w.w), 16.f * bfhi(w.w), hi8, true);
                        u32x2 w8; w8.x = (unsigned)lo8; w8.y = (unsigned)hi8; *(u32x2*)((unsigned char*)O + (size_t)row * DM + col) = w8; }
                    else *(u32x4*)(O + (size_t)row * DM + col) = w; } }
    }
};
template <bool IN_F32> struct EpiResid {
    static constexpr bool PERM = true, AFTER_DRAIN = false, HAS_MID = false;
    const float* XiF; const bf16_t* XiB; bf16_t* Xo; unsigned char* X8;
    __device__ __forceinline__ void operator()(const f32x4 (&acc)[2][2][4][2], const Unit& u, int wr, int wc, int fr, int fq) const {
        const int row0 = u.pm * BM + wr * 64 + fr, col0 = u.pn * BM + wc * 32 + 8 * fq;
#pragma unroll
        for (int ai = 0; ai < 2; ++ai)
#pragma unroll
            for (int m = 0; m < 4; ++m) { const size_t ro = (size_t)(row0 + ai * HALF + m * 16) * DM + col0;
#pragma unroll
                for (int bj = 0; bj < 2; ++bj) { const size_t o = ro + bj * HALF; f32x4 x0, x1;
                    if constexpr (IN_F32) { x0 = *(const f32x4*)(XiF + o); x1 = *(const f32x4*)(XiF + o + 4); }
                    else { const u32x4 xb = *(const u32x4*)(XiB + o); x0[0] = bflo(xb.x); x0[1] = bfhi(xb.x); x0[2] = bflo(xb.y); x0[3] = bfhi(xb.y); x1[0] = bflo(xb.z); x1[1] = bfhi(xb.z); x1[2] = bflo(xb.w); x1[3] = bfhi(xb.w); }
                    x0 += acc[ai][bj][m][0]; x1 += acc[ai][bj][m][1];
                    u32x4 w; w.x = cvt_pk_bf16(x0[0], x0[1]); w.y = cvt_pk_bf16(x0[2], x0[3]); w.z = cvt_pk_bf16(x1[0], x1[1]); w.w = cvt_pk_bf16(x1[2], x1[3]);
                    *(u32x4*)(Xo + o) = w;
                    if (F8_MOE) { int lo8 = 0, hi8 = 0; lo8 = __builtin_amdgcn_cvt_pk_fp8_f32(x0[0], x0[1], lo8, false); lo8 = __builtin_amdgcn_cvt_pk_fp8_f32(x0[2], x0[3], lo8, true);
                        hi8 = __builtin_amdgcn_cvt_pk_fp8_f32(x1[0], x1[1], hi8, false); hi8 = __builtin_amdgcn_cvt_pk_fp8_f32(x1[2], x1[3], hi8, true);
                        u32x2 w8; w8.x = (unsigned)lo8; w8.y = (unsigned)hi8; *(u32x2*)(X8 + o) = w8; } } }
    }
};
struct MoeOrder {
    int first, stride, limit, nN; const PG8_LAS int* panel_e; const PG8_LAS int* panel_sb;
    __device__ __forceinline__ bool next(int i, Unit& u) const {
        const int L = first + i * stride; if (L >= limit) return false;
        const int p = L / nN, t = L - p * nN; u.pm = p; u.pn = __builtin_amdgcn_readfirstlane(panel_e[p]) * nN + t; u.kq = 0; u.sb = __builtin_amdgcn_readfirstlane(panel_sb[p]); return true; }
    __device__ __forceinline__ void a_ready(const Unit&) const {}
    __device__ __forceinline__ void done(const Unit&) const {}
};
struct EpiSwiGlu {
    static constexpr bool PERM = true, AFTER_DRAIN = false, HAS_MID = false;
    bf16_t* Hd; const int* slot_tok; const float* rstd;
    __device__ __forceinline__ void operator()(const f32x4 (&acc)[2][2][4][2], const Unit& u, int wr, int wc, int fr, int fq) const {
        const int row0 = u.pm * BM + wr * 64 + fr, t = u.pn & 3, j0 = t * 128 + wc * 16 + 4 * fq, s0 = u.sb + wr * 64 + fr;
        int tk[2][4]; float rs[2][4];
#pragma unroll
        for (int ai = 0; ai < 2; ++ai)
#pragma unroll
            for (int m = 0; m < 4; ++m) tk[ai][m] = slot_tok[s0 + ai * HALF + m * 16];
#pragma unroll
        for (int ai = 0; ai < 2; ++ai)
#pragma unroll
            for (int m = 0; m < 4; ++m) rs[ai][m] = (tk[ai][m] >= 0) ? rstd[tk[ai][m] >> 1] : 0.f;
#pragma unroll
        for (int ai = 0; ai < 2; ++ai)
#pragma unroll
            for (int m = 0; m < 4; ++m) { bf16_t* rowp = Hd + (size_t)(row0 + ai * HALF + m * 16) * EH + j0;
#pragma unroll
                for (int bj = 0; bj < 2; ++bj) { const f32x4 g = acc[ai][bj][m][0] * rs[ai][m], up = acc[ai][bj][m][1] * rs[ai][m];
                    if (F8_MOE) { int p8 = 0; p8 = __builtin_amdgcn_cvt_pk_fp8_f32(8.f * g[0] * sigmoidf_(g[0]) * up[0], 8.f * g[1] * sigmoidf_(g[1]) * up[1], p8, false);
                        p8 = __builtin_amdgcn_cvt_pk_fp8_f32(8.f * g[2] * sigmoidf_(g[2]) * up[2], 8.f * g[3] * sigmoidf_(g[3]) * up[3], p8, true);
                        *(unsigned*)((unsigned char*)Hd + (size_t)(row0 + ai * HALF + m * 16) * EH + j0 + bj * 64) = (unsigned)p8; }
                    else { u32x2 w; w.x = cvt_pk_bf16(g[0] * sigmoidf_(g[0]) * up[0], g[1] * sigmoidf_(g[1]) * up[1]); w.y = cvt_pk_bf16(g[2] * sigmoidf_(g[2]) * up[2], g[3] * sigmoidf_(g[3]) * up[3]);
                    *(u32x2*)(rowp + bj * 64) = w; } } }
    }
};
struct EpiMoeDown {
    static constexpr bool PERM = true, AFTER_DRAIN = false, HAS_MID = false;
    bf16_t* Out; const int* slot_tok; const float* slot_w;
    __device__ __forceinline__ void operator()(const f32x4 (&acc)[2][2][4][2], const Unit& u, int wr, int wc, int fr, int fq) const {
        const int row0 = u.sb + wr * 64 + fr, col0 = (u.pn & 7) * BM + wc * 32 + 8 * fq;
        int tk[2][4]; float wv[2][4];
#pragma unroll
        for (int ai = 0; ai < 2; ++ai)
#pragma unroll
            for (int m = 0; m < 4; ++m) { const int slot = row0 + ai * HALF + m * 16; tk[ai][m] = slot_tok[slot]; wv[ai][m] = slot_w[slot]; }
#pragma unroll
        for (int ai = 0; ai < 2; ++ai)
#pragma unroll
            for (int m = 0; m < 4; ++m) { const int t = tk[ai][m]; const float w = wv[ai][m];
                if (t >= 0) { bf16_t* rowp = Out + ((size_t)(t & 1) * NTOK + (size_t)(t >> 1)) * DM + col0;
#pragma unroll
                    for (int bj = 0; bj < 2; ++bj) { const f32x4 v0 = acc[ai][bj][m][0] * w, v1 = acc[ai][bj][m][1] * w;
                        u32x4 o; o.x = cvt_pk_bf16(v0[0], v0[1]); o.y = cvt_pk_bf16(v0[2], v0[3]); o.z = cvt_pk_bf16(v1[0], v1[1]); o.w = cvt_pk_bf16(v1[2], v1[3]);
                        __builtin_nontemporal_store(o, (u32x4*)(rowp + bj * HALF)); } } }
    }
};
}

constexpr int KS_STRIDE = 72;
constexpr int VT_STRIDE = 260;
constexpr int ATT_KS_OFF = 0, ATT_VT_OFF = 256 * KS_STRIDE * 2;
__device__ __forceinline__ void attn_phase(const Frame& F, const In& I, int l) {
    const bf16* proj = (const bf16*)(F.ws + WS_PROJ); bf16* attn = (bf16*)(F.ws + WS_AY);
    LAS bf16* Ks = (LAS bf16*)(F.lds + ATT_KS_OFF); LAS bf16* Vt = (LAS bf16*)(F.lds + ATT_VT_OFF);
    const int lane = F.lane, r32 = lane & 31, h = lane >> 5;
    for (int u = F.vcu; u < 256; u += F.G) {
        const int kvh = u & 3, n = (u >> 2) & 31, b = u >> 7;
#pragma unroll
        for (int i = 0; i < 4; ++i) { const int c = F.tid + 512 * i, key = c >> 3, ch = c & 7;
            int s = 128 * (n - 1) + key; if (s < 0) s = 0;
            const bf16* rowp = proj + (size_t)(b * SEQ + s) * INP;
            const v4u kv = *(const GAS v4u*)(rowp + C_K + kvh * 64 + ch * 8);
            const v4u vv = *(const GAS v4u*)(rowp + C_V + kvh * 64 + ch * 8);
            *(LAS v4u*)(Ks + key * KS_STRIDE + ch * 8) = kv;
            LAS bf16* vp = Vt + (ch * 8) * VT_STRIDE + key;
            vp[0 * VT_STRIDE] = (bf16)(vv.x & 0xffff); vp[1 * VT_STRIDE] = (bf16)(vv.x >> 16); vp[2 * VT_STRIDE] = (bf16)(vv.y & 0xffff); vp[3 * VT_STRIDE] = (bf16)(vv.y >> 16);
            vp[4 * VT_STRIDE] = (bf16)(vv.z & 0xffff); vp[5 * VT_STRIDE] = (bf16)(vv.z >> 16); vp[6 * VT_STRIDE] = (bf16)(vv.w & 0xffff); vp[7 * VT_STRIDE] = (bf16)(vv.w >> 16); }
        __syncthreads();
        const int g = F.wave & 3, half = F.wave >> 2, hq = kvh * 4 + g;
        const float slope2 = exp2f(-0.5f * (float)(hq + 1)) * LOG2E;
        const float sink2 = I.sinks[l * 16 + hq] * LOG2E;
#pragma unroll 1
        for (int qt = 0; qt < 2; ++qt) {
            const int qrel = 64 * half + 32 * qt;
            const int tpos = 128 * n + qrel + r32;
            const bf16* qp = proj + (size_t)(b * SEQ + tpos) * INP + C_Q + hq * 64 + h * 8;
            bf16x8 qf[4];
#pragma unroll
            for (int ks = 0; ks < 4; ++ks) qf[ks] = *(const GAS bf16x8*)(qp + ks * 16);
            float mx = sink2, lsum = 0.f;
            f32x16 o0, o1;
#pragma unroll
            for (int i = 0; i < 16; ++i) { o0[i] = 0.f; o1[i] = 0.f; }
#pragma unroll 1
            for (int j = 0; j < 5; ++j) {
                f32x16 a;
#pragma unroll
                for (int i = 0; i < 16; ++i) a[i] = 0.f;
#pragma unroll
                for (int ks = 0; ks < 4; ++ks) { const bf16x8 kf = *(const LAS bf16x8*)(Ks + (qrel + 32 * j + r32) * KS_STRIDE + ks * 16 + h * 8);
                    a = __builtin_amdgcn_mfma_f32_32x32x16_bf16(kf, qf[ks], a, 0, 0, 0); }
                float tm = -1e30f;
#pragma unroll
                for (int i = 0; i < 16; ++i) { const int row = (i & 3) + 8 * (i >> 2) + 4 * h;
                    const int dist = r32 + 128 - 32 * j - row;
                    const int spos = tpos - dist;
                    const bool ok = (dist >= 0) && (dist < 128) && (spos >= 0);
                    const float v = ok ? (a[i] * (0.125f * LOG2E) - slope2 * (float)dist) : -1e30f;
                    a[i] = v; tm = fmaxf(tm, v); }
                tm = fmaxf(tm, __shfl_xor(tm, 32));
                const float mn = fmaxf(mx, tm), alpha = exp2f(mx - mn); mx = mn;
                lsum *= alpha;
#pragma unroll
                for (int i = 0; i < 16; ++i) { o0[i] *= alpha; o1[i] *= alpha; }
#pragma unroll
                for (int i = 0; i < 16; ++i) { const float p = exp2f(a[i] - mx); a[i] = p; lsum += p; }
#pragma unroll
                for (int s = 0; s < 2; ++s) {
                    bf16x8 pf; { v4u w; w.x = pk2(a[8 * s + 0], a[8 * s + 1]); w.y = pk2(a[8 * s + 2], a[8 * s + 3]); w.z = pk2(a[8 * s + 4], a[8 * s + 5]); w.w = pk2(a[8 * s + 6], a[8 * s + 7]); pf = __builtin_bit_cast(bf16x8, w); }
                    const int kb = qrel + 32 * j + 16 * s + 4 * h;
                    { const LAS bf16* vp = Vt + r32 * VT_STRIDE + kb; const v2u lo = *(const LAS v2u*)vp, hi = *(const LAS v2u*)(vp + 8);
                      v4u w; w.x = lo.x; w.y = lo.y; w.z = hi.x; w.w = hi.y; o0 = __builtin_amdgcn_mfma_f32_32x32x16_bf16(__builtin_bit_cast(bf16x8, w), pf, o0, 0, 0, 0); }
                    { const LAS bf16* vp = Vt + (32 + r32) * VT_STRIDE + kb; const v2u lo = *(const LAS v2u*)vp, hi = *(const LAS v2u*)(vp + 8);
                      v4u w; w.x = lo.x; w.y = lo.y; w.z = hi.x; w.w = hi.y; o1 = __builtin_amdgcn_mfma_f32_32x32x16_bf16(__builtin_bit_cast(bf16x8, w), pf, o1, 0, 0, 0); }
                }
            }
            lsum += __shfl_xor(lsum, 32);
            const float inv = rcpf_(lsum + exp2f(sink2 - mx));
            bf16* op = attn + (size_t)(b * SEQ + tpos) * 2048 + hq * 64 + 4 * h;
#pragma unroll
            for (int gi = 0; gi < 4; ++gi) {
                if (F8_MRG) { GAS unsigned char* op8 = (GAS unsigned char*)attn + (size_t)(b * SEQ + tpos) * 2048 + hq * 64 + 4 * h; const float i16 = 16.f * inv;
                    int p0 = 0, p1 = 0; p0 = __builtin_amdgcn_cvt_pk_fp8_f32(o0[4 * gi + 0] * i16, o0[4 * gi + 1] * i16, p0, false); p0 = __builtin_amdgcn_cvt_pk_fp8_f32(o0[4 * gi + 2] * i16, o0[4 * gi + 3] * i16, p0, true);
                    p1 = __builtin_amdgcn_cvt_pk_fp8_f32(o1[4 * gi + 0] * i16, o1[4 * gi + 1] * i16, p1, false); p1 = __builtin_amdgcn_cvt_pk_fp8_f32(o1[4 * gi + 2] * i16, o1[4 * gi + 3] * i16, p1, true);
                    *(GAS unsigned*)(op8 + 8 * gi) = (unsigned)p0; *(GAS unsigned*)(op8 + 32 + 8 * gi) = (unsigned)p1; }
                else {
                v2u w0; w0.x = pk2(o0[4 * gi + 0] * inv, o0[4 * gi + 1] * inv); w0.y = pk2(o0[4 * gi + 2] * inv, o0[4 * gi + 3] * inv); *(GAS v2u*)(op + 8 * gi) = w0;
                v2u w1; w1.x = pk2(o1[4 * gi + 0] * inv, o1[4 * gi + 1] * inv); w1.y = pk2(o1[4 * gi + 2] * inv, o1[4 * gi + 3] * inv); *(GAS v2u*)(op + 32 + 8 * gi) = w1; } }
        }
        __syncthreads();
    }
}

constexpr int ACT_STRIDE = 328;
__device__ __forceinline__ float lerp_bf(unsigned cur, unsigned prv, float mix, bool hi) {
    const float c = hi ? bfhi(cur) : bflo(cur), p = hi ? bfhi(prv) : bflo(prv); return c + (p - c) * mix; }
__device__ __forceinline__ f32x4 lerp4(const bf16* cur, const bf16* prv, bool has_prev, const float* mix) {
    const v2u c = *(const GAS v2u*)cur; v2u p = (v2u){0u, 0u}; if (has_prev) p = *(const GAS v2u*)prv; const f32x4 m = *(const GAS f32x4*)mix;
    f32x4 o; o[0] = lerp_bf(c.x, p.x, m[0], false); o[1] = lerp_bf(c.x, p.x, m[1], true); o[2] = lerp_bf(c.y, p.y, m[2], false); o[3] = lerp_bf(c.y, p.y, m[3], true); return o; }
__device__ __forceinline__ void prep_phase(const Frame& F, const In& I, int l) {
    const bf16* proj = (const bf16*)(F.ws + WS_PROJ);
    const bf16* lw = (const bf16*)(F.ws + WS_LORA);
    float* SC = (float*)(F.ws + WS_SCAN); float* Gout = (float*)(F.ws + WS_G); float* VF = (float*)(F.ws + WS_VFIRST);
    LAS bf16* act = (LAS bf16*)F.lds;
    const float* mixz = I.shift_mix + (size_t)l * ZW;
    const int lane = F.lane, tl = lane & 15, q4 = lane >> 4;
    for (int u = F.vcu; u < NTOK / 32; u += F.G) {
        const int tok0 = u * 32;
        for (int idx = F.tid; idx < 32 * 160; idx += NTHR) { const int t = idx / 160, c = (idx - t * 160) * 2; const int tok = tok0 + t; const bool hp = (tok & (SEQ - 1)) != 0;
            float v0 = 0.f, v1 = 0.f;
            if (c < 288 || l == 1) {
                const int col = (c < 288) ? (C_Z + 3072 + c) : (C_ZV + (c - 288));
                const float* mp = (c < 288) ? (mixz + 3072 + c) : (I.vres_mix + (c - 288));
                const unsigned cu = *(const GAS unsigned*)(proj + (size_t)tok * INP + col); unsigned pu = 0u; if (hp) pu = *(const GAS unsigned*)(proj + (size_t)(tok - 1) * INP + col);
                v0 = lerp_bf(cu, pu, mp[0], false); v1 = lerp_bf(cu, pu, mp[1], true);
                if (c < 64) { v0 = tanhf(v0); v1 = tanhf(v1); } else if (c >= 128 && c < 288) { v0 = sigmoidf_(v0); v1 = sigmoidf_(v1); }
            }
            *(LAS unsigned*)(act + t * ACT_STRIDE + c) = pk2(v0, v1); }
        __syncthreads();
#pragma unroll 1
        for (int hh = 0; hh < 2; ++hh) {
            const int H = 2 * F.wave + hh, cb = 64 * H + 4 * q4;
            float inv[2];
#pragma unroll
            for (int mt = 0; mt < 2; ++mt) { const int tok = tok0 + 16 * mt + tl; const bool hp = (tok & (SEQ - 1)) != 0; float ss = 0.f;
#pragma unroll
                for (int rt = 0; rt < 4; ++rt) { const int c = cb + 16 * rt;
                    const f32x4 kr = lerp4(proj + (size_t)tok * INP + C_Z + 1024 + c, proj + (size_t)(tok - 1) * INP + C_Z + 1024 + c, hp, mixz + 1024 + c);
                    const f32x4 kk = kr * *(const GAS f32x4*)(I.k_k + l * 1024 + c); ss += (kk[0] * kk[0] + kk[1] * kk[1]) + (kk[2] * kk[2] + kk[3] * kk[3]); }
                ss += __shfl_xor(ss, 16); ss += __shfl_xor(ss, 32);
                inv[mt] = 1.f / fmaxf(sqrtf(ss), 1e-12f); }
#pragma unroll 1
            for (int rt = 0; rt < 4; ++rt) {
                const int c = cb + 16 * rt;
                const int arow = 64 * H + 16 * rt + tl;
                bf16x8 fw[2], fa[2], fg[5], fv;
#pragma unroll
                for (int ks = 0; ks < 2; ++ks) { fw[ks] = *(const GAS bf16x8*)(lw + LO_WUP + (size_t)arow * 64 + ks * 32 + 8 * q4); fa[ks] = *(const GAS bf16x8*)(lw + LO_AUP + (size_t)arow * 64 + ks * 32 + 8 * q4); }
#pragma unroll
                for (int ks = 0; ks < 5; ++ks) fg[ks] = *(const GAS bf16x8*)(lw + LO_GUP + (size_t)arow * 160 + ks * 32 + 8 * q4);
                if (l == 1) fv = *(const GAS bf16x8*)(lw + LO_VUP + (size_t)arow * 32 + 8 * q4); else fv = (bf16x8){0, 0, 0, 0, 0, 0, 0, 0};
                const f32x4 w0 = *(const GAS f32x4*)(I.w0 + l * 1024 + c), a0 = *(const GAS f32x4*)(I.a0 + l * 1024 + c), kkc = *(const GAS f32x4*)(I.k_k + l * 1024 + c), kac = *(const GAS f32x4*)(I.k_a + l * 1024 + c);
                f32x4 v0c = (f32x4){0.f, 0.f, 0.f, 0.f}; if (l == 1) v0c = *(const GAS f32x4*)(I.vres_v0 + c);
#pragma unroll
                for (int mt = 0; mt < 2; ++mt) {
                    const int tok = tok0 + 16 * mt + tl; const bool hp = (tok & (SEQ - 1)) != 0;
                    const LAS bf16* ap = act + (16 * mt + tl) * ACT_STRIDE + 8 * q4;
                    f32x4 aw = (f32x4){0.f, 0.f, 0.f, 0.f}, aa = aw, ag = aw, av = aw;
#pragma unroll
                    for (int ks = 0; ks < 2; ++ks) { aw = __builtin_amdgcn_mfma_f32_16x16x32_bf16(fw[ks], *(const LAS bf16x8*)(ap + ks * 32), aw, 0, 0, 0);
                                                     aa = __builtin_amdgcn_mfma_f32_16x16x32_bf16(fa[ks], *(const LAS bf16x8*)(ap + 64 + ks * 32), aa, 0, 0, 0); }
#pragma unroll
                    for (int ks = 0; ks < 5; ++ks) ag = __builtin_amdgcn_mfma_f32_16x16x32_bf16(fg[ks], *(const LAS bf16x8*)(ap + 128 + ks * 32), ag, 0, 0, 0);
                    if (l == 1) av = __builtin_amdgcn_mfma_f32_16x16x32_bf16(fv, *(const LAS bf16x8*)(ap + 288), av, 0, 0, 0);
                    const bf16* pc = proj + (size_t)tok * INP + C_Z + c; const bf16* pp = proj + (size_t)(tok - 1) * INP + C_Z + c;
                    const f32x4 r = lerp4(pc, pp, hp, mixz + c), kr = lerp4(pc + 1024, pp + 1024, hp, mixz + 1024 + c), vr = lerp4(pc + 2048, pp + 2048, hp, mixz + 2048 + c);
                    f32x4 dec, a, vv, kkn, k2, bb;
                    const size_t o = (size_t)tok * 1024 + c;
                    f32x4 vf = (f32x4){0.f, 0.f, 0.f, 0.f}; if (l == 1) vf = *(const GAS f32x4*)(VF + o);
#pragma unroll
                    for (int e = 0; e < 4; ++e) {
                        const float xw = -(w0[e] + aw[e]);
                        const float sp = fmaxf(xw, 0.f) + __logf(1.f + __expf(-fabsf(xw)));
                        dec[e] = __expf(-__expf(-sp - 0.5f));
                        a[e] = sigmoidf_(a0[e] + aa[e]);
                        vv[e] = (l == 1) ? (vr[e] + (vf[e] - vr[e]) * sigmoidf_(v0c[e] + av[e])) : vr[e];
                        kkn[e] = kr[e] * kkc[e] * inv[mt];
                        k2[e] = kr[e] * (1.f + (a[e] - 1.f) * kac[e]);
                        bb[e] = kkn[e] * a[e];
                    }
                    *(GAS f32x4*)(SC + 0 * SCAN_STRIDE + o) = r; *(GAS f32x4*)(SC + 1 * SCAN_STRIDE + o) = dec; *(GAS f32x4*)(SC + 2 * SCAN_STRIDE + o) = k2;
                    *(GAS f32x4*)(SC + 3 * SCAN_STRIDE + o) = vv; *(GAS f32x4*)(SC + 4 * SCAN_STRIDE + o) = kkn; *(GAS f32x4*)(SC + 5 * SCAN_STRIDE + o) = bb;
                    *(GAS f32x4*)(Gout + o) = ag;
                    if (l == 0) *(GAS f32x4*)(VF + o) = vr;
                }
            }
        }
        __syncthreads();
    }
}

__device__ __forceinline__ float red16(float v) {
    v += __builtin_bit_cast(float, __builtin_amdgcn_update_dpp(0, __builtin_bit_cast(int, v), 0xB1, 0xF, 0xF, false));
    v += __builtin_bit_cast(float, __builtin_amdgcn_update_dpp(0, __builtin_bit_cast(int, v), 0x4E, 0xF, 0xF, false));
    v += __builtin_bit_cast(float, __builtin_amdgcn_update_dpp(0, __builtin_bit_cast(int, v), 0x141, 0xF, 0xF, false));
    v += __builtin_bit_cast(float, __builtin_amdgcn_update_dpp(0, __builtin_bit_cast(int, v), 0x140, 0xF, 0xF, false));
    return v;
}
struct ScanIn { f32x4 w, kk, b, k, r; float v; };
__device__ __forceinline__ ScanIn scan_load(const float* SC, size_t base, int kq, int row) {
    ScanIn s; const size_t o = base + 4 * kq;
    s.r = *(const GAS f32x4*)(SC + 0 * SCAN_STRIDE + o); s.w = *(const GAS f32x4*)(SC + 1 * SCAN_STRIDE + o); s.k = *(const GAS f32x4*)(SC + 2 * SCAN_STRIDE + o);
    s.kk = *(const GAS f32x4*)(SC + 4 * SCAN_STRIDE + o); s.b = *(const GAS f32x4*)(SC + 5 * SCAN_STRIDE + o); s.v = *(const GAS float*)(SC + 3 * SCAN_STRIDE + base + row); return s; }
__device__ __forceinline__ void scan_phase(const Frame& F) {
    const float* SC = (const float*)(F.ws + WS_SCAN); float* Y = (float*)(F.ws + WS_Y);
    const int lane = F.lane, kq = lane & 15;
    for (int u = F.vcu; u < 64; u += F.G) {
        const int half = u & 1, H = (u >> 1) & 15, b = u >> 5;
        const int row = 32 * half + 4 * F.wave + (lane >> 4);
        const size_t base0 = (size_t)b * SEQ * 1024 + H * 64;
        f32x4 S = (f32x4){0.f, 0.f, 0.f, 0.f};
        ScanIn in0 = scan_load(SC, base0, kq, row), in1 = scan_load(SC, base0 + 1024, kq, row), in2 = scan_load(SC, base0 + 2048, kq, row), in3 = scan_load(SC, base0 + 3072, kq, row);
#define SCAN_STEP(IN, T) do { \
            float p = (S[0] * IN.kk[0] + S[1] * IN.kk[1]) + (S[2] * IN.kk[2] + S[3] * IN.kk[3]); p = red16(p); const float sa = -p; \
            S[0] = S[0] * IN.w[0] + (sa * IN.b[0] + IN.v * IN.k[0]); S[1] = S[1] * IN.w[1] + (sa * IN.b[1] + IN.v * IN.k[1]); \
            S[2] = S[2] * IN.w[2] + (sa * IN.b[2] + IN.v * IN.k[2]); S[3] = S[3] * IN.w[3] + (sa * IN.b[3] + IN.v * IN.k[3]); \
            float y = (S[0] * IN.r[0] + S[1] * IN.r[1]) + (S[2] * IN.r[2] + S[3] * IN.r[3]); y = red16(y); \
            if (kq == 0) Y[base0 + (size_t)(T) * 1024 + row] = y; \
            const int tn = (T) + 4; if (tn < SEQ) IN = scan_load(SC, base0 + (size_t)tn * 1024, kq, row); } while (0)
#pragma unroll 1
        for (int t = 0; t < SEQ; t += 4) { SCAN_STEP(in0, t); SCAN_STEP(in1, t + 1); SCAN_STEP(in2, t + 2); SCAN_STEP(in3, t + 3); }
#undef SCAN_STEP
    }
}

__device__ __forceinline__ void post_phase(const Frame& F, const In& I, int l) {
    const float* SC = (const float*)(F.ws + WS_SCAN); const float* Y = (const float*)(F.ws + WS_Y); const float* Gv = (const float*)(F.ws + WS_G); bf16* YB = (bf16*)(F.ws + WS_YB);
    const int gw = F.vcu * NWAVES + F.wave, NGW = F.G * NWAVES, lane = F.lane;
    for (int p = gw; p < NTOK * 16; p += NGW) {
        const size_t o = (size_t)p * 64 + lane; const int c = (p & 15) * 64 + lane;
        const float y = Y[o], r = SC[o], k = SC[2 * SCAN_STRIDE + o], v = SC[3 * SCAN_STRIDE + o], g = Gv[o];
        const float mu = wave_sum(y) * (1.f / 64.f); const float d = y - mu; const float var = wave_sum(d * d) * (1.f / 64.f);
        const float rk = wave_sum(r * k * I.r_k[l * 1024 + c]);
        const float yn = d * (__builtin_amdgcn_rsqf(var + GN_EPS)) * I.ln_w[l * 1024 + c] + I.ln_b[l * 1024 + c];
        YB[o] = (bf16)f2bf((yn + rk * v) * g);
    }
}

typedef short s16x4_t __attribute__((ext_vector_type(4)));
constexpr int CS = 72;
constexpr int L_At = 0, L_Rt = 9216, L_Bt = 18432, L_Kt = 27648, L_BT = 36864, L_KT = 46080, L_VT = 55296, L_NLab = 64512, L_Lak = 73728, L_Mrb = 82944, L_Mrk = 92160,
              L_G = 101376, L_Ld = 117760, L_Tbb = 121856, L_SEG = 123904;
static_assert(L_SEG + 2048 <= RING_BYTES, "scanA LDS");
constexpr size_t WS_PF = WS_TMP, WS_RWF = WS_TMP + 16 * MiB, WS_QF = WS_TMP + 32 * MiB, WS_Y0F = WS_TMP + 64 * MiB;
constexpr size_t WS_S0F = WS_H, WS_RK = WS_H + 16 * MiB;
static_assert(WS_Y0F + 32 * MiB <= WS_ROUTE, "scan scratch");
__device__ __forceinline__ s16x4_t pk4(float a, float b, float c, float d) { v2u w; w.x = pk2(a, b); w.y = pk2(c, d); return __builtin_bit_cast(s16x4_t, w); }
__device__ __forceinline__ f32x4 mfma16(s16x4_t a, s16x4_t b, f32x4 c) { return __builtin_amdgcn_mfma_f32_16x16x16bf16_1k(a, b, c, 0, 0, 0); }
__device__ __forceinline__ s16x4_t lds4(const LAS bf16* p) { return *(const LAS s16x4_t*)p; }

__device__ __forceinline__ void scanA_phase(const Frame& F, const In& I, int l) {
    const float* SC = (const float*)(F.ws + WS_SCAN);
    LAS unsigned char* L = F.lds;
    LAS bf16* At = (LAS bf16*)(L + L_At); LAS bf16* Rt = (LAS bf16*)(L + L_Rt); LAS bf16* Bt = (LAS bf16*)(L + L_Bt); LAS bf16* Kt = (LAS bf16*)(L + L_Kt);
    LAS bf16* BT = (LAS bf16*)(L + L_BT); LAS bf16* KT = (LAS bf16*)(L + L_KT); LAS bf16* VT = (LAS bf16*)(L + L_VT);
    LAS bf16* NLab = (LAS bf16*)(L + L_NLab); LAS bf16* Lak = (LAS bf16*)(L + L_Lak); LAS bf16* Mrb = (LAS bf16*)(L + L_Mrb); LAS bf16* Mrk = (LAS bf16*)(L + L_Mrk);
    LAS float* Gs = (LAS float*)(L + L_G); LAS float* Ld = (LAS float*)(L + L_Ld); LAS bf16* Tbb = (LAS bf16*)(L + L_Tbb); LAS float* SEG = (LAS float*)(L + L_SEG);
    const int lane = F.lane, w = F.wave, c16 = lane & 15, q = lane >> 4;
    for (int u = F.vcu; u < 2048; u += F.G) {
        const int c = u & 63, H = (u >> 6) & 15, b = u >> 10;
        const size_t base = ((size_t)(b * SEQ + c * 64)) * 1024 + H * 64;
        { float loc[8]; float p = 1.f;
#pragma unroll
          for (int i = 0; i < 8; ++i) { p *= SC[1 * SCAN_STRIDE + base + (size_t)(8 * w + i) * 1024 + lane]; loc[i] = p; }
          SEG[w * 64 + lane] = p;
          __syncthreads();
          float pre = 1.f;
          for (int s = 0; s < w; ++s) pre *= SEG[s * 64 + lane];
#pragma unroll
          for (int i = 0; i < 8; ++i) Gs[(8 * w + i) * 64 + lane] = loc[i] * pre; }
        __syncthreads();
#pragma unroll
        for (int it = 0; it < 2; ++it) { const int item = F.tid + 512 * it, t = item >> 4, kq = item & 15; const size_t o = base + (size_t)t * 1024 + 4 * kq;
            const f32x4 r4 = *(const GAS f32x4*)(SC + o), k4 = *(const GAS f32x4*)(SC + 2 * SCAN_STRIDE + o), v4 = *(const GAS f32x4*)(SC + 3 * SCAN_STRIDE + o),
                        a4 = *(const GAS f32x4*)(SC + 4 * SCAN_STRIDE + o), b4 = *(const GAS f32x4*)(SC + 5 * SCAN_STRIDE + o);
            const f32x4 g4 = *(const LAS f32x4*)(Gs + t * 64 + 4 * kq); f32x4 gp4 = (f32x4){1.f, 1.f, 1.f, 1.f}; if (t > 0) gp4 = *(const LAS f32x4*)(Gs + (t - 1) * 64 + 4 * kq);
            const f32x4 rk4 = *(const GAS f32x4*)(I.r_k + l * 1024 + H * 64 + 4 * kq);
            f32x4 ig; ig[0] = rcpf_(g4[0]); ig[1] = rcpf_(g4[1]); ig[2] = rcpf_(g4[2]); ig[3] = rcpf_(g4[3]);
            const f32x4 at = a4 * gp4, bt = b4 * ig, kt = k4 * ig, rt = r4 * g4;
            *(LAS s16x4_t*)(At + t * CS + 4 * kq) = pk4(at[0], at[1], at[2], at[3]); *(LAS s16x4_t*)(Rt + t * CS + 4 * kq) = pk4(rt[0], rt[1], rt[2], rt[3]);
            *(LAS s16x4_t*)(Bt + t * CS + 4 * kq) = pk4(bt[0], bt[1], bt[2], bt[3]); *(LAS s16x4_t*)(Kt + t * CS + 4 * kq) = pk4(kt[0], kt[1], kt[2], kt[3]);
#pragma unroll
            for (int e = 0; e < 4; ++e) { BT[(4 * kq + e) * CS + t] = (bf16)f2bf(bt[e]); KT[(4 * kq + e) * CS + t] = (bf16)f2bf(kt[e]); VT[(4 * kq + e) * CS + t] = (bf16)f2bf(v4[e]); }
            float rk = (r4[0] * k4[0] * rk4[0] + r4[1] * k4[1] * rk4[1]) + (r4[2] * k4[2] * rk4[2] + r4[3] * k4[3] * rk4[3]);
            rk = red16(rk);
            if (kq == 0) ((float*)(F.ws + WS_RK))[(size_t)u * 64 + t] = rk; }
        __syncthreads();
        { const int tt = w & 3; const LAS bf16* Arow = ((w < 4) ? At : Rt) + (16 * tt + c16) * CS + 4 * q;
          s16x4_t af[4];
#pragma unroll
          for (int ks = 0; ks < 4; ++ks) af[ks] = lds4(Arow + 16 * ks);
          for (int jt = 0; jt <= tt; ++jt) {
#pragma unroll
              for (int which = 0; which < 2; ++which) {
                  const LAS bf16* Brow = (which ? Kt : Bt) + (16 * jt + c16) * CS + 4 * q;
                  f32x4 acc = (f32x4){0.f, 0.f, 0.f, 0.f};
#pragma unroll
                  for (int ks = 0; ks < 4; ++ks) acc = mfma16(af[ks], lds4(Brow + 16 * ks), acc);
                  LAS bf16* dst = (w < 4) ? (which ? Lak : NLab) : (which ? Mrk : Mrb);
#pragma unroll
                  for (int e = 0; e < 4; ++e) { const int t = 16 * tt + 4 * q + e, j = 16 * jt + c16;
                      const bool keep = (w < 4) ? (j < t) : (j <= t); float v = keep ? acc[e] : 0.f;
                      if (w < 4 && which == 0) { if (jt == tt) Ld[(tt * 16 + c16) * 16 + 4 * q + e] = v; v = -v; }
                      dst[t * CS + j] = (bf16)f2bf(v); } } } }
        __syncthreads();
        if (w == 0) { float s[16]; const LAS float* Lb = Ld + q * 256;
#pragma unroll
            for (int i = 0; i < 16; ++i) s[i] = (i == c16) ? 1.f : 0.f;
#pragma unroll
            for (int j = 0; j < 16; ++j) { const float Tj = s[j]; Tbb[(q * 16 + j) * 16 + c16] = (bf16)f2bf(Tj);
#pragma unroll
                for (int ci = (j + 1) / 4; ci < 4; ++ci) { const f32x4 lc = *(const LAS f32x4*)(Lb + j * 16 + 4 * ci);
#pragma unroll
                    for (int e = 0; e < 4; ++e) if (4 * ci + e > j) s[4 * ci + e] -= lc[e] * Tj; } } }
        f32x4 X[4]; s16x4_t vB[4];
        if (w < 4) {
#pragma unroll
            for (int bb = 0; bb < 4; ++bb)
#pragma unroll
                for (int e = 0; e < 4; ++e) X[bb][e] = bflo((unsigned)At[(16 * bb + 4 * q + e) * CS + 16 * w + c16]);
#pragma unroll
            for (int bb = 0; bb < 4; ++bb) vB[bb] = (s16x4_t){0, 0, 0, 0};
        } else {
#pragma unroll
            for (int bb = 0; bb < 4; ++bb) vB[bb] = lds4(VT + (16 * (w - 4) + c16) * CS + 16 * bb + 4 * q);
#pragma unroll
            for (int bb = 0; bb < 4; ++bb) { f32x4 acc = (f32x4){0.f, 0.f, 0.f, 0.f};
#pragma unroll
                for (int jb = 0; jb <= bb; ++jb) acc = mfma16(lds4(Lak + (16 * bb + c16) * CS + 16 * jb + 4 * q), vB[jb], acc);
                X[bb] = acc; }
        }
        __syncthreads();
        s16x4_t XB[4];
#pragma unroll
        for (int bb = 0; bb < 4; ++bb) {
            f32x4 r = X[bb];
#pragma unroll
            for (int jb = 0; jb < bb; ++jb) r = mfma16(lds4(NLab + (16 * bb + c16) * CS + 16 * jb + 4 * q), pk4(X[jb][0], X[jb][1], X[jb][2], X[jb][3]), r);
            const f32x4 z = (f32x4){0.f, 0.f, 0.f, 0.f};
            X[bb] = mfma16(lds4(Tbb + (bb * 16 + c16) * 16 + 4 * q), pk4(r[0], r[1], r[2], r[3]), z);
        }
#pragma unroll
        for (int bb = 0; bb < 4; ++bb) XB[bb] = pk4(-X[bb][0], -X[bb][1], -X[bb][2], -X[bb][3]);
        if (w < 4) {
            s16x4_t* PF = (s16x4_t*)(F.ws + WS_PF) + ((size_t)u * 16 + w * 4) * 64 + lane;
#pragma unroll
            for (int ct = 0; ct < 4; ++ct) { f32x4 acc = (f32x4){0.f, 0.f, 0.f, 0.f};
#pragma unroll
                for (int bb = 0; bb < 4; ++bb) acc = mfma16(XB[bb], lds4(BT + (16 * ct + c16) * CS + 16 * bb + 4 * q), acc);
                const float g63 = Gs[63 * 64 + 16 * ct + c16];
#pragma unroll
                for (int e = 0; e < 4; ++e) acc[e] = (acc[e] + ((ct == w && 4 * q + e == c16) ? 1.f : 0.f)) * g63;
                PF[ct * 64] = pk4(acc[0], acc[1], acc[2], acc[3]); }
            s16x4_t* RWF = (s16x4_t*)(F.ws + WS_RWF) + ((size_t)u * 16 + w) * 64 + lane;
#pragma unroll
            for (int tt = 0; tt < 4; ++tt) { const v2u rr = *(const LAS v2u*)(Rt + (16 * tt + c16) * CS + 16 * w + 4 * q);
                f32x4 acc; acc[0] = bflo(rr.x); acc[1] = bfhi(rr.x); acc[2] = bflo(rr.y); acc[3] = bfhi(rr.y);
#pragma unroll
                for (int bb = 0; bb <= tt; ++bb) acc = mfma16(XB[bb], lds4(Mrb + (16 * tt + c16) * CS + 16 * bb + 4 * q), acc);
                RWF[tt * 4 * 64] = pk4(acc[0], acc[1], acc[2], acc[3]); }
        } else {
            const int vt = w - 4;
            f32x4* QF = (f32x4*)(F.ws + WS_QF) + ((size_t)u * 16 + vt * 4) * 64 + lane;
#pragma unroll
            for (int ct = 0; ct < 4; ++ct) { f32x4 acc = (f32x4){0.f, 0.f, 0.f, 0.f};
#pragma unroll
                for (int bb = 0; bb < 4; ++bb) { acc = mfma16(lds4(BT + (16 * ct + c16) * CS + 16 * bb + 4 * q), XB[bb], acc); acc = mfma16(lds4(KT + (16 * ct + c16) * CS + 16 * bb + 4 * q), vB[bb], acc); }
                const f32x4 g63 = *(const LAS f32x4*)(Gs + 63 * 64 + 16 * ct + 4 * q);
                QF[ct * 64] = acc * g63; }
            f32x4* Y0F = (f32x4*)(F.ws + WS_Y0F) + ((size_t)u * 16 + vt * 4) * 64 + lane;
#pragma unroll
            for (int tt = 0; tt < 4; ++tt) { f32x4 acc = (f32x4){0.f, 0.f, 0.f, 0.f};
#pragma unroll
                for (int bb = 0; bb <= tt; ++bb) { acc = mfma16(lds4(Mrb + (16 * tt + c16) * CS + 16 * bb + 4 * q), XB[bb], acc); acc = mfma16(lds4(Mrk + (16 * tt + c16) * CS + 16 * bb + 4 * q), vB[bb], acc); }
                Y0F[tt * 64] = acc; }
        }
        __syncthreads();
    }
}


constexpr size_t WS_ACT = WS_YB, WS_INVN = WS_YB + 8 * MiB;
__device__ __forceinline__ void acts_phase(const Frame& F, const In& I, int l) {
    const bf16* proj = (const bf16*)(F.ws + WS_PROJ); bf16* ACT = (bf16*)(F.ws + WS_ACT); float* INV = (float*)(F.ws + WS_INVN);
    const float* mixz = I.shift_mix + (size_t)l * ZW;
    for (int u = F.vcu; u < NTOK / 32; u += F.G) {
        const int tok0 = 32 * u;
        { unsigned cu[10], pu[10];
#pragma unroll
          for (int i = 0; i < 10; ++i) { const int idx = F.tid + NTHR * i, t = idx / 160, cc = (idx - t * 160) * 2; const int tok = tok0 + t; const bool hp = (tok & (SEQ - 1)) != 0;
              cu[i] = 0u; pu[i] = 0u;
              if (cc < 288 || l == 1) {
                  const int col = (cc < 288) ? (C_Z + 3072 + cc) : (C_ZV + (cc - 288));
                  cu[i] = *(const GAS unsigned*)(proj + (size_t)tok * INP + col); if (hp) pu[i] = *(const GAS unsigned*)(proj + (size_t)(tok - 1) * INP + col); } }
#pragma unroll
          for (int i = 0; i < 10; ++i) { const int idx = F.tid + NTHR * i, t = idx / 160, cc = (idx - t * 160) * 2;
              float v0 = 0.f, v1 = 0.f;
              if (cc < 288 || l == 1) { const float* mp = (cc < 288) ? (mixz + 3072 + cc) : (I.vres_mix + (cc - 288));
                  v0 = lerp_bf(cu[i], pu[i], mp[0], false); v1 = lerp_bf(cu[i], pu[i], mp[1], true);
                  if (cc < 64) { v0 = tanhf(v0); v1 = tanhf(v1); } else if (cc >= 128 && cc < 288) { v0 = sigmoidf_(v0); v1 = sigmoidf_(v1); } }
              *(GAS unsigned*)(ACT + (size_t)(tok0 + t) * 320 + cc) = pk2(v0, v1); } }
#pragma unroll 4
        for (int it = 0; it < 16; ++it) { const int item = F.tid + NTHR * it, kq = item & 15, hh = (item >> 4) & 15, t = item >> 8; const int tok = tok0 + t; const bool hp = (tok & (SEQ - 1)) != 0; const int ch = 64 * hh + 4 * kq;
            const f32x4 kr = lerp4(proj + (size_t)tok * INP + C_Z + 1024 + ch, proj + (size_t)(tok - 1) * INP + C_Z + 1024 + ch, hp, mixz + 1024 + ch);
            const f32x4 kk = kr * *(const GAS f32x4*)(I.k_k + l * 1024 + ch); float ss = (kk[0] * kk[0] + kk[1] * kk[1]) + (kk[2] * kk[2] + kk[3] * kk[3]);
            ss = red16(ss);
            if (kq == 0) INV[(size_t)tok * 16 + hh] = 1.f / fmaxf(sqrtf(ss), 1e-12f); }
    }
}

__device__ __forceinline__ int chunk_unit(int vcu, int i, int G) {
#ifndef CHUNK_LOCAL
#define CHUNK_LOCAL 0
#endif
    if (!CHUNK_LOCAL || G != 256) return vcu + i * G;
    const int x = vcu >> 5, j = vcu & 31; const int b = x >> 2, cc = 16 * (x & 3) + (j & 15), H = (j >> 4) + 2 * i;
    return (b << 10) | (H << 6) | cc; }
constexpr int L_ACT = 64512;
constexpr int L_G2 = 106496, L_Ld2 = 122880, L_Tbb2 = 126976, L_SEG2 = 129024;
constexpr int L_INVN = LDSCTL_OFF + 4096, L_RKS = LDSCTL_OFF + 4096 + 256, L_GT = LDSCTL_OFF + 6144;
constexpr size_t WS_VGF = WS_G;
static_assert(L_ACT + 64 * ACT_STRIDE * 2 <= L_G2 && L_SEG2 + 2048 <= RING_BYTES && L_RKS + 1024 <= L_GT && L_GT + 64 * CS * 2 <= LDS_BYTES, "chunk LDS");
__device__ __forceinline__ float scan16_mul(float v) {
    v *= __builtin_bit_cast(float, __builtin_amdgcn_update_dpp(0x3f800000, __builtin_bit_cast(int, v), 0x111, 0xF, 0xF, false));
    v *= __builtin_bit_cast(float, __builtin_amdgcn_update_dpp(0x3f800000, __builtin_bit_cast(int, v), 0x112, 0xF, 0xF, false));
    v *= __builtin_bit_cast(float, __builtin_amdgcn_update_dpp(0x3f800000, __builtin_bit_cast(int, v), 0x114, 0xF, 0xF, false));
    v *= __builtin_bit_cast(float, __builtin_amdgcn_update_dpp(0x3f800000, __builtin_bit_cast(int, v), 0x118, 0xF, 0xF, false));
    return v; }
__device__ __forceinline__ void chunk_phase(const Frame& F, const In& I, int l) {
    const bf16* proj = (const bf16*)(F.ws + WS_PROJ); const bf16* lw = (const bf16*)(F.ws + WS_LORA);
    bf16* VF = (bf16*)(F.ws + WS_VFIRST);
    LAS unsigned char* L = F.lds;
    LAS bf16* At = (LAS bf16*)(L + L_At); LAS bf16* Rt = (LAS bf16*)(L + L_Rt); LAS bf16* Bt = (LAS bf16*)(L + L_Bt); LAS bf16* Kt = (LAS bf16*)(L + L_Kt);
    LAS bf16* BT = (LAS bf16*)(L + L_BT); LAS bf16* KT = (LAS bf16*)(L + L_KT); LAS bf16* VT = (LAS bf16*)(L + L_VT);
    LAS bf16* NLab = (LAS bf16*)(L + L_NLab); LAS bf16* Lak = (LAS bf16*)(L + L_Lak); LAS bf16* Mrb = (LAS bf16*)(L + L_Mrb); LAS bf16* Mrk = (LAS bf16*)(L + L_Mrk);
    LAS float* Gs = (LAS float*)(L + L_G2); LAS float* Ld = (LAS float*)(L + L_Ld2); LAS bf16* Tbb = (LAS bf16*)(L + L_Tbb2); LAS float* SEG = (LAS float*)(L + L_SEG2);
    LAS float* RKS = (LAS float*)(L + L_RKS); LAS bf16* GT = (LAS bf16*)(L + L_GT); LAS bf16* act = (LAS bf16*)(L + L_ACT); const bf16* ACT = (const bf16*)(F.ws + WS_ACT); const float* INV = (const float*)(F.ws + WS_INVN);
    const float* mixz = I.shift_mix + (size_t)l * ZW;
    const int lane = F.lane, w = F.wave, c16 = lane & 15, q = lane >> 4;
    for (int it = 0; it * F.G < 2048; ++it) { const int u = chunk_unit(F.vcu, it, F.G); if (u >= 2048) break;
        const int c = u & 63, H = (u >> 6) & 15, b = u >> 10;
        const int tok0 = b * SEQ + c * 64;
        const bool hp0 = (c != 0);
        f32x4 rr[2], kn[2], k2r[2], bbr[2], dcv[2];
        { const int rt = w & 3, chl = 16 * rt + 4 * q, ch = 64 * H + chl;
          const int arow = 64 * H + 16 * rt + c16;
          v4u ac[5];
#pragma unroll
          for (int i = 0; i < 5; ++i) ac[i] = *(const GAS v4u*)(ACT + (size_t)(tok0 + (F.tid >> 3)) * 320 + ((F.tid & 7) + 8 * i) * 8);
          bf16x8 fw[2], fa[2], fg[5], fv;
#pragma unroll
          for (int ks = 0; ks < 2; ++ks) { fw[ks] = *(const GAS bf16x8*)(lw + LO_WUP + (size_t)arow * 64 + ks * 32 + 8 * q); fa[ks] = *(const GAS bf16x8*)(lw + LO_AUP + (size_t)arow * 64 + ks * 32 + 8 * q); }
#pragma unroll
          for (int ks = 0; ks < 5; ++ks) fg[ks] = *(const GAS bf16x8*)(lw + LO_GUP + (size_t)arow * 160 + ks * 32 + 8 * q);
          if (l == 1) fv = *(const GAS bf16x8*)(lw + LO_VUP + (size_t)arow * 32 + 8 * q); else fv = (bf16x8){0, 0, 0, 0, 0, 0, 0, 0};
          v2u zc[2][3], zp[2][3]; f32x4 vfv[2]; float invv[2];
#pragma unroll
          for (int mi = 0; mi < 2; ++mi) { const int t = 16 * (2 * (w >> 2) + mi) + c16, tok = tok0 + t; const bool hp = hp0 || (t != 0);
              const bf16* pc = proj + (size_t)tok * INP + C_Z + ch; const bf16* pp = proj + (size_t)(tok - 1) * INP + C_Z + ch;
#pragma unroll
              for (int j = 0; j < 3; ++j) { zc[mi][j] = *(const GAS v2u*)(pc + 1024 * j); zp[mi][j] = (v2u){0u, 0u}; if (hp) zp[mi][j] = *(const GAS v2u*)(pp + 1024 * j); }
              vfv[mi] = (f32x4){0.f, 0.f, 0.f, 0.f}; if (l == 1) { const v2u vb_ = *(const GAS v2u*)(VF + (size_t)tok * 1024 + ch); vfv[mi][0] = bflo(vb_.x); vfv[mi][1] = bfhi(vb_.x); vfv[mi][2] = bflo(vb_.y); vfv[mi][3] = bfhi(vb_.y); }
              invv[mi] = INV[(size_t)tok * 16 + H]; }
#pragma unroll
          for (int i = 0; i < 5; ++i) *(LAS v4u*)(act + (F.tid >> 3) * ACT_STRIDE + ((F.tid & 7) + 8 * i) * 8) = ac[i];
          __syncthreads();
          const f32x4 w0 = *(const GAS f32x4*)(I.w0 + l * 1024 + ch), a0 = *(const GAS f32x4*)(I.a0 + l * 1024 + ch), kkc = *(const GAS f32x4*)(I.k_k + l * 1024 + ch), kac = *(const GAS f32x4*)(I.k_a + l * 1024 + ch);
          const f32x4 rkc = *(const GAS f32x4*)(I.r_k + l * 1024 + ch);
          f32x4 v0c = (f32x4){0.f, 0.f, 0.f, 0.f}; if (l == 1) v0c = *(const GAS f32x4*)(I.vres_v0 + ch);
          const f32x4 mxr = *(const GAS f32x4*)(mixz + ch), mxk = *(const GAS f32x4*)(mixz + 1024 + ch), mxv = *(const GAS f32x4*)(mixz + 2048 + ch);
#pragma unroll
          for (int mi = 0; mi < 2; ++mi) {
              const int mt = 2 * (w >> 2) + mi, t = 16 * mt + c16, tok = tok0 + t;
              const LAS bf16* ap = act + t * ACT_STRIDE + 8 * q;
              f32x4 aw = (f32x4){0.f, 0.f, 0.f, 0.f}, aa = aw, ag = aw, av = aw;
#pragma unroll
              for (int ks = 0; ks < 2; ++ks) { aw = __builtin_amdgcn_mfma_f32_16x16x32_bf16(fw[ks], *(const LAS bf16x8*)(ap + ks * 32), aw, 0, 0, 0);
                                               aa = __builtin_amdgcn_mfma_f32_16x16x32_bf16(fa[ks], *(const LAS bf16x8*)(ap + 64 + ks * 32), aa, 0, 0, 0); }
#pragma unroll
              for (int ks = 0; ks < 5; ++ks) ag = __builtin_amdgcn_mfma_f32_16x16x32_bf16(fg[ks], *(const LAS bf16x8*)(ap + 128 + ks * 32), ag, 0, 0, 0);
              if (l == 1) av = __builtin_amdgcn_mfma_f32_16x16x32_bf16(fv, *(const LAS bf16x8*)(ap + 288), av, 0, 0, 0);
              f32x4 r, kr, vr;
              { const v2u* C = zc[mi]; const v2u* P = zp[mi];
                r[0] = lerp_bf(C[0].x, P[0].x, mxr[0], false); r[1] = lerp_bf(C[0].x, P[0].x, mxr[1], true); r[2] = lerp_bf(C[0].y, P[0].y, mxr[2], false); r[3] = lerp_bf(C[0].y, P[0].y, mxr[3], true);
                kr[0] = lerp_bf(C[1].x, P[1].x, mxk[0], false); kr[1] = lerp_bf(C[1].x, P[1].x, mxk[1], true); kr[2] = lerp_bf(C[1].y, P[1].y, mxk[2], false); kr[3] = lerp_bf(C[1].y, P[1].y, mxk[3], true);
                vr[0] = lerp_bf(C[2].x, P[2].x, mxv[0], false); vr[1] = lerp_bf(C[2].x, P[2].x, mxv[1], true); vr[2] = lerp_bf(C[2].y, P[2].y, mxv[2], false); vr[3] = lerp_bf(C[2].y, P[2].y, mxv[3], true); }
              const size_t o = (size_t)tok * 1024 + ch;
              const f32x4 vf = vfv[mi];
              const float invn = invv[mi];
              f32x4 dec, vv; float rkp = 0.f;
#pragma unroll
              for (int e = 0; e < 4; ++e) {
                  const float xw = -(w0[e] + aw[e]);
                  const float sp = fmaxf(xw, 0.f) + __logf(1.f + __expf(-fabsf(xw)));
                  dec[e] = __expf(-__expf(-sp - 0.5f));
                  const float a = sigmoidf_(a0[e] + aa[e]);
                  vv[e] = (l == 1) ? (vr[e] + (vf[e] - vr[e]) * sigmoidf_(v0c[e] + av[e])) : vr[e];
                  kn[mi][e] = kr[e] * kkc[e] * invn;
                  k2r[mi][e] = kr[e] * (1.f + (a - 1.f) * kac[e]);
                  bbr[mi][e] = kn[mi][e] * a;
                  rkp += r[e] * k2r[mi][e] * rkc[e];
              }
              rr[mi] = r;
              dcv[mi] = dec;
#pragma unroll
              for (int e = 0; e < 4; ++e) { VT[(chl + e) * CS + t] = (bf16)f2bf(vv[e]); GT[(chl + e) * CS + t] = (bf16)f2bf(ag[e]); }
              if (l == 0) { v2u vb_; vb_.x = pk2(vr[0], vr[1]); vb_.y = pk2(vr[2], vr[3]); *(GAS v2u*)(VF + o) = vb_; }
              rkp += __shfl_xor(rkp, 16); rkp += __shfl_xor(rkp, 32);
              if (q == 0) RKS[rt * 64 + t] = rkp;
          } }
        f32x4 G[2];
        { const int rt = w & 3, chl = 16 * rt + 4 * q;
          LAS float* TOT = SEG; LAS float* G63 = SEG + 64;
#pragma unroll
          for (int mi = 0; mi < 2; ++mi)
#pragma unroll
              for (int e = 0; e < 4; ++e) G[mi][e] = scan16_mul(dcv[mi][e]);
#pragma unroll
          for (int e = 0; e < 4; ++e) G[1][e] *= __shfl(G[0][e], (lane & 48) | 15);
          if (w < 4 && c16 == 15) *(LAS f32x4*)(TOT + chl) = G[1];
          __syncthreads();
          if (w >= 4) { const f32x4 tq = *(const LAS f32x4*)(TOT + chl); G[0] *= tq; G[1] *= tq; if (c16 == 15) *(LAS f32x4*)(G63 + chl) = G[1]; }
#pragma unroll
          for (int mi = 0; mi < 2; ++mi) { const int t = 16 * (2 * (w >> 2) + mi) + c16;
              const f32x4 g4 = G[mi];
              f32x4 ig; ig[0] = rcpf_(g4[0]); ig[1] = rcpf_(g4[1]); ig[2] = rcpf_(g4[2]); ig[3] = rcpf_(g4[3]);
              f32x4 gp4; gp4[0] = g4[0] * rcpf_(dcv[mi][0]); gp4[1] = g4[1] * rcpf_(dcv[mi][1]); gp4[2] = g4[2] * rcpf_(dcv[mi][2]); gp4[3] = g4[3] * rcpf_(dcv[mi][3]);
              const f32x4 at = kn[mi] * gp4, bt = bbr[mi] * ig, kt = k2r[mi] * ig, rt_ = rr[mi] * g4;
              *(LAS s16x4_t*)(At + t * CS + chl) = pk4(at[0], at[1], at[2], at[3]); *(LAS s16x4_t*)(Rt + t * CS + chl) = pk4(rt_[0], rt_[1], rt_[2], rt_[3]);
              *(LAS s16x4_t*)(Bt + t * CS + chl) = pk4(bt[0], bt[1], bt[2], bt[3]); *(LAS s16x4_t*)(Kt + t * CS + chl) = pk4(kt[0], kt[1], kt[2], kt[3]);
#pragma unroll
              for (int e = 0; e < 4; ++e) { BT[(chl + e) * CS + t] = (bf16)f2bf(bt[e]); KT[(chl + e) * CS + t] = (bf16)f2bf(kt[e]); } }
          if (F.tid < 64) ((float*)(F.ws + WS_RK))[(size_t)u * 64 + F.tid] = (RKS[F.tid] + RKS[64 + F.tid]) + (RKS[128 + F.tid] + RKS[192 + F.tid]); }
        __syncthreads();
        { const int tt = w & 3; const LAS bf16* Arow = ((w < 4) ? At : Rt) + (16 * tt + c16) * CS + 4 * q;
          s16x4_t af[4];
#pragma unroll
          for (int ks = 0; ks < 4; ++ks) af[ks] = lds4(Arow + 16 * ks);
          for (int jt = 0; jt <= tt; ++jt) {
#pragma unroll
              for (int which = 0; which < 2; ++which) {
                  const LAS bf16* Brow = (which ? Kt : Bt) + (16 * jt + c16) * CS + 4 * q;
                  f32x4 acc = (f32x4){0.f, 0.f, 0.f, 0.f};
#pragma unroll
                  for (int ks = 0; ks < 4; ++ks) acc = mfma16(af[ks], lds4(Brow + 16 * ks), acc);
                  LAS bf16* dst = (w < 4) ? (which ? Lak : NLab) : (which ? Mrk : Mrb);
#pragma unroll
                  for (int e = 0; e < 4; ++e) { const int t = 16 * tt + 4 * q + e, j = 16 * jt + c16;
                      const bool keep = (w < 4) ? (j < t) : (j <= t); float v = keep ? acc[e] : 0.f;
                      if (w < 4 && which == 0) { if (jt == tt) Ld[(tt * 16 + c16) * 16 + 4 * q + e] = v; v = -v; }
                      dst[t * CS + j] = (bf16)f2bf(v); } } } }
        __syncthreads();
        if (w == 0) { float s[16]; const LAS float* Lb = Ld + q * 256;
#pragma unroll
            for (int i = 0; i < 16; ++i) s[i] = (i == c16) ? 1.f : 0.f;
#pragma unroll
            for (int j = 0; j < 16; ++j) { const float Tj = s[j]; Tbb[(q * 16 + j) * 16 + c16] = (bf16)f2bf(Tj);
#pragma unroll
                for (int ci = (j + 1) / 4; ci < 4; ++ci) { const f32x4 lc = *(const LAS f32x4*)(Lb + j * 16 + 4 * ci);
#pragma unroll
                    for (int e = 0; e < 4; ++e) if (4 * ci + e > j) s[4 * ci + e] -= lc[e] * Tj; } } }
        f32x4 X[4]; s16x4_t vB[4]; f32x4 qv[4], yv[4];
        if (w < 4) {
#pragma unroll
            for (int bb = 0; bb < 4; ++bb)
#pragma unroll
                for (int e = 0; e < 4; ++e) X[bb][e] = bflo((unsigned)At[(16 * bb + 4 * q + e) * CS + 16 * w + c16]);
#pragma unroll
            for (int bb = 0; bb < 4; ++bb) { vB[bb] = (s16x4_t){0, 0, 0, 0}; qv[bb] = (f32x4){0.f, 0.f, 0.f, 0.f}; yv[bb] = qv[bb]; }
        } else {
#pragma unroll
            for (int bb = 0; bb < 4; ++bb) vB[bb] = lds4(VT + (16 * (w - 4) + c16) * CS + 16 * bb + 4 * q);
#pragma unroll
            for (int bb = 0; bb < 4; ++bb) { f32x4 acc = (f32x4){0.f, 0.f, 0.f, 0.f};
#pragma unroll
                for (int jb = 0; jb <= bb; ++jb) acc = mfma16(lds4(Lak + (16 * bb + c16) * CS + 16 * jb + 4 * q), vB[jb], acc);
                X[bb] = acc; }
#pragma unroll
            for (int ct = 0; ct < 4; ++ct) { f32x4 acc = (f32x4){0.f, 0.f, 0.f, 0.f};
#pragma unroll
                for (int bb = 0; bb < 4; ++bb) acc = mfma16(lds4(KT + (16 * ct + c16) * CS + 16 * bb + 4 * q), vB[bb], acc);
                qv[ct] = acc; }
#pragma unroll
            for (int tt = 0; tt < 4; ++tt) { f32x4 acc = (f32x4){0.f, 0.f, 0.f, 0.f};
#pragma unroll
                for (int bb = 0; bb <= tt; ++bb) acc = mfma16(lds4(Mrk + (16 * tt + c16) * CS + 16 * bb + 4 * q), vB[bb], acc);
                yv[tt] = acc; }
            { const int vt = w - 4; v4u* VGF = (v4u*)(F.ws + WS_VGF) + ((size_t)u * 16 + vt * 4) * 64 + lane;
#pragma unroll
              for (int tt = 0; tt < 4; ++tt) { const v2u vv2 = __builtin_bit_cast(v2u, vB[tt]); const v2u gg2 = *(const LAS v2u*)(GT + (16 * vt + c16) * CS + 16 * tt + 4 * q);
                  v4u o; o.x = vv2.x; o.y = vv2.y; o.z = gg2.x; o.w = gg2.y; __builtin_nontemporal_store(o, VGF + tt * 64); } }
        }
        __syncthreads();
        s16x4_t XB[4];
#pragma unroll
        for (int bb = 0; bb < 4; ++bb) {
            f32x4 r = X[bb];
#pragma unroll
            for (int jb = 0; jb < bb; ++jb) r = mfma16(lds4(NLab + (16 * bb + c16) * CS + 16 * jb + 4 * q), pk4(X[jb][0], X[jb][1], X[jb][2], X[jb][3]), r);
            const f32x4 z = (f32x4){0.f, 0.f, 0.f, 0.f};
            X[bb] = mfma16(lds4(Tbb + (bb * 16 + c16) * 16 + 4 * q), pk4(r[0], r[1], r[2], r[3]), z);
        }
#pragma unroll
        for (int bb = 0; bb < 4; ++bb) XB[bb] = pk4(-X[bb][0], -X[bb][1], -X[bb][2], -X[bb][3]);
        if (w < 4) {
            s16x4_t* PF = (s16x4_t*)(F.ws + WS_PF) + ((size_t)u * 16 + w * 4) * 64 + lane;
#pragma unroll
            for (int ct = 0; ct < 4; ++ct) { f32x4 acc = (f32x4){0.f, 0.f, 0.f, 0.f};
#pragma unroll
                for (int bb = 0; bb < 4; ++bb) acc = mfma16(XB[bb], lds4(BT + (16 * ct + c16) * CS + 16 * bb + 4 * q), acc);
                const float g63 = SEG[64 + 16 * ct + c16];
#pragma unroll
                for (int e = 0; e < 4; ++e) acc[e] = (acc[e] + ((ct == w && 4 * q + e == c16) ? 1.f : 0.f)) * g63;
                __builtin_nontemporal_store(pk4(acc[0], acc[1], acc[2], acc[3]), PF + ct * 64); }
            s16x4_t* RWF = (s16x4_t*)(F.ws + WS_RWF) + ((size_t)u * 16 + w) * 64 + lane;
#pragma unroll
            for (int tt = 0; tt < 4; ++tt) { const v2u rr = *(const LAS v2u*)(Rt + (16 * tt + c16) * CS + 16 * w + 4 * q);
                f32x4 acc; acc[0] = bflo(rr.x); acc[1] = bfhi(rr.x); acc[2] = bflo(rr.y); acc[3] = bfhi(rr.y);
#pragma unroll
                for (int bb = 0; bb <= tt; ++bb) acc = mfma16(XB[bb], lds4(Mrb + (16 * tt + c16) * CS + 16 * bb + 4 * q), acc);
                __builtin_nontemporal_store(pk4(acc[0], acc[1], acc[2], acc[3]), RWF + tt * 4 * 64); }
        } else {
            const int vt = w - 4;
            s16x4_t* QF = (s16x4_t*)(F.ws + WS_QF) + ((size_t)u * 16 + vt * 4) * 64 + lane;
#pragma unroll
            for (int ct = 0; ct < 4; ++ct) { f32x4 acc = qv[ct];
#pragma unroll
                for (int bb = 0; bb < 4; ++bb) acc = mfma16(lds4(BT + (16 * ct + c16) * CS + 16 * bb + 4 * q), XB[bb], acc);
                const f32x4 g63 = *(const LAS f32x4*)(SEG + 64 + 16 * ct + 4 * q);
                { const f32x4 qq = acc * g63; __builtin_nontemporal_store(pk4(qq[0], qq[1], qq[2], qq[3]), QF + ct * 64); } }
            s16x4_t* Y0F = (s16x4_t*)(F.ws + WS_Y0F) + ((size_t)u * 16 + vt * 4) * 64 + lane;
#pragma unroll
            for (int tt = 0; tt < 4; ++tt) { f32x4 acc = yv[tt];
#pragma unroll
                for (int bb = 0; bb <= tt; ++bb) acc = mfma16(lds4(Mrb + (16 * tt + c16) * CS + 16 * bb + 4 * q), XB[bb], acc);
                __builtin_nontemporal_store(pk4(acc[0], acc[1], acc[2], acc[3]), Y0F + tt * 64); }
        }
        __syncthreads();
    }
}

__device__ __forceinline__ void scanB_phase(const Frame& F) {
    const int task = F.vcu >> 1;
    if (F.wave != 0 || (F.vcu & 1) || task >= 128) return;
    const int lane = F.lane, bh = task >> 2, vt = task & 3;
    const s16x4_t* PF = (const s16x4_t*)(F.ws + WS_PF) + (size_t)bh * 64 * 16 * 64 + lane;
    const s16x4_t* QF = (const s16x4_t*)(F.ws + WS_QF) + ((size_t)bh * 64 * 16 + vt * 4) * 64 + lane;
    s16x4_t* S0F = (s16x4_t*)(F.ws + WS_S0F) + ((size_t)bh * 64 * 16 + vt * 4) * 64 + lane;
    f32x4 S[4];
#pragma unroll
    for (int i = 0; i < 4; ++i) S[i] = (f32x4){0.f, 0.f, 0.f, 0.f};
    s16x4_t P0[16], P1[16], P2[16]; s16x4_t Q0[4], Q1[4], Q2[4];
#define SB_LOAD(P, Q, C) do { _Pragma("unroll") for (int i = 0; i < 16; ++i) P[i] = __builtin_nontemporal_load(PF + ((size_t)(C) * 16 + i) * 64); _Pragma("unroll") for (int i = 0; i < 4; ++i) Q[i] = __builtin_nontemporal_load(QF + ((size_t)(C) * 16 + i) * 64); } while (0)
#define SB_STEP(P, Q, C) do { s16x4_t Sb[4]; \
        _Pragma("unroll") for (int i = 0; i < 4; ++i) { Sb[i] = pk4(S[i][0], S[i][1], S[i][2], S[i][3]); __builtin_nontemporal_store(Sb[i], S0F + ((size_t)(C) * 16 + i) * 64); } \
        _Pragma("unroll") for (int ct = 0; ct < 4; ++ct) { const v2u qb_ = __builtin_bit_cast(v2u, Q[ct]); f32x4 acc; acc[0] = bflo(qb_.x); acc[1] = bfhi(qb_.x); acc[2] = bflo(qb_.y); acc[3] = bfhi(qb_.y); \
            _Pragma("unroll") for (int kb = 0; kb < 4; ++kb) acc = mfma16(P[kb * 4 + ct], Sb[kb], acc); \
            S[ct] = acc; } } while (0)
    SB_LOAD(P0, Q0, 0); SB_LOAD(P1, Q1, 1); SB_LOAD(P2, Q2, 2);
#pragma unroll 1
    for (int c = 0; c < 63; c += 3) {
        SB_STEP(P0, Q0, c);     SB_LOAD(P0, Q0, c + 3);
        SB_STEP(P1, Q1, c + 1); if (c + 4 < 64) SB_LOAD(P1, Q1, c + 4);
        SB_STEP(P2, Q2, c + 2); if (c + 5 < 64) SB_LOAD(P2, Q2, c + 5);
    }
    SB_STEP(P0, Q0, 63);
#undef SB_LOAD
#undef SB_STEP
}

__device__ __forceinline__ void scanC_phase(const Frame& F, const In& I, int l) {
    bf16* YB = (bf16*)(F.ws + WS_AY) + 1024;
    const int gw = F.vcu * NWAVES + F.wave, NGW = F.G * NWAVES, lane = F.lane, c16 = lane & 15, q = lane >> 4;
    for (int it = 0; it * NGW < 2048; ++it) { const int u = (CHUNK_LOCAL && F.G == 256) ? chunk_unit(F.vcu, F.wave, F.G) : gw + it * NGW; if (u >= 2048) break;
        const int c = u & 63, H = (u >> 6) & 15, b = u >> 10;
        const s16x4_t* RWF = (const s16x4_t*)(F.ws + WS_RWF) + (size_t)u * 16 * 64 + lane;
        const s16x4_t* S0F = (const s16x4_t*)(F.ws + WS_S0F) + (size_t)u * 16 * 64 + lane;
        const s16x4_t* Y0F = (const s16x4_t*)(F.ws + WS_Y0F) + (size_t)u * 16 * 64 + lane;
        const v4u* VGF = (const v4u*)(F.ws + WS_VGF) + (size_t)u * 16 * 64 + lane;
        const float* RK = (const float*)(F.ws + WS_RK) + (size_t)u * 64;
        s16x4_t rw[16], s0[16];
#pragma unroll
        for (int i = 0; i < 16; ++i) { rw[i] = __builtin_nontemporal_load(RWF + i * 64); s0[i] = __builtin_nontemporal_load(S0F + i * 64); }
        float lnw[4], lnb[4];
#pragma unroll
        for (int vt = 0; vt < 4; ++vt) { lnw[vt] = I.ln_w[l * 1024 + H * 64 + 16 * vt + c16]; lnb[vt] = I.ln_b[l * 1024 + H * 64 + 16 * vt + c16]; }
        bf16* yb = YB + ((size_t)(b * SEQ + c * 64)) * 2048 + H * 64;
        s16x4_t yn[4]; v4u vgn[4]; f32x4 rkn;
#pragma unroll
        for (int vt = 0; vt < 4; ++vt) { yn[vt] = __builtin_nontemporal_load(Y0F + (vt * 4) * 64); vgn[vt] = __builtin_nontemporal_load(VGF + (vt * 4) * 64); }
        rkn = *(const GAS f32x4*)(RK + 4 * q);
#pragma unroll
        for (int tt = 0; tt < 4; ++tt) {
            f32x4 y[4]; v4u vg[4]; const f32x4 rk4 = rkn;
#pragma unroll
            for (int vt = 0; vt < 4; ++vt) { const v2u yb_ = __builtin_bit_cast(v2u, yn[vt]); y[vt][0] = bflo(yb_.x); y[vt][1] = bfhi(yb_.x); y[vt][2] = bflo(yb_.y); y[vt][3] = bfhi(yb_.y); vg[vt] = vgn[vt]; }
            if (tt < 3) {
#pragma unroll
                for (int vt = 0; vt < 4; ++vt) { yn[vt] = __builtin_nontemporal_load(Y0F + (vt * 4 + tt + 1) * 64); vgn[vt] = __builtin_nontemporal_load(VGF + (vt * 4 + tt + 1) * 64); }
                rkn = *(const GAS f32x4*)(RK + 16 * (tt + 1) + 4 * q); }
            __builtin_amdgcn_sched_barrier(0);
#pragma unroll
            for (int vt = 0; vt < 4; ++vt) { f32x4 acc = y[vt];
#pragma unroll
                for (int kb = 0; kb < 4; ++kb) acc = mfma16(rw[tt * 4 + kb], s0[vt * 4 + kb], acc);
                y[vt] = acc; }
#pragma unroll
            for (int e = 0; e < 4; ++e) {
                float s = (y[0][e] + y[1][e]) + (y[2][e] + y[3][e]); s = red16(s); const float mu = s * (1.f / 64.f);
                const float d0 = y[0][e] - mu, d1 = y[1][e] - mu, d2 = y[2][e] - mu, d3 = y[3][e] - mu;
                float s2 = (d0 * d0 + d1 * d1) + (d2 * d2 + d3 * d3); s2 = red16(s2);
                const float rs = __builtin_amdgcn_rsqf(s2 * (1.f / 64.f) + GN_EPS);
                y[0][e] = d0 * rs; y[1][e] = d1 * rs; y[2][e] = d2 * rs; y[3][e] = d3 * rs; }
#pragma unroll
            for (int vt = 0; vt < 4; ++vt) { const unsigned vw[2] = {vg[vt].x, vg[vt].y}, gw_[2] = {vg[vt].z, vg[vt].w};
#pragma unroll
                for (int e = 0; e < 4; ++e) { const float vv = (e & 1) ? bfhi(vw[e >> 1]) : bflo(vw[e >> 1]), gg = (e & 1) ? bfhi(gw_[e >> 1]) : bflo(gw_[e >> 1]);
                    const float o = (y[vt][e] * lnw[vt] + lnb[vt] + rk4[e] * vv) * gg;
                    if (F8_MRG) ((GAS unsigned char*)(F.ws + WS_AY))[1024 + ((size_t)(b * SEQ + c * 64) + 16 * tt + 4 * q + e) * 2048 + H * 64 + 16 * vt + c16] = (unsigned char)__builtin_amdgcn_cvt_pk_fp8_f32(16.f * o, 0.f, 0, false);
                    else yb[(size_t)(16 * tt + 4 * q + e) * 2048 + 16 * vt + c16] = (bf16)f2bf(o); } }
        }
    }
}

__device__ __forceinline__ void router_phase(const Frame& F, const In& I, int l, const bf16* X, int cslot = -1, size_t rt_off = 0) {
    const bf16* lw = (const bf16*)(F.ws + WS_LORA); float* RS = (float*)(F.ws + WS_RSTD);
    if (cslot < 0) cslot = l;
    int* ST = (int*)(F.ws + WS_SLOT_TOK + rt_off) + (size_t)l * NEXP * ECAP; float* SW = (float*)(F.ws + WS_SLOT_W + rt_off) + (size_t)l * NEXP * ECAP;
    LAS float* ssq = (LAS float*)(F.lds); LAS float* part = (LAS float*)(F.lds + 1024); LAS float* logit = (LAS float*)(F.lds + 1024 + 49152);
    LAS int* lcnt = (LAS int*)(F.lds + 1024 + 49152 + 6144); LAS int* lbase = lcnt + 32; LAS int* tsel = lbase + 32; LAS float* twt = (LAS float*)(tsel + 128);
    const int lane = F.lane, tl = lane & 15, q4 = lane >> 4;
    for (int u = F.vcu; u < NTOK / 32; u += F.G) {
        const int tok0 = 32 * u;
        if (F.tid < 32) lcnt[F.tid] = 0;
        { f32x4 acc[2][3]; float ss[2] = {0.f, 0.f};
#pragma unroll
          for (int mt = 0; mt < 2; ++mt)
#pragma unroll
              for (int nt = 0; nt < 3; ++nt) acc[mt][nt] = (f32x4){0.f, 0.f, 0.f, 0.f};
#pragma unroll 4
          for (int ks = 0; ks < 8; ++ks) { const int k = 256 * F.wave + 32 * ks + 8 * q4;
              bf16x8 ah[2];
#pragma unroll
              for (int mt = 0; mt < 2; ++mt) { const v4u xb = *(const GAS v4u*)(X + (size_t)(tok0 + 16 * mt + tl) * DM + k); ah[mt] = __builtin_bit_cast(bf16x8, xb);
                  const float a0 = bflo(xb.x), a1 = bfhi(xb.x), a2 = bflo(xb.y), a3 = bfhi(xb.y), a4 = bflo(xb.z), a5 = bfhi(xb.z), a6 = bflo(xb.w), a7 = bfhi(xb.w);
                  ss[mt] += ((a0 * a0 + a1 * a1) + (a2 * a2 + a3 * a3)) + ((a4 * a4 + a5 * a5) + (a6 * a6 + a7 * a7)); }
#pragma unroll
              for (int nt = 0; nt < 3; ++nt) { const size_t wo = (size_t)(16 * nt + tl) * 2048 + k;
                  const bf16x8 bh = *(const GAS bf16x8*)(lw + LO_RH + wo), bl = *(const GAS bf16x8*)(lw + LO_RL + wo);
#pragma unroll
                  for (int mt = 0; mt < 2; ++mt) { acc[mt][nt] = __builtin_amdgcn_mfma_f32_16x16x32_bf16(ah[mt], bh, acc[mt][nt], 0, 0, 0);
                      acc[mt][nt] = __builtin_amdgcn_mfma_f32_16x16x32_bf16(ah[mt], bl, acc[mt][nt], 0, 0, 0); } } }
#pragma unroll
          for (int mt = 0; mt < 2; ++mt) { ss[mt] += __shfl_xor(ss[mt], 16); ss[mt] += __shfl_xor(ss[mt], 32); if (q4 == 0) ssq[F.wave * 32 + 16 * mt + tl] = ss[mt]; }
#pragma unroll
          for (int mt = 0; mt < 2; ++mt)
#pragma unroll
              for (int nt = 0; nt < 3; ++nt)
#pragma unroll
                  for (int e = 0; e < 4; ++e) part[(F.wave * 32 + 16 * mt + 4 * q4 + e) * 48 + 16 * nt + tl] = acc[mt][nt][e]; }
        __syncthreads();
        for (int idx = F.tid; idx < 32 * 36; idx += NTHR) { const int t = idx / 36, c = idx - t * 36; float s = 0.f, q = 0.f;
#pragma unroll
            for (int w = 0; w < 8; ++w) { s += part[(w * 32 + t) * 48 + c]; q += ssq[w * 32 + t]; }
            const float rstd = __builtin_amdgcn_rsqf(q * (1.f / DM) + NORM_EPS);
            if (c == 0) RS[tok0 + t] = rstd;
            s = s * rstd + ((c < 32) ? I.re_b[l * 32 + c] : I.rg_b[l * 4 + (c - 32)]); logit[t * 48 + c] = s; }
        __syncthreads();
        if (F.tid < 32) { const int t = F.tid; const LAS float* lg = logit + t * 48;
            int gs = 0; float gm = lg[32];
#pragma unroll
            for (int j = 1; j < 4; ++j) if (lg[32 + j] > gm) { gm = lg[32 + j]; gs = j; }
            float den = 0.f;
#pragma unroll
            for (int j = 0; j < 4; ++j) den += __expf(lg[32 + j] - gm);
            const float gp = 1.f / den;
            int i1 = 0; float v1 = lg[gs * 8];
#pragma unroll
            for (int j = 1; j < 8; ++j) if (lg[gs * 8 + j] > v1) { v1 = lg[gs * 8 + j]; i1 = j; }
            int i2 = -1; float v2 = -3.0e38f;
#pragma unroll
            for (int j = 0; j < 8; ++j) if (j != i1 && lg[gs * 8 + j] > v2) { v2 = lg[gs * 8 + j]; i2 = j; }
            const float e2 = __expf(v2 - v1); const float wa = gp / (1.f + e2), wb = gp * e2 / (1.f + e2);
            const int ea = gs * 8 + i1, eb = gs * 8 + i2;
            tsel[t * 4 + 0] = ea; tsel[t * 4 + 1] = eb; tsel[t * 4 + 2] = atomicAdd((int*)(lcnt + ea), 1); tsel[t * 4 + 3] = atomicAdd((int*)(lcnt + eb), 1);
            twt[t * 2] = wa; twt[t * 2 + 1] = wb; }
        __syncthreads();
        if (F.tid < 32) lbase[F.tid] = (int)atomicAdd(F.ctl + CW_CNT + 64 * cslot + F.tid, (unsigned)lcnt[F.tid]);
        __syncthreads();
        if (F.tid < 64) { const int t = F.tid >> 1, k = F.tid & 1; const int e = tsel[t * 4 + k]; const int i = (tok0 + t) * 2 + k;
            const int slot = e * ECAP + lbase[e] + tsel[t * 4 + 2 + k]; ST[slot] = i; SW[slot] = twt[t * 2 + k]; }
        __syncthreads();
    }
}

__device__ __forceinline__ void moe_tables(const Frame& F, int l) {
    LAS int* panel_e = (LAS int*)(F.lds + LDS_PANEL); LAS int* panel_sb = (LAS int*)(F.lds + LDS_PSB); LAS int* tab = (LAS int*)(F.lds + LDS_TAB);
    if (F.tid < 32) tab[F.tid] = (int)__hip_atomic_load(F.ctl + CW_CNT + 64 * l + F.tid, __ATOMIC_RELAXED, __HIP_MEMORY_SCOPE_AGENT);
    __syncthreads();
    if (F.tid == 0) { int pp = 0;
        for (int e = 0; e < 32; ++e) { const int np = (tab[e] + 255) >> 8; for (int j = 0; j < np; ++j) { panel_e[pp + j] = e; panel_sb[pp + j] = e * ECAP + 256 * j; } pp += np; }
        tab[65] = pp; }
    __syncthreads();
}
__device__ __forceinline__ void combine_phase(const Frame& F, const In& I, int l, const bf16* X, float* out, bool dummy = false) {
    const bf16* MO = (const bf16*)(F.ws + WS_MOEOUT); bf16* XC = (bf16*)(F.ws + (dummy ? WS_TMP : WS_X)); bf16* Hn = (bf16*)(F.ws + (dummy ? WS_ATTN : WS_H));
    const int gw = F.vcu * NWAVES + F.wave, NGW = F.G * NWAVES, lane = F.lane;
    const float* w = (l == 0) ? (I.attn_norm_w + DM) : I.final_w;
    for (int rp_ = 0; rp_ * 2 * NGW < NTOK; ++rp_) {
        f32x4 v[2][8]; float s[2] = {0.f, 0.f};
#pragma unroll
        for (int r = 0; r < 2; ++r) { const int m = row_of(gw, 2 * rp_ + r, NGW); if (m < NTOK) {
            const GAS v2u* xr = (const GAS v2u*)(X + (size_t)m * DM) + lane; const GAS v2u* m0 = (const GAS v2u*)(MO + (size_t)m * DM) + lane; const GAS v2u* m1 = (const GAS v2u*)(MO + ((size_t)NTOK + m) * DM) + lane;
#pragma unroll
            for (int j = 0; j < 8; ++j) { const v2u a = __builtin_nontemporal_load(m0 + 64 * j), b = __builtin_nontemporal_load(m1 + 64 * j); { const v2u xb = xr[64 * j]; v[r][j].x = bflo(xb.x); v[r][j].y = bfhi(xb.x); v[r][j].z = bflo(xb.y); v[r][j].w = bfhi(xb.y); }
                v[r][j].x += bflo(a.x) + bflo(b.x); v[r][j].y += bfhi(a.x) + bfhi(b.x); v[r][j].z += bflo(a.y) + bflo(b.y); v[r][j].w += bfhi(a.y) + bfhi(b.y);
                s[r] += (v[r][j].x * v[r][j].x + v[r][j].y * v[r][j].y) + (v[r][j].z * v[r][j].z + v[r][j].w * v[r][j].w); } } }
#pragma unroll
        for (int r = 0; r < 2; ++r) { const int m = row_of(gw, 2 * rp_ + r, NGW); if (m < NTOK) {
            const GAS f32x4* wr = (const GAS f32x4*)w + lane;
            const float rstd = __builtin_amdgcn_rsqf(wave_sum(s[r]) * (1.f / DM) + NORM_EPS);
            if (l == 0) { GAS v2u* xo = (GAS v2u*)(XC + (size_t)m * DM) + lane; GAS v2u* o8 = (GAS v2u*)(Hn + (size_t)m * DM) + lane; GAS unsigned* o4 = (GAS unsigned*)((GAS unsigned char*)Hn + (size_t)m * DM) + lane;
                float qs = 0.f;
                if (F8_IN == 2) { float mx = 0.f;
#pragma unroll
                    for (int j = 0; j < 8; ++j) { const f32x4 hh = v[r][j] * rstd * wr[64 * j]; mx = fmaxf(mx, fmaxf(fmaxf(fabsf(hh.x), fabsf(hh.y)), fmaxf(fabsf(hh.z), fabsf(hh.w)))); }
                    mx = fmaxf(wave_max(mx), 1e-20f); qs = 127.f / mx; if (lane == 0) ((float*)(F.ws + WS_ASC))[m] = mx * (1.f / (127.f * IN_WS)); }
#pragma unroll
                for (int j = 0; j < 8; ++j) { { v2u xq; xq.x = pk2(v[r][j].x, v[r][j].y); xq.y = pk2(v[r][j].z, v[r][j].w); xo[64 * j] = xq; } const f32x4 ww = wr[64 * j];
                    if (F8_IN == 2) { o4[64 * j] = pack_i8x4(v[r][j].x * rstd * ww.x * qs, v[r][j].y * rstd * ww.y * qs, v[r][j].z * rstd * ww.z * qs, v[r][j].w * rstd * ww.w * qs); continue; }
                    if (F8_GATE) { int p = 0; p = __builtin_amdgcn_cvt_pk_fp8_f32(v[r][j].x * rstd * ww.x, v[r][j].y * rstd * ww.y, p, false); p = __builtin_amdgcn_cvt_pk_fp8_f32(v[r][j].z * rstd * ww.z, v[r][j].w * rstd * ww.w, p, true); ((GAS unsigned*)(F.ws + WS_H8 + (size_t)m * DM) + lane)[64 * j] = (unsigned)p; }
                    if (F8_IN) { int p = 0; p = __builtin_amdgcn_cvt_pk_fp8_f32(v[r][j].x * rstd * ww.x, v[r][j].y * rstd * ww.y, p, false); p = __builtin_amdgcn_cvt_pk_fp8_f32(v[r][j].z * rstd * ww.z, v[r][j].w * rstd * ww.w, p, true); o4[64 * j] = (unsigned)p; }
                    else { v2u o; o.x = pk2(v[r][j].x * rstd * ww.x, v[r][j].y * rstd * ww.y); o.y = pk2(v[r][j].z * rstd * ww.z, v[r][j].w * rstd * ww.w); o8[64 * j] = o; } } }
            else { GAS f32x4* oo = (GAS f32x4*)(out + (size_t)m * DM) + lane;
#pragma unroll
                for (int j = 0; j < 8; ++j) __builtin_nontemporal_store(v[r][j] * rstd * wr[64 * j], oo + 64 * j); } } }
    }
}

#ifndef MERGE_WGM
#define MERGE_WGM 8
#endif
#ifndef GEMMIN_WGM
#define GEMMIN_WGM 8
#endif
#ifndef DOWN_ALIGN
#define DOWN_ALIGN true
#endif
#ifndef CV_T1
#define CV_T1 4608
#endif
#ifndef GEMMIN_SP2
#define GEMMIN_SP2 true
#endif
#ifndef GEMMIN_ALIGN
#define GEMMIN_ALIGN true
#endif
#ifndef PROBE_MASK
#define PROBE_MASK 0
#endif
#ifndef CUT
#define CUT 0
#endif
__device__ __forceinline__ void finalize_phase(const Frame& F, const In& I, const bf16* X, float* out) {
    const int gw = F.vcu * NWAVES + F.wave, NGW = F.G * NWAVES, lane = F.lane;
    for (int m = gw; m < NTOK; m += NGW) {
        const GAS v2u* xr = (const GAS v2u*)(X + (size_t)m * DM) + lane; const GAS f32x4* wr = (const GAS f32x4*)I.final_w + lane;
        f32x4 v[8]; float s = 0.f;
#pragma unroll
        for (int j = 0; j < 8; ++j) { const v2u xb = xr[64 * j]; v[j].x = bflo(xb.x); v[j].y = bfhi(xb.x); v[j].z = bflo(xb.y); v[j].w = bfhi(xb.y); s += (v[j].x * v[j].x + v[j].y * v[j].y) + (v[j].z * v[j].z + v[j].w * v[j].w); }
        const float rstd = __builtin_amdgcn_rsqf(wave_sum(s) * (1.f / DM) + NORM_EPS);
        GAS f32x4* oo = (GAS f32x4*)(out + (size_t)m * DM) + lane;
#pragma unroll
        for (int j = 0; j < 8; ++j) oo[64 * j] = v[j] * rstd * wr[64 * j];
    }
}
struct Args { const float* in[31]; float* out; unsigned char* ws; int ph_lo, ph_hi; };
#define PHASE_BEGIN if (ph >= lo && ph < hi) { { int t_ = threadIdx.x; asm volatile("" : "+v"(t_)); F.tid = t_; F.lane = t_ & 63; F.wave = __builtin_amdgcn_readfirstlane(t_ >> 6); unsigned char* w_ = args.ws; asm volatile("" : "+s"(w_)); F.ws = w_; F.ctl = (unsigned*)(w_ + WS_CTL); } const In I = load_in(F); \
    bf16* Hb = (bf16*)(F.ws + WS_H); bf16* PROJ = (bf16*)(F.ws + WS_PROJ); bf16* XC = (bf16*)(F.ws + WS_X); (void)Hb; (void)PROJ; (void)XC;
#define PHASE_END(last) if (ph + 1 < hi && !(last)) xcd_barrier(bar); } ++ph;
template <int l> __device__ __forceinline__ bool layer_body(Frame& F, const Args& args, const XcdBarrier& bar, int& ph, const int lo, const int hi) {

#if (PROBE_MASK & 1)
        if (l == 1) { PHASE_BEGIN conv_phase(F, I, 1); PHASE_END(false) }
#endif
#if F8_GATE
        PHASE_BEGIN { { pg8::Gemm g{Hb, (const bf16*)(F.ws + WS_WIN_T), NTOK, C_GATE, DM}; pg8::StaticOrder S; S.init(NTOK, C_GATE, F.G, (int)blockIdx.x, GEMMIN_WGM);
              pg8::EpiStoreBf16 E{PROJ, INP, (unsigned char*)(F.ws + WS_GATE8), 0, nullptr}; pg8::gemm_phase<pg8::EpiStoreBf16, pg8::StaticOrder, GEMMIN_ALIGN, GEMMIN_SP2>(F.lds, g, S, E); }
            { pg8::Gemm g{(const bf16*)(F.ws + WS_H8), (const bf16*)(F.ws + WS_WIN_T + WIN8_OFF), NTOK, INP - C_GATE, DM / 2}; pg8::ListOrder S; S.base.init(NTOK, INP - C_GATE, F.G, 0, GEMMIN_WGM);
              const int bx = (int)blockIdx.x; if (F.G == 256) { S.first = (bx < 128) ? bx : bx; S.stride = 128; S.cnt = (bx < 128) ? 1 : 3; if (bx >= 128) S.first = bx; } else { S.first = bx; S.stride = F.G; S.cnt = 1 << 20; }
              pg8::EpiStoreBf16 E{PROJ, INP, (unsigned char*)(F.ws + WS_GATE8), C_GATE / 256, nullptr}; pg8::gemm_phase<pg8::EpiStoreBf16, pg8::ListOrder, GEMMIN_ALIGN, GEMMIN_SP2, false, 124>(F.lds, g, S, E); }
            { __syncthreads(); const int d = conv_dense_items(l); conv_items(F, I, l, conv_first_items(l, F.G), d + ((F.G == 256) ? CV_B1 : 0), F.vcu, F.G); } } PHASE_END(false)
#else
        PHASE_BEGIN { pg8::Gemm g{Hb, (const bf16*)(F.ws + WS_WIN_T), NTOK, INP, F8_IN ? DM / 2 : DM}; pg8::StaticOrder S; S.init(NTOK, INP, F.G, (int)blockIdx.x, GEMMIN_WGM);
            pg8::EpiStoreBf16 E{PROJ, INP, (unsigned char*)(F.ws + WS_GATE8), 0, (F8_IN == 2) ? (const float*)(F.ws + WS_ASC) : nullptr}; pg8::gemm_phase<pg8::EpiStoreBf16, pg8::StaticOrder, GEMMIN_ALIGN, GEMMIN_SP2, false, (F8_IN == 1 ? 124 : 0), (F8_IN == 2)>(F.lds, g, S, E);
            if (F.G == 256) { const int d = conv_dense_items(l), c0 = conv_first_items(l, F.G), c1 = (F8_IN ? c0 + CV_T1 : d + CV_B1);
                if ((int)blockIdx.x >= 128) conv_items(F, I, l, c0, c1, (int)blockIdx.x - 128, 128);
                if (c1 < d + CV_B1) { __syncthreads(); conv_items(F, I, l, c1, d + CV_B1, F.vcu, F.G); } } } PHASE_END(false)
#endif
#if (PROBE_MASK & 2)
        PHASE_BEGIN { pg8::Gemm g{Hb, (const bf16*)(F.ws + WS_WIN_T), NTOK, INP, DM}; pg8::StaticOrder S; S.init(NTOK, INP, F.G, (int)blockIdx.x, GEMMIN_WGM);
            pg8::EpiStoreBf16 E{PROJ, INP, (unsigned char*)(F.ws + WS_GATE8), 0, nullptr}; pg8::gemm_phase<pg8::EpiStoreBf16, pg8::StaticOrder, true, true>(F.lds, g, S, E); } PHASE_END(false)
#endif
#ifdef UNFUSED_PREP
        PHASE_BEGIN attn_phase(F, I, l); prep_phase(F, I, l); PHASE_END(false)
#else
        PHASE_BEGIN acts_phase(F, I, l); attn_phase(F, I, l); PHASE_END(false)
        PHASE_BEGIN chunk_phase(F, I, l); PHASE_END(false)
#endif
#if (PROBE_MASK & 4)
        PHASE_BEGIN acts_phase(F, I, l); attn_phase(F, I, l); PHASE_END(false)
#endif
#if (PROBE_MASK & 64)
        PHASE_BEGIN attn_phase(F, I, l); PHASE_END(false)
#endif
#ifdef SEQ_SCAN
        PHASE_BEGIN scan_phase(F); PHASE_END(false)
#else
#ifdef UNFUSED_PREP
        PHASE_BEGIN scanA_phase(F, I, l); PHASE_END(false)
#endif
        PHASE_BEGIN scanB_phase(F); if (F.G == 256 && (F.vcu & 1)) { const int d = conv_dense_items(l); conv_items(F, I, l, d + CV_B1, d + CV_B2, F.vcu >> 1, 128); } PHASE_END(false)
        PHASE_BEGIN scanC_phase(F, I, l); PHASE_END(false)
#endif
#if (PROBE_MASK & 512)
        PHASE_BEGIN scanC_phase(F, I, l); PHASE_END(false)
#endif
#if (PROBE_MASK & 128)
        PHASE_BEGIN chunk_phase(F, I, l); PHASE_END(false)
#endif
#if (PROBE_MASK & 256)
        PHASE_BEGIN scanB_phase(F); PHASE_END(false)
#endif
#if defined(SEQ_SCAN)
        PHASE_BEGIN post_phase(F, I, l); PHASE_END(false)
#endif
        PHASE_BEGIN { pg8::Gemm g{(const bf16*)(F.ws + WS_AY), (const bf16*)(F.ws + WS_WA_T), NTOK, DM, F8_MRG ? 512 : 1024, F8_MRG ? DM / 2 : DM}; pg8::MergeOrder S; S.base.init(NTOK, DM, F.G, (int)blockIdx.x, MERGE_WGM);
            pg8::EpiMerge E{(const unsigned char*)(F.ws + WS_GATE8), (const unsigned char*)(F.ws + WS_GATE8) + 2048, 4096, (bf16*)(F.ws + WS_MERGED)}; pg8::gemm_phase<pg8::EpiMerge, pg8::MergeOrder, true, true, false, (F8_MRG ? 122 : 0)>(F.lds, g, S, E); } PHASE_END(false)
#if (PROBE_MASK & 32)
        PHASE_BEGIN { pg8::Gemm g{(const bf16*)(F.ws + WS_AY), (const bf16*)(F.ws + WS_WA_T), NTOK, DM, 1024, DM}; pg8::MergeOrder S; S.base.init(NTOK, DM, F.G, (int)blockIdx.x, MERGE_WGM);
            pg8::EpiMerge E{(const unsigned char*)(F.ws + WS_GATE8), (const unsigned char*)(F.ws + WS_GATE8) + 2048, 4096, (bf16*)(F.ws + WS_MERGED)}; pg8::gemm_phase<pg8::EpiMerge, pg8::MergeOrder, true, true>(F.lds, g, S, E); } PHASE_END(false)
#endif
        PHASE_BEGIN { pg8::Gemm g{(const bf16*)(F.ws + WS_MERGED), (const bf16*)(F.ws + WS_WOUT_T), NTOK, DM, F8_OUT ? DM / 2 : DM}; pg8::StaticOrder S; S.init(NTOK, DM, F.G, (int)blockIdx.x, MERGE_WGM);
            pg8::EpiResid<l == 0> E{I.x, XC, XC, (unsigned char*)(F.ws + WS_H)}; pg8::gemm_phase<pg8::EpiResid<l == 0>, pg8::StaticOrder, true, true, false, (F8_OUT ? 122 : 0)>(F.lds, g, S, E); } PHASE_END(false)
#if (PROBE_MASK & 1024)
        if (l == 0) { PHASE_BEGIN { pg8::Gemm g{(const bf16*)(F.ws + WS_MERGED), (const bf16*)(F.ws + WS_WOUT_T), NTOK, DM, DM}; pg8::StaticOrder S; S.init(NTOK, DM, F.G, (int)blockIdx.x, MERGE_WGM);
            pg8::EpiResid<true> E{I.x, XC, XC, (unsigned char*)(F.ws + WS_H)}; pg8::gemm_phase<pg8::EpiResid<true>, pg8::StaticOrder, true, true>(F.lds, g, S, E); } PHASE_END(false) }
#endif
        if (CUT == 1 + 2 * l) { PHASE_BEGIN finalize_phase(F, I, XC, args.out); PHASE_END(true) return true; }
#if (PROBE_MASK & 4096)
        PHASE_BEGIN router_phase(F, I, l, XC, 2 + l, 8 * MiB); PHASE_END(false)
#endif
        PHASE_BEGIN router_phase(F, I, l, XC); { const int d = conv_dense_items(l); conv_items(F, I, l, (F.G == 256) ? d + CV_B2 : d, d + CV_MOE, F.vcu, F.G); } PHASE_END(false)
#define MOE_UP(FIRST, STRIDE, LIMIT) do { pg8::Gemm g{(const bf16*)(F.ws + (F8_MOE ? WS_H : WS_X)), (const bf16*)(F.ws + WS_WGU_T), MAXSLOT, NEXP * 1024, F8_MOE ? DM / 2 : DM}; \
            pg8::MoeOrder S{(FIRST), (STRIDE), (LIMIT), 4, (const LAS int*)(F.lds + LDS_PANEL), (const LAS int*)(F.lds + LDS_PSB)}; \
            pg8::EpiSwiGlu E{(bf16*)(F.ws + WS_HID), (const int*)(F.ws + WS_SLOT_TOK) + (size_t)l * NEXP * ECAP, (const float*)(F.ws + WS_RSTD)}; pg8::gemm_phase<pg8::EpiSwiGlu, pg8::MoeOrder, true, true, true, (F8_MOE ? 124 : 0)>(F.lds, g, S, E, (const int*)(F.ws + WS_SLOT_TOK) + (size_t)l * NEXP * ECAP); } while (0)
#define MOE_DOWN(FIRST, STRIDE, LIMIT) do { pg8::Gemm g{(const bf16*)(F.ws + WS_HID), (const bf16*)(F.ws + WS_WD_T), MAXSLOT, NEXP * DM, F8_MOE ? EH / 2 : EH}; \
            pg8::MoeOrder S{(FIRST), (STRIDE), (LIMIT), 8, (const LAS int*)(F.lds + LDS_PANEL), (const LAS int*)(F.lds + LDS_PSB)}; \
            pg8::EpiMoeDown E{(bf16*)(F.ws + WS_MOEOUT), (const int*)(F.ws + WS_SLOT_TOK) + (size_t)l * NEXP * ECAP, (const float*)(F.ws + WS_SLOT_W) + (size_t)l * NEXP * ECAP}; \
            pg8::gemm_phase<pg8::EpiMoeDown, pg8::MoeOrder, DOWN_ALIGN, true, false, (F8_MOE ? 123 : 0)>(F.lds, g, S, E); } while (0)
        PHASE_BEGIN { moe_tables(F, l); const int np = ((const LAS int*)(F.lds + LDS_TAB))[65], n_up = np * 4, G = F.G, c = F.vcu;
            MOE_UP(c, G, (n_up < G ? n_up : G)); } PHASE_END(false)
        PHASE_BEGIN { const int np = ((const LAS int*)(F.lds + LDS_TAB))[65], n_up = np * 4, G = F.G, c = F.vcu;
            const int R2 = moe_r2(np, G), n_early = moe_n_early(np, G);
            if (c < R2) MOE_UP(G + c, R2, n_up); else MOE_DOWN(c - R2, G - R2, n_early); } PHASE_END(false)
        PHASE_BEGIN { const int np = ((const LAS int*)(F.lds + LDS_TAB))[65], G = F.G, c = F.vcu;
            const int n_early = moe_n_early(np, G);
            MOE_DOWN(n_early + c, G, np * 8);
            if (l == 0) { const int idle = cv_z_idle(np, G); if (idle > 0 && c >= G - idle) conv_items(F, I, 1, 0, cv_z_items(np, G), c - (G - idle), idle); } } PHASE_END(false)
#if (PROBE_MASK & 16)
        PHASE_BEGIN { moe_tables(F, l); const int np = ((const LAS int*)(F.lds + LDS_TAB))[65], n_up = np * 4, G = F.G, c = F.vcu;
            MOE_UP(c, G, (n_up < G ? n_up : G)); } PHASE_END(false)
        PHASE_BEGIN { const int np = ((const LAS int*)(F.lds + LDS_TAB))[65], n_up = np * 4, G = F.G, c = F.vcu;
            const int R2 = moe_r2(np, G), n_early = moe_n_early(np, G);
            if (c < R2) MOE_UP(G + c, R2, n_up); else MOE_DOWN(c - R2, G - R2, n_early); } PHASE_END(false)
        PHASE_BEGIN { const int np = ((const LAS int*)(F.lds + LDS_TAB))[65], G = F.G, c = F.vcu;
            const int n_early = moe_n_early(np, G);
            MOE_DOWN(n_early + c, G, np * 8);
            if (false) { const int idle = cv_z_idle(np, G); if (idle > 0 && c >= G - idle) conv_items(F, I, 1, 0, cv_z_items(np, G), c - (G - idle), idle); } } PHASE_END(false)
#endif
#undef MOE_UP
#undef MOE_DOWN
#if (PROBE_MASK & 8192)
        PHASE_BEGIN combine_phase(F, I, 0, XC, args.out, true); PHASE_END(false)
#endif
        PHASE_BEGIN combine_phase(F, I, l, XC, args.out); if (l == 0) { __syncthreads(); conv_phase(F, I, 1, cv_z_items(((const LAS int*)(F.lds + LDS_TAB))[65], F.G)); } PHASE_END(l == 1)
        if (CUT == 2 && l == 0) { PHASE_BEGIN finalize_phase(F, I, XC, args.out); PHASE_END(true) return true; }
        return false;
}
__global__ void __launch_bounds__(NTHR, 2) hybrid_fwd(Args args) {
    extern __shared__ __attribute__((aligned(16))) unsigned char lds_raw[];
    Frame F;
    F.lds = (LAS unsigned char*)lds_raw; F.ws = args.ws; F.ctl = (unsigned*)(args.ws + WS_CTL);
    F.tid = threadIdx.x; F.lane = F.tid & 63; F.wave = __builtin_amdgcn_readfirstlane(F.tid >> 6);
    F.G = gridDim.x; { const int bx = blockIdx.x; F.vcu = (F.G % 8 == 0) ? (bx % 8) * (F.G / 8) + bx / 8 : bx; }
    for (int u = F.tid; u < (LDS_BYTES - LDSCTL_OFF) / 4; u += NTHR) ((LAS unsigned*)(F.lds + LDSCTL_OFF))[u] = 0u;
    __syncthreads();
    if (F.tid == 0) {
#pragma unroll
        for (int k = 0; k < 31; ++k) *(LAS unsigned long long*)(F.lds + LDS_PTRS + 8 * k) = (unsigned long long)args.in[k]; }
    __syncthreads();
    XcdBarrier bar = xcd_barrier_post(F.ctl + CW_BAR, (volatile LAS unsigned*)(F.lds + LDSCTL_OFF));
    const int lo = args.ph_lo, hi = args.ph_hi;
    int ph = 0;

    PHASE_BEGIN conv_phase(F, I, 0); norm_phase(F, I.x, I.attn_norm_w, Hb); PHASE_END(false)
#if (PROBE_MASK & 1)
    PHASE_BEGIN conv_phase(F, I, 0); PHASE_END(false)
#endif
    if (layer_body<0>(F, args, bar, ph, lo, hi)) return;
    (void)layer_body<1>(F, args, bar, ph, lo, hi);
}

extern "C" void kernel_launch(void* const* d_in, const int* in_sizes, int n_in, void* d_out, int out_size, void* d_ws, size_t ws_size, hipStream_t stream) {
    static int grid = 0;
    if (grid == 0) {
        if (n_in != 31 || out_size != NTOK * DM || ws_size < WS_END) { fprintf(stderr, "kernel_launch: unexpected shapes: n_in %d out %d ws %zu (need %zu)\n", n_in, out_size, ws_size, (size_t)WS_END); grid = -1; return; }
        int dev = 0, cus = 0, per_cu = 0;
        if (hipGetDevice(&dev) != hipSuccess || hipDeviceGetAttribute(&cus, hipDeviceAttributeMultiprocessorCount, dev) != hipSuccess) { grid = -1; return; }
        if (hipFuncSetAttribute((const void*)hybrid_fwd, hipFuncAttributeMaxDynamicSharedMemorySize, LDS_BYTES) != hipSuccess) { fprintf(stderr, "kernel_launch: hipFuncSetAttribute failed\n"); grid = -1; return; }
        if (hipOccupancyMaxActiveBlocksPerMultiprocessor(&per_cu, (const void*)hybrid_fwd, NTHR, LDS_BYTES) != hipSuccess || per_cu < 1) fprintf(stderr, "kernel_launch: occupancy query says %d\n", per_cu);
        (void)hipGetLastError();
        grid = cus;
    }
    if (grid < 0) return;
    (void)hipMemsetAsync((char*)d_ws + WS_CTL, 0, CTL_ZERO_BYTES, stream);
    (void)hipMemsetAsync((char*)d_ws + WS_SLOT_TOK, 0xFF, 2 * MiB, stream);
    Args a{};
    for (int i = 0; i < 31; ++i) a.in[i] = (const float*)d_in[i];
    a.out = (float*)d_out; a.ws = (unsigned char*)d_ws; a.ph_lo = 0; a.ph_hi = 1000;
    hipLaunchKernelGGL(hybrid_fwd, dim3(grid), dim3(NTHR), LDS_BYTES, stream, a);
}
```
